# Optimizing an MI355X kernel written in HIP

```python
import math
import jax
import jax.numpy as jnp
from jax import lax
import numpy as np

D_MODEL = 1024
BATCH = 8
SEQ = 4096
DEPTH = 2

GRID_W = 64
CTX_LEN = 256
N_MOD = 6
EPS = 1e-6
NEG_INF = -1e30
ROPE_BASE = 10000.0
BLOCK = 128
DA_HEADS = 4
DA_QK_DIM = 32
DA_V_DIM = 64
HEAD_DIM = 64
SW_HEADS = 6
SW_KV_HEADS = 2
SW_GROUP = SW_HEADS // SW_KV_HEADS
WINDOW = 128
LRU_WIDTH = 384
LRU_BLOCKS = 6
LRU_BLOCK_DIM = LRU_WIDTH // LRU_BLOCKS
LRU_CONV = 4
LRU_C = 8.0
D_MIX = DA_HEADS * DA_V_DIM + SW_HEADS * HEAD_DIM + LRU_WIDTH
IN_SIZES = (DA_HEADS * 2 * DA_QK_DIM, DA_HEADS * 2 * DA_QK_DIM, DA_HEADS * DA_V_DIM,
            SW_HEADS * HEAD_DIM, SW_KV_HEADS * HEAD_DIM, SW_KV_HEADS * HEAD_DIM,
            LRU_WIDTH, LRU_WIDTH)
D_IN = sum(IN_SIZES)
D_FF = 2816
FFN_CONV = 3

kernel_name = 'hybrid_diffusion_parallel_heads'

F32 = jnp.float32


def rms_norm(x, gain):
    xf = x.astype(F32)
    y = xf * lax.rsqrt(jnp.mean(xf * xf, axis=-1, keepdims=True) + EPS)
    return (y * gain.astype(F32)).astype(x.dtype)


def modulate(h, shift, scale):
    return h * (1 + scale) + shift


def axial_rope_tables(rows, head_dim):
    row = jnp.repeat(jnp.arange(rows, dtype=F32), GRID_W)
    col = jnp.tile(jnp.arange(GRID_W, dtype=F32), rows)
    quarter = head_dim // 4
    inv_freq = ROPE_BASE ** (-jnp.arange(quarter, dtype=F32) / quarter)
    ang = jnp.concatenate([row[:, None] * inv_freq, col[:, None] * inv_freq], axis=-1)
    return jnp.cos(ang), jnp.sin(ang)


def apply_rope(x, cos, sin):
    xf = x.astype(F32)
    half = x.shape[-1] // 2
    x1, x2 = xf[..., :half], xf[..., half:]
    shape = (1, cos.shape[0]) + (1,) * (x.ndim - 3) + (half,)
    cs, sn = cos.reshape(shape), sin.reshape(shape)
    return jnp.concatenate([x1 * cs - x2 * sn, x1 * sn + x2 * cs], axis=-1).astype(x.dtype)


def dwconv(x, w, b, left):
    k_width = w.shape[0]
    t_len = x.shape[1]
    xp = jnp.pad(x, ((0, 0), (left, k_width - 1 - left), (0, 0)))
    out = b
    for k in range(k_width):
        out = out + xp[:, k:k + t_len] * w[k]
    return out


def linear_scan(a, b, h0):
    def combine(l, r):
        return (l[0] * r[0], r[0] * l[1] + r[1])
    a_cum, b_cum = lax.associative_scan(combine, (a, b), axis=1)
    return a_cum * h0[:, None] + b_cum


def da_qkv(aq, ak, av, q_gain, k_gain, rope):
    bsz, t_len = aq.shape[:2]
    q = rms_norm(aq.reshape(bsz, t_len, DA_HEADS, 2, DA_QK_DIM), q_gain)
    k = rms_norm(ak.reshape(bsz, t_len, DA_HEADS, 2, DA_QK_DIM), k_gain)
    v = av.reshape(bsz, t_len, DA_HEADS, DA_V_DIM)
    if rope is not None:
        q = apply_rope(q, rope[0], rope[1])
        k = apply_rope(k, rope[0], rope[1])
    return q, k, v


def diff_attention(q, k, v, qc, kc, vc, lam, lambda_init, sub_gain, ctx_out):
    bsz, n_tok = q.shape[:2]
    scale = DA_QK_DIM ** -0.5

    def attend(qb, keys, vals):
        s = jnp.einsum('bqhmd,bkhmd->bhmqk', qb, keys).astype(F32) * scale
        p = jax.nn.softmax(s, axis=-1)
        w = p[:, :, 0] - lam * p[:, :, 1]
        return jnp.einsum('bhqk,bkhd->bqhd', w.astype(vals.dtype), vals)

    def finish(o):
        return (rms_norm(o, sub_gain) * (1.0 - lambda_init)).reshape(o.shape[0], o.shape[1], -1)

    k_all = jnp.concatenate([kc, k], axis=1)
    v_all = jnp.concatenate([vc, v], axis=1)
    n_blk = n_tok // BLOCK
    qb = q.reshape((bsz, n_blk, BLOCK) + q.shape[2:]).swapaxes(0, 1)
    o = lax.map(lambda blk: attend(blk, k_all, v_all), qb)
    y = finish(o.swapaxes(0, 1).reshape(bsz, n_tok, DA_HEADS, DA_V_DIM))
    yc = finish(attend(qc, kc, vc)) if ctx_out else None
    return y, yc


def sw_qkv(bq, bk, bv, q_gain, k_gain, rope):
    bsz, t_len = bq.shape[:2]
    q = rms_norm(bq.reshape(bsz, t_len, SW_HEADS, HEAD_DIM), q_gain)
    k = rms_norm(bk.reshape(bsz, t_len, SW_KV_HEADS, HEAD_DIM), k_gain)
    v = bv.reshape(bsz, t_len, SW_KV_HEADS, HEAD_DIM)
    if rope is not None:
        q = apply_rope(q, rope[0], rope[1])
        k = apply_rope(k, rope[0], rope[1])
    return q, k, v


def window_attention(q, k, v, qc, kc, vc, sink, ctx_out):
    bsz, n_tok = q.shape[:2]
    n_ctx = kc.shape[1]
    n_blk = n_tok // BLOCK
    scale = HEAD_DIM ** -0.5
    sink_l = sink.astype(F32).reshape(SW_KV_HEADS, SW_GROUP, 1, 1)

    def band(t):
        tp = jnp.pad(t, ((0, 0), (BLOCK, BLOCK), (0, 0), (0, 0)))
        tp = tp.reshape(bsz, n_blk + 2, BLOCK, SW_KV_HEADS, HEAD_DIM)
        bd = jnp.concatenate([tp[:, :-2], tp[:, 1:-1], tp[:, 2:]], axis=2)
        return bd.swapaxes(0, 1)

    kb, vb = band(k), band(v)
    qb = q.reshape(bsz, n_blk, BLOCK, SW_KV_HEADS, SW_GROUP, HEAD_DIM).swapaxes(0, 1)
    qi = jnp.arange(BLOCK)
    kj = jnp.arange(3 * BLOCK) - BLOCK

    def one_block(args):
        n, qblk, kblk, vblk = args
        qpos = n * BLOCK + qi
        kpos = n * BLOCK + kj
        valid = ((jnp.abs(qpos[:, None] - kpos[None, :]) <= WINDOW)
                 & (kpos >= 0)[None, :] & (kpos < n_tok)[None, :])
        s_lat = jnp.einsum('bqkgd,bjkd->bkgqj', qblk, kblk).astype(F32) * scale
        s_lat = jnp.where(valid, s_lat, NEG_INF)
        s_ctx = jnp.einsum('bqkgd,bckd->bkgqc', qblk, kc).astype(F32) * scale
        sink_col = jnp.broadcast_to(sink_l, s_ctx.shape[:-1] + (1,))
        p = jax.nn.softmax(jnp.concatenate([s_ctx, s_lat, sink_col], axis=-1), axis=-1)
        p_ctx = p[..., :n_ctx]
        p_lat = p[..., n_ctx:n_ctx + 3 * BLOCK]
        return (jnp.einsum('bkgqc,bckd->bqkgd', p_ctx.astype(vc.dtype), vc)
                + jnp.einsum('bkgqj,bjkd->bqkgd', p_lat.astype(vblk.dtype), vblk))

    o = lax.map(one_block, (jnp.arange(n_blk), qb, kb, vb))
    y = o.swapaxes(0, 1).reshape(bsz, n_tok, SW_HEADS * HEAD_DIM)
    yc = None
    if ctx_out:
        qcg = qc.reshape(bsz, n_ctx, SW_KV_HEADS, SW_GROUP, HEAD_DIM)
        s = jnp.einsum('bqkgd,bckd->bkgqc', qcg, kc).astype(F32) * scale
        sink_col = jnp.broadcast_to(sink_l, s.shape[:-1] + (1,))
        p = jax.nn.softmax(jnp.concatenate([s, sink_col], axis=-1), axis=-1)[..., :n_ctx]
        yc = jnp.einsum('bkgqc,bckd->bqkgd', p.astype(vc.dtype), vc).reshape(bsz, n_ctx, -1)
    return y, yc


def rglru_gates(xs, conv_w, conv_b, wa, ba, wx, bx, lam_param):
    xc = dwconv(xs, conv_w, conv_b, LRU_CONV - 1)
    xblk = xc.reshape(xc.shape[0], xc.shape[1], LRU_BLOCKS, LRU_BLOCK_DIM)
    r = jax.nn.sigmoid(jnp.einsum('bthi,hij->bthj', xblk, wa).reshape(xc.shape) + ba)
    i = jax.nn.sigmoid(jnp.einsum('bthi,hij->bthj', xblk, wx).reshape(xc.shape) + bx)
    log_a = -LRU_C * r.astype(F32) * jax.nn.softplus(-lam_param.astype(F32))
    a = jnp.exp(log_a)
    b = jnp.sqrt(-jnp.expm1(2.0 * log_a)) * (i * xc).astype(F32)
    return a, b


def rglru_mixer(cx, cg, cxc, cgc, lp, ctx_out):
    bsz = cx.shape[0]
    lat_sum = 0.0
    ctx_sum = 0.0
    for d in range(2):
        flip = (lambda t: t[:, ::-1]) if d == 1 else (lambda t: t)
        params = (lp['lru_conv_w'][d], lp['lru_conv_b'][d], lp['lru_wa'][d], lp['lru_ba'][d],
                  lp['lru_wx'][d], lp['lru_bx'][d], lp['lru_lambda'][d])
        a_c, b_c = rglru_gates(flip(cxc), *params)
        h_c = linear_scan(a_c, b_c, jnp.zeros((bsz, LRU_WIDTH), F32))
        a_l, b_l = rglru_gates(flip(cx), *params)
        h_l = linear_scan(a_l, b_l, h_c[:, -1])
        lat_sum = lat_sum + flip(h_l)
        ctx_sum = ctx_sum + flip(h_c)
    y = (lat_sum * jax.nn.gelu(cg.astype(F32), approximate=True)).astype(cx.dtype)
    yc = (ctx_sum * jax.nn.gelu(cgc.astype(F32), approximate=True)).astype(cxc.dtype) if ctx_out else None
    return y, yc


def conv_ffn(h, lp):
    up = h @ lp['w_up']
    gate, val = jnp.split(up, 2, axis=-1)
    gate = dwconv(gate, lp['ffn_conv_w'], lp['ffn_conv_b'], (FFN_CONV - 1) // 2)
    return (jax.nn.silu(gate) * val) @ lp['w_down']


def hybrid_layer(x, xc, c, c_ctx, lp, lambda_init, rope_a, rope_b, ctx_out):
    mod = jax.nn.silu(c) @ lp['w_mod'] + lp['b_mod']
    mod_c = jax.nn.silu(c_ctx) @ lp['w_mod'] + lp['b_mod']
    sh1, sc1, g1, sh2, sc2, g2 = [m[:, None] for m in jnp.split(mod, N_MOD, axis=-1)]
    sh1c, sc1c, g1c, sh2c, sc2c, g2c = jnp.split(mod_c, N_MOD, axis=-1)

    h = modulate(rms_norm(x, lp['norm1_gain']), sh1, sc1)
    hc = modulate(rms_norm(xc, lp['norm1_gain']), sh1c, sc1c)
    split_pts = np.cumsum(IN_SIZES)[:-1].tolist()
    aq, ak, av, bq, bk, bv, cx, cg = jnp.split(h @ lp['w_in'], split_pts, axis=-1)
    aqc, akc, avc, bqc, bkc, bvc, cxc, cgc = jnp.split(hc @ lp['w_in'], split_pts, axis=-1)

    lam = (jnp.exp(jnp.sum(lp['da_lam_q1'].astype(F32) * lp['da_lam_k1'].astype(F32)))
           - jnp.exp(jnp.sum(lp['da_lam_q2'].astype(F32) * lp['da_lam_k2'].astype(F32)))
           + lambda_init)
    qa, ka, va = da_qkv(aq, ak, av, lp['da_q_gain'], lp['da_k_gain'], rope_a)
    qac, kac, vac = da_qkv(aqc, akc, avc, lp['da_q_gain'], lp['da_k_gain'], None)
    ya, yac = diff_attention(qa, ka, va, qac, kac, vac, lam, lambda_init, lp['da_sub_gain'], ctx_out)

    qb, kb, vb = sw_qkv(bq, bk, bv, lp['sw_q_gain'], lp['sw_k_gain'], rope_b)
    qbc, kbc, vbc = sw_qkv(bqc, bkc, bvc, lp['sw_q_gain'], lp['sw_k_gain'], None)
    yb, ybc = window_attention(qb, kb, vb, qbc, kbc, vbc, lp['sw_sink'], ctx_out)

    yc_, ycc = rglru_mixer(cx, cg, cxc, cgc, lp, ctx_out)

    y = jnp.concatenate([ya, yb, yc_], axis=-1) @ lp['w_out']
    x = x + g1 * y
    x = x + g2 * conv_ffn(modulate(rms_norm(x, lp['norm2_gain']), sh2, sc2), lp)
    if ctx_out:
        yctx = jnp.concatenate([yac, ybc, ycc], axis=-1) @ lp['w_out']
        xc = xc + g1c * yctx
        xc = xc + g2c * conv_ffn(modulate(rms_norm(xc, lp['norm2_gain']), sh2c, sc2c), lp)
    return x, xc


def setup_inputs(seed: int = 0) -> dict:
    key = jax.random.key(seed)
    ks = iter(jax.random.split(key, 40))
    D = D_MODEL

    def nrm(shape, scale):
        return jax.random.normal(next(ks), shape, F32) * scale

    def gain(shape):
        return 1.0 + nrm(shape, 0.02)

    x = nrm((BATCH, SEQ, D), 1.0)
    c = nrm((BATCH, D), 1.0)
    ctx = nrm((BATCH, CTX_LEN, D), 1.0)
    c_ctx = nrm((D,), 1.0)
    w_mod = nrm((DEPTH, D, N_MOD * D), 0.3 * D ** -0.5)
    b_mod = nrm((DEPTH, N_MOD * D), 0.02)
    norm1_gain = gain((DEPTH, D))
    norm2_gain = gain((DEPTH, D))
    w_in = nrm((DEPTH, D, D_IN), D ** -0.5)
    da_q_gain = gain((DEPTH, DA_QK_DIM))
    da_k_gain = gain((DEPTH, DA_QK_DIM))
    da_lam_q1 = nrm((DEPTH, DA_QK_DIM), 0.1)
    da_lam_k1 = nrm((DEPTH, DA_QK_DIM), 0.1)
    da_lam_q2 = nrm((DEPTH, DA_QK_DIM), 0.1)
    da_lam_k2 = nrm((DEPTH, DA_QK_DIM), 0.1)
    da_sub_gain = gain((DEPTH, DA_V_DIM))
    sw_q_gain = gain((DEPTH, HEAD_DIM))
    sw_k_gain = gain((DEPTH, HEAD_DIM))
    sw_sink = nrm((DEPTH, SW_HEADS), 1.0)
    lru_conv_w = nrm((DEPTH, 2, LRU_CONV, LRU_WIDTH), LRU_CONV ** -0.5)
    lru_conv_b = nrm((DEPTH, 2, LRU_WIDTH), 0.02)
    lru_wa = nrm((DEPTH, 2, LRU_BLOCKS, LRU_BLOCK_DIM, LRU_BLOCK_DIM), LRU_BLOCK_DIM ** -0.5)
    lru_ba = nrm((DEPTH, 2, LRU_WIDTH), 0.02)
    lru_wx = nrm((DEPTH, 2, LRU_BLOCKS, LRU_BLOCK_DIM, LRU_BLOCK_DIM), LRU_BLOCK_DIM ** -0.5)
    lru_bx = nrm((DEPTH, 2, LRU_WIDTH), 0.02)
    a_min, a_max = 0.9 ** (1.0 / LRU_C), 0.999 ** (1.0 / LRU_C)
    a = jax.random.uniform(next(ks), (DEPTH, 2, LRU_WIDTH), F32, a_min, a_max)
    lru_lambda = jnp.log(a) - jnp.log1p(-a)
    w_out = nrm((DEPTH, D_MIX, D), D_MIX ** -0.5)
    w_up = nrm((DEPTH, D, 2 * D_FF), D ** -0.5)
    ffn_conv_w = nrm((DEPTH, FFN_CONV, D_FF), FFN_CONV ** -0.5)
    ffn_conv_b = nrm((DEPTH, D_FF), 0.02)
    w_down = nrm((DEPTH, D_FF, D), D_FF ** -0.5)
    return {'x': x, 'c': c, 'ctx': ctx, 'c_ctx': c_ctx, 'w_mod': w_mod, 'b_mod': b_mod,
            'norm1_gain': norm1_gain, 'norm2_gain': norm2_gain, 'w_in': w_in,
            'da_q_gain': da_q_gain, 'da_k_gain': da_k_gain, 'da_lam_q1': da_lam_q1,
            'da_lam_k1': da_lam_k1, 'da_lam_q2': da_lam_q2, 'da_lam_k2': da_lam_k2,
            'da_sub_gain': da_sub_gain, 'sw_q_gain': sw_q_gain, 'sw_k_gain': sw_k_gain,
            'sw_sink': sw_sink, 'lru_conv_w': lru_conv_w, 'lru_conv_b': lru_conv_b,
            'lru_wa': lru_wa, 'lru_ba': lru_ba, 'lru_wx': lru_wx, 'lru_bx': lru_bx,
            'lru_lambda': lru_lambda, 'w_out': w_out, 'w_up': w_up, 'ffn_conv_w': ffn_conv_w,
            'ffn_conv_b': ffn_conv_b, 'w_down': w_down}


def reference(x, c, ctx, c_ctx, w_mod, b_mod, norm1_gain, norm2_gain, w_in, da_q_gain, da_k_gain,
              da_lam_q1, da_lam_k1, da_lam_q2, da_lam_k2, da_sub_gain, sw_q_gain, sw_k_gain,
              sw_sink, lru_conv_w, lru_conv_b, lru_wa, lru_ba, lru_wx, lru_bx, lru_lambda,
              w_out, w_up, ffn_conv_w, ffn_conv_b, w_down):
    n_tok = x.shape[1]
    rows = n_tok // GRID_W
    rope_a = axial_rope_tables(rows, DA_QK_DIM)
    rope_b = axial_rope_tables(rows, HEAD_DIM)
    xc = ctx
    for i in range(DEPTH):
        lp = dict(w_mod=w_mod[i], b_mod=b_mod[i], norm1_gain=norm1_gain[i], norm2_gain=norm2_gain[i],
                  w_in=w_in[i], da_q_gain=da_q_gain[i], da_k_gain=da_k_gain[i],
                  da_lam_q1=da_lam_q1[i], da_lam_k1=da_lam_k1[i], da_lam_q2=da_lam_q2[i],
                  da_lam_k2=da_lam_k2[i], da_sub_gain=da_sub_gain[i], sw_q_gain=sw_q_gain[i],
                  sw_k_gain=sw_k_gain[i], sw_sink=sw_sink[i], lru_conv_w=lru_conv_w[i],
                  lru_conv_b=lru_conv_b[i], lru_wa=lru_wa[i], lru_ba=lru_ba[i], lru_wx=lru_wx[i],
                  lru_bx=lru_bx[i], lru_lambda=lru_lambda[i], w_out=w_out[i], w_up=w_up[i],
                  ffn_conv_w=ffn_conv_w[i], ffn_conv_b=ffn_conv_b[i], w_down=w_down[i])
        lambda_init = 0.8 - 0.6 * math.exp(-0.3 * i)
        x, xc = hybrid_layer(x, xc, c, c_ctx, lp, lambda_init, rope_a, rope_b, i < DEPTH - 1)
    return x
```

```cpp
#include <hip/hip_runtime.h>
#include <math.h>
#include <stdint.h>

namespace orc {
constexpr int D = 1024, NB = 8, T = 4096, C = 256, R = C + T  , DIN = 2176, DMIX = 1024, DFF = 2816, NMOD = 6;
constexpr int LW = 384;
constexpr float EPS = 1e-6f;
constexpr int O_AQ = 0, O_AK = 256, O_AV = 512, O_BQ = 768, O_BK = 1152, O_BV = 1280, O_CX = 1408, O_CG = 1792;

__device__ __forceinline__ float sigmoidf_(float x) { return 1.f / (1.f + expf(-x)); }
__device__ __forceinline__ float siluf_(float x) { return x * sigmoidf_(x); }
__device__ __forceinline__ float gelu_tanh_(float x) { return 0.5f * x * (1.f + tanhf(0.7978845608028654f * (x + 0.044715f * x * x * x))); }

__global__ void __launch_bounds__(256) k_mod(const float* __restrict__ c, const float* __restrict__ cctx, const float* __restrict__ wmod, const float* __restrict__ bmod, float* __restrict__ mod) {
    const int n = blockIdx.x * blockDim.x + threadIdx.x; const int l = blockIdx.y;
    if (n >= NMOD * D) return;
    float acc[9];
#pragma unroll
    for (int v = 0; v < 9; ++v) acc[v] = 0.f;
    const float* w = wmod + (size_t)l * D * NMOD * D;
    for (int k = 0; k < D; ++k) {
        const float wv = w[(size_t)k * NMOD * D + n];
#pragma unroll
        for (int v = 0; v < 8; ++v) acc[v] += siluf_(c[v * D + k]) * wv;
        acc[8] += siluf_(cctx[k]) * wv;
    }
    const float bb = bmod[l * NMOD * D + n];
#pragma unroll
    for (int v = 0; v < 9; ++v) mod[((size_t)l * 9 + v) * NMOD * D + n] = acc[v] + bb;
}

__global__ void __launch_bounds__(256) k_normmod(const float* __restrict__ srcC, const float* __restrict__ srcL, const float* __restrict__ gain, const float* __restrict__ modC, const float* __restrict__ modL, int shOff, int scOff, float* __restrict__ out) {
    const int r = blockIdx.x; const int tid = threadIdx.x;
    const float* src = r < C ? srcC + (size_t)r * D : srcL + (size_t)(r - C) * D;
    const float* mod = r < C ? modC : modL;
    __shared__ float red[256];
    float v[4]; float s = 0.f;
#pragma unroll
    for (int i = 0; i < 4; ++i) { v[i] = src[tid + 256 * i]; s += v[i] * v[i]; }
    red[tid] = s; __syncthreads();
    for (int o = 128; o > 0; o >>= 1) { if (tid < o) red[tid] += red[tid + o]; __syncthreads(); }
    const float rs = 1.0f / sqrtf(red[0] / D + EPS);
#pragma unroll
    for (int i = 0; i < 4; ++i) { const int n = tid + 256 * i; out[(size_t)r * D + n] = v[i] * rs * gain[n] * (1.f + mod[scOff + n]) + mod[shOff + n]; }
}

__global__ void __launch_bounds__(256) k_gemm(const float* __restrict__ A, const float* __restrict__ W, float* __restrict__ Cc, int M, int N, int K) {
    __shared__ float As[16][65];
    __shared__ float Bs[16][64];
    const int tid = threadIdx.x, tx = tid & 15, ty = tid >> 4;
    const int m0 = blockIdx.y * 64, n0 = blockIdx.x * 64;
    float acc[4][4];
#pragma unroll
    for (int i = 0; i < 4; ++i) for (int j = 0; j < 4; ++j) acc[i][j] = 0.f;
    for (int k0 = 0; k0 < K; k0 += 16) {
#pragma unroll
        for (int i = 0; i < 4; ++i) { const int e = tid + 256 * i; const int mm = e >> 4, kk = e & 15; As[kk][mm] = A[(size_t)(m0 + mm) * K + k0 + kk]; }
#pragma unroll
        for (int i = 0; i < 4; ++i) { const int e = tid + 256 * i; const int kk = e >> 6, nn = e & 63; Bs[kk][nn] = W[(size_t)(k0 + kk) * N + n0 + nn]; }
        __syncthreads();
        for (int kk = 0; kk < 16; ++kk) {
            float a[4], b[4];
#pragma unroll
            for (int i = 0; i < 4; ++i) a[i] = As[kk][ty * 4 + i];
#pragma unroll
            for (int j = 0; j < 4; ++j) b[j] = Bs[kk][tx * 4 + j];
#pragma unroll
            for (int i = 0; i < 4; ++i) for (int j = 0; j < 4; ++j) acc[i][j] += a[i] * b[j];
        }
        __syncthreads();
    }
#pragma unroll
    for (int i = 0; i < 4; ++i) for (int j = 0; j < 4; ++j) Cc[(size_t)(m0 + ty * 4 + i) * N + n0 + tx * 4 + j] = acc[i][j];
}

__global__ void k_rope_table(float* __restrict__ tab32, float* __restrict__ tab64) {
    const int idx = blockIdx.x * blockDim.x + threadIdx.x;
    if (idx >= 64 * 8 + 64 * 16) return;
    int quarter, pos, fi; float* dst;
    if (idx < 64 * 8) { quarter = 8; pos = idx / 8; fi = idx % 8; dst = tab32 + idx * 2; }
    else { const int j = idx - 64 * 8; quarter = 16; pos = j / 16; fi = j % 16; dst = tab64 + j * 2; }
    const float invf = (float)exp(-(double)fi / (double)quarter * 9.210340371976184);
    const double x = (double)((float)pos * invf);
    const double twopi = 6.283185307179586476925;
    const double k = rint(x / twopi); const double r = x - k * twopi; const double r2 = r * r;
    double ss = 1.0; for (int n = 27; n >= 3; n -= 2) ss = 1.0 - ss * r2 / (double)(n * (n - 1));
    double cc = 1.0; for (int n = 26; n >= 2; n -= 2) cc = 1.0 - cc * r2 / (double)(n * (n - 1));
    dst[0] = (float)cc; dst[1] = (float)(r * ss);
}
template <int DIM> __device__ __forceinline__ void prep_group(float* __restrict__ p, const float* __restrict__ gain, int r, const float* __restrict__ tab) {
    float v[DIM]; float s = 0.f;
#pragma unroll
    for (int i = 0; i < DIM; ++i) { v[i] = p[i]; s += v[i] * v[i]; }
    const float rs = 1.0f / sqrtf(s / DIM + EPS);
#pragma unroll
    for (int i = 0; i < DIM; ++i) v[i] = v[i] * rs * gain[i];
    if (r >= C) {
        const int t = r - C; const int row = t / 64, col = t % 64;
        constexpr int half = DIM / 2, quarter = DIM / 4;
#pragma unroll
        for (int i = 0; i < half; ++i) {
            const int fi = i < quarter ? i : i - quarter;
            const int pos = i < quarter ? row : col;
            const float cs = tab[(pos * quarter + fi) * 2], sn = tab[(pos * quarter + fi) * 2 + 1];
            const float x1 = v[i], x2 = v[i + half];
            v[i] = x1 * cs - x2 * sn; v[i + half] = x1 * sn + x2 * cs;
        }
    }
#pragma unroll
    for (int i = 0; i < DIM; ++i) p[i] = v[i];
}
__global__ void __launch_bounds__(256) k_qkprep(float* __restrict__ P, const float* __restrict__ daq, const float* __restrict__ dak, const float* __restrict__ swq, const float* __restrict__ swk, const float* __restrict__ tab32, const float* __restrict__ tab64) {
    const int idx = blockIdx.x * blockDim.x + threadIdx.x;
    if (idx >= R * 24) return;
    const int r = idx / 24, g = idx % 24;
    float* row = P + (size_t)r * DIN;
    if (g < 8) prep_group<32>(row + O_AQ + g * 32, daq, r, tab32);
    else if (g < 16) prep_group<32>(row + O_AK + (g - 8) * 32, dak, r, tab32);
    else if (g < 22) prep_group<64>(row + O_BQ + (g - 16) * 64, swq, r, tab64);
    else prep_group<64>(row + O_BK + (g - 22) * 64, swk, r, tab64);
}

__global__ void __launch_bounds__(256) k_da_attn(const float* __restrict__ P, float* __restrict__ OA) {
    const int tid = threadIdx.x; const int r = blockIdx.x * 32 + (tid >> 3); const int h = (tid >> 1) & 3, m = tid & 1;
    const int nkeys = r < C ? C : R;
    float q[32];
    const float scale = 0.17677669529663687f;
#pragma unroll
    for (int i = 0; i < 32; ++i) q[i] = P[(size_t)r * DIN + O_AQ + h * 64 + m * 32 + i] * scale;
    float mx = -1e30f, l = 0.f; float acc[64];
#pragma unroll
    for (int i = 0; i < 64; ++i) acc[i] = 0.f;
    for (int j = 0; j < nkeys; ++j) {
        const float* kp = P + (size_t)j * DIN + O_AK + h * 64 + m * 32;
        float s = 0.f;
#pragma unroll
        for (int i = 0; i < 32; ++i) s += q[i] * kp[i];
        const float mn = fmaxf(mx, s); const float f = expf(mx - mn); const float p = expf(s - mn);
        l = l * f + p; mx = mn;
        const float* vp = P + (size_t)j * DIN + O_AV + h * 64;
#pragma unroll
        for (int i = 0; i < 64; ++i) acc[i] = acc[i] * f + p * vp[i];
    }
    const float il = 1.f / l;
    float* o = OA + (((size_t)r * 4 + h) * 2 + m) * 64;
#pragma unroll
    for (int i = 0; i < 64; ++i) o[i] = acc[i] * il;
}

__global__ void __launch_bounds__(256) k_da_finish(const float* __restrict__ OA, const float* __restrict__ lq1, const float* __restrict__ lk1, const float* __restrict__ lq2, const float* __restrict__ lk2, const float* __restrict__ subg, float lambda_init, float* __restrict__ Y) {
    const int idx = blockIdx.x * blockDim.x + threadIdx.x;
    if (idx >= R * 4) return;
    const int r = idx >> 2, h = idx & 3;
    float s1 = 0.f, s2 = 0.f;
#pragma unroll
    for (int i = 0; i < 32; ++i) { s1 += lq1[i] * lk1[i]; s2 += lq2[i] * lk2[i]; }
    const float lam = expf(s1) - expf(s2) + lambda_init;
    const float* o0 = OA + (((size_t)r * 4 + h) * 2 + 0) * 64; const float* o1 = o0 + 64;
    float v[64]; float ss = 0.f;
#pragma unroll
    for (int i = 0; i < 64; ++i) { v[i] = o0[i] - lam * o1[i]; ss += v[i] * v[i]; }
    const float rs = 1.0f / sqrtf(ss / 64.f + EPS);
#pragma unroll
    for (int i = 0; i < 64; ++i) Y[(size_t)r * DMIX + h * 64 + i] = v[i] * rs * subg[i] * (1.f - lambda_init);
}

__global__ void __launch_bounds__(256) k_sw_attn(const float* __restrict__ P, const float* __restrict__ sink, float* __restrict__ Y) {
    const int idx = blockIdx.x * blockDim.x + threadIdx.x;
    if (idx >= R * 6) return;
    const int r = idx / 6, qh = idx % 6, kv = qh / 3;
    float q[64];
#pragma unroll
    for (int i = 0; i < 64; ++i) q[i] = P[(size_t)r * DIN + O_BQ + qh * 64 + i] * 0.125f;
    float mx = sink[qh], l = 1.f; float acc[64];
#pragma unroll
    for (int i = 0; i < 64; ++i) acc[i] = 0.f;
    int lo = 0, hi = -1;
    if (r >= C) { const int t = r - C; lo = t - 128 < 0 ? 0 : t - 128; hi = t + 128 > T - 1 ? T - 1 : t + 128; }
    const int nk = C + (hi >= lo ? hi - lo + 1 : 0);
    for (int jj = 0; jj < nk; ++jj) {
        const int j = jj < C ? jj : C + lo + (jj - C);
        const float* kp = P + (size_t)j * DIN + O_BK + kv * 64;
        float s = 0.f;
#pragma unroll
        for (int i = 0; i < 64; ++i) s += q[i] * kp[i];
        const float mn = fmaxf(mx, s); const float f = expf(mx - mn); const float p = expf(s - mn);
        l = l * f + p; mx = mn;
        const float* vp = P + (size_t)j * DIN + O_BV + kv * 64;
#pragma unroll
        for (int i = 0; i < 64; ++i) acc[i] = acc[i] * f + p * vp[i];
    }
    const float il = 1.f / l;
#pragma unroll
    for (int i = 0; i < 64; ++i) Y[(size_t)r * DMIX + 256 + qh * 64 + i] = acc[i] * il;
}

__global__ void __launch_bounds__(256) k_lru_conv(const float* __restrict__ P, const float* __restrict__ cw, const float* __restrict__ cb, float* __restrict__ XCV) {
    const int idx = blockIdx.x * blockDim.x + threadIdx.x;
    if (idx >= 2 * R * LW) return;
    const int j = idx % LW, r = (idx / LW) % R, d = idx / (LW * R);
    const int seg0 = r < C ? 0 : C, L = r < C ? C : T, t = r - seg0;
    float s = cb[d * LW + j];
    for (int k = 0; k < 4; ++k) {
        const int tt = t + (d == 0 ? k - 3 : 3 - k);
        if (tt >= 0 && tt < L) s += cw[(d * 4 + k) * LW + j] * P[(size_t)(seg0 + tt) * DIN + O_CX + j];
    }
    XCV[((size_t)d * R + r) * LW + j] = s;
}
__global__ void __launch_bounds__(256) k_lru_gates(const float* __restrict__ XCV, const float* __restrict__ wa, const float* __restrict__ ba, const float* __restrict__ wx, const float* __restrict__ bx, const float* __restrict__ lam, float* __restrict__ AG, float* __restrict__ BG) {
    const int idx = blockIdx.x * blockDim.x + threadIdx.x;
    if (idx >= 2 * R * LW) return;
    const int j = idx % LW, r = (idx / LW) % R, d = idx / (LW * R);
    const int hb = j / 64, jj = j % 64;
    const float* x = XCV + ((size_t)d * R + r) * LW + hb * 64;
    const float* wap = wa + ((size_t)(d * 6 + hb) * 64) * 64 + jj; const float* wxp = wx + ((size_t)(d * 6 + hb) * 64) * 64 + jj;
    float rp = ba[d * LW + j], ip = bx[d * LW + j];
#pragma unroll
    for (int i = 0; i < 64; ++i) { rp += x[i] * wap[i * 64]; ip += x[i] * wxp[i * 64]; }
    const float rg = sigmoidf_(rp), ig = sigmoidf_(ip);
    const float lp = lam[d * LW + j];
    const float sp = lp > 0.f ? log1pf(expf(-lp)) : -lp + log1pf(expf(lp));
    const float log_a = -8.0f * rg * sp;
    const float a = expf(log_a);
    const float b = sqrtf(-expm1f(2.0f * log_a)) * (ig * x[jj]);
    AG[((size_t)d * R + r) * LW + j] = a; BG[((size_t)d * R + r) * LW + j] = b;
}
__global__ void k_lru_scan(const float* __restrict__ AG, const float* __restrict__ BG, float* __restrict__ HS) {
    const int idx = blockIdx.x * blockDim.x + threadIdx.x;
    if (idx >= 2 * LW) return;
    const int j = idx % LW, d = idx / LW;
    float h = 0.f;
    if (d == 0) {
        for (int r = 0; r < R; ++r) { const size_t o = ((size_t)d * R + r) * LW + j; h = AG[o] * h + BG[o]; HS[o] = h; }
    } else {
        for (int r = C - 1; r >= 0; --r) { const size_t o = ((size_t)d * R + r) * LW + j; h = AG[o] * h + BG[o]; HS[o] = h; }
        for (int r = R - 1; r >= C; --r) { const size_t o = ((size_t)d * R + r) * LW + j; h = AG[o] * h + BG[o]; HS[o] = h; }
    }
}
__global__ void __launch_bounds__(256) k_lru_out(const float* __restrict__ HS, const float* __restrict__ P, float* __restrict__ Y) {
    const int idx = blockIdx.x * blockDim.x + threadIdx.x;
    if (idx >= R * LW) return;
    const int j = idx % LW, r = idx / LW;
    const float hsum = HS[((size_t)0 * R + r) * LW + j] + HS[((size_t)1 * R + r) * LW + j];
    Y[(size_t)r * DMIX + 640 + j] = hsum * gelu_tanh_(P[(size_t)r * DIN + O_CG + j]);
}
__global__ void __launch_bounds__(256) k_resid(const float* __restrict__ srcC, const float* __restrict__ srcL, const float* __restrict__ Z, const float* __restrict__ modC, const float* __restrict__ modL, int gOff, float* __restrict__ dstC, float* __restrict__ dstL, int writeC) {
    const size_t idx = (size_t)blockIdx.x * blockDim.x + threadIdx.x;
    if (idx >= (size_t)R * D) return;
    const int n = (int)(idx % D), r = (int)(idx / D);
    if (r < C) { if (writeC) dstC[(size_t)r * D + n] = srcC[(size_t)r * D + n] + modC[gOff + n] * Z[idx]; }
    else dstL[(size_t)(r - C) * D + n] = srcL[(size_t)(r - C) * D + n] + modL[gOff + n] * Z[idx];
}
__global__ void __launch_bounds__(256) k_ffn_act(const float* __restrict__ U, const float* __restrict__ fw, const float* __restrict__ fb, float* __restrict__ A2) {
    const size_t idx = (size_t)blockIdx.x * blockDim.x + threadIdx.x;
    if (idx >= (size_t)R * DFF) return;
    const int c = (int)(idx % DFF), r = (int)(idx / DFF);
    const int seg0 = r < C ? 0 : C, L = r < C ? C : T, t = r - seg0;
    float g = fb[c] + fw[1 * DFF + c] * U[(size_t)r * 2 * DFF + c];
    if (t > 0) g += fw[0 * DFF + c] * U[(size_t)(r - 1) * 2 * DFF + c];
    if (t < L - 1) g += fw[2 * DFF + c] * U[(size_t)(r + 1) * 2 * DFF + c];
    A2[idx] = siluf_(g) * U[(size_t)r * 2 * DFF + DFF + c];
}
}

extern "C" void kernel_launch(void* const* d_in, const int* in_sizes, int n_in, void* d_out, int out_size, void* d_ws, size_t ws_size, hipStream_t stream) {
    using namespace orc;
    const float* x = (const float*)d_in[0]; const float* c = (const float*)d_in[1]; const float* ctx = (const float*)d_in[2]; const float* cctx = (const float*)d_in[3];
    const float* w_mod = (const float*)d_in[4]; const float* b_mod = (const float*)d_in[5]; const float* n1g = (const float*)d_in[6]; const float* n2g = (const float*)d_in[7];
    const float* w_in = (const float*)d_in[8]; const float* daq = (const float*)d_in[9]; const float* dak = (const float*)d_in[10];
    const float* lq1 = (const float*)d_in[11]; const float* lk1 = (const float*)d_in[12]; const float* lq2 = (const float*)d_in[13]; const float* lk2 = (const float*)d_in[14];
    const float* subg = (const float*)d_in[15]; const float* swq = (const float*)d_in[16]; const float* swk = (const float*)d_in[17]; const float* sink = (const float*)d_in[18];
    const float* lcw = (const float*)d_in[19]; const float* lcb = (const float*)d_in[20]; const float* lwa = (const float*)d_in[21]; const float* lba = (const float*)d_in[22];
    const float* lwx = (const float*)d_in[23]; const float* lbx = (const float*)d_in[24]; const float* llam = (const float*)d_in[25];
    const float* w_out = (const float*)d_in[26]; const float* w_up = (const float*)d_in[27]; const float* fcw = (const float*)d_in[28]; const float* fcb = (const float*)d_in[29]; const float* w_down = (const float*)d_in[30];
    float* out = (float*)d_out;
    float* ws = (float*)d_ws; size_t o = 0;
    auto take = [&](size_t n) { float* p = ws + o; o += (n + 63) & ~(size_t)63; return p; };
    float* mod = take((size_t)2 * 9 * NMOD * D);
    float* XCb = take((size_t)NB * C * D);
    float* HB = take((size_t)R * D);
    float* P = take((size_t)R * DIN);
    float* OA = take((size_t)R * 8 * 64);
    float* Y = take((size_t)R * DMIX);
    float* XCV = take((size_t)2 * R * LW);
    float* AG = take((size_t)2 * R * LW);
    float* BG = take((size_t)2 * R * LW);
    float* HS = take((size_t)2 * R * LW);
    float* Z = take((size_t)R * D);
    float* U = take((size_t)R * 2 * DFF);
    float* A2 = take((size_t)R * DFF);
    float* X1C = take((size_t)C * D);
    float* tab32 = take(64 * 8 * 2);
    float* tab64 = take(64 * 16 * 2);
    if (o * 4 > ws_size) return;

    k_mod<<<dim3(NMOD * D / 256, 2), 256, 0, stream>>>(c, cctx, w_mod, b_mod, mod);
    k_rope_table<<<(64 * 24 + 255) / 256, 256, 0, stream>>>(tab32, tab64);
    for (int l = 0; l < 2; ++l) {
        const float lambda_init = 0.8f - 0.6f * expf(-0.3f * (float)l);
        const float* modCv = mod + ((size_t)l * 9 + 8) * NMOD * D;
        for (int b = 0; b < NB; ++b) {
            const float* modLv = mod + ((size_t)l * 9 + b) * NMOD * D;
            const float* srcC = (l == 0 ? ctx : XCb) + (size_t)b * C * D;
            const float* srcL = (l == 0 ? x : out) + (size_t)b * T * D;
            float* dstL = out + (size_t)b * T * D;
            float* dstC = XCb + (size_t)b * C * D;
            k_normmod<<<R, 256, 0, stream>>>(srcC, srcL, n1g + l * D, modCv, modLv, 0 * D, 1 * D, HB);
            k_gemm<<<dim3(DIN / 64, R / 64), 256, 0, stream>>>(HB, w_in + (size_t)l * D * DIN, P, R, DIN, D);
            k_qkprep<<<(R * 24 + 255) / 256, 256, 0, stream>>>(P, daq + l * 32, dak + l * 32, swq + l * 64, swk + l * 64, tab32, tab64);
            k_da_attn<<<R / 32, 256, 0, stream>>>(P, OA);
            k_da_finish<<<(R * 4 + 255) / 256, 256, 0, stream>>>(OA, lq1 + l * 32, lk1 + l * 32, lq2 + l * 32, lk2 + l * 32, subg + l * 64, lambda_init, Y);
            k_sw_attn<<<(R * 6 + 255) / 256, 256, 0, stream>>>(P, sink + l * 6, Y);
            k_lru_conv<<<(2 * R * LW + 255) / 256, 256, 0, stream>>>(P, lcw + (size_t)l * 2 * 4 * LW, lcb + (size_t)l * 2 * LW, XCV);
            k_lru_gates<<<(2 * R * LW + 255) / 256, 256, 0, stream>>>(XCV, lwa + (size_t)l * 2 * 6 * 64 * 64, lba + (size_t)l * 2 * LW, lwx + (size_t)l * 2 * 6 * 64 * 64, lbx + (size_t)l * 2 * LW, llam + (size_t)l * 2 * LW, AG, BG);
            k_lru_scan<<<(2 * LW + 63) / 64, 64, 0, stream>>>(AG, BG, HS);
            k_lru_out<<<(R * LW + 255) / 256, 256, 0, stream>>>(HS, P, Y);
            k_gemm<<<dim3(D / 64, R / 64), 256, 0, stream>>>(Y, w_out + (size_t)l * DMIX * D, Z, R, D, DMIX);
            k_resid<<<(int)(((size_t)R * D + 255) / 256), 256, 0, stream>>>(srcC, srcL, Z, modCv, modLv, 2 * D, X1C, dstL, 1);
            k_normmod<<<R, 256, 0, stream>>>(X1C, dstL, n2g + l * D, modCv, modLv, 3 * D, 4 * D, HB);
            k_gemm<<<dim3(2 * DFF / 64, R / 64), 256, 0, stream>>>(HB, w_up + (size_t)l * D * 2 * DFF, U, R, 2 * DFF, D);
            k_ffn_act<<<(int)(((size_t)R * DFF + 255) / 256), 256, 0, stream>>>(U, fcw + (size_t)l * 3 * DFF, fcb + (size_t)l * DFF, A2);
            k_gemm<<<dim3(D / 64, R / 64), 256, 0, stream>>>(A2, w_down + (size_t)l * DFF * D, Z, R, D, DFF);
            k_resid<<<(int)(((size_t)R * D + 255) / 256), 256, 0, stream>>>(X1C, dstL, Z, modCv, modLv, 5 * D, dstC, dstL, l == 0 ? 1 : 0);
        }
    }
}
```

```cpp
#include <hip/hip_runtime.h>
#include <hip/hip_cooperative_groups.h>
#include <math.h>
#include <stdint.h>
#include <cstdio>
namespace cg = cooperative_groups;
namespace pg8 {
#define PG8_LAS __attribute__((address_space(3)))
typedef unsigned short bf16_t;
typedef short bf16x8 __attribute__((ext_vector_type(8)));
typedef float f32x4 __attribute__((ext_vector_type(4)));
typedef unsigned u32x4 __attribute__((ext_vector_type(4)));
constexpr int BM = 256, BK = 64, HALF = 128, HTB = HALF * BK * 2  , STAGE_BYTES = 8 * HTB, NXCD = 8, WGM = 8;

__host__ __device__ __forceinline__ int lds_byte(int r, int c) { const int st = (r >> 4) * 2 + (c >> 5), rr = r & 15, cc = c & 31, ob = rr * 64 + cc * 2; return st * 1024 + (ob ^ (((ob >> 9) & 1) << 5)); }
__host__ __device__ __forceinline__ void stage_rc(int b, int& R, int& C) { const int st = b / 1024, sb = b % 1024, swz = sb ^ (((sb >> 9) & 1) << 5); R = (st >> 1) * 16 + swz / 64; C = (st & 1) * 32 + (swz % 64) / 2; }
__host__ __device__ __forceinline__ int perm32(int rho) { const int n = rho >> 4, i = rho & 15; return 8 * (i >> 2) + 4 * n + (i & 3); }

struct Unit { int pm, pn; };
struct Gemm { const bf16_t* A; const bf16_t* Bt; int M, N, K; };

struct StaticOrder {
    int nM, nN, nwg, G, c;
    __host__ __device__ void init(int M, int N, int G_, int c_) { nM = M / BM; nN = N / BM; nwg = nM * nN; G = G_; c = c_; }
    __host__ __device__ bool next(int i, Unit& u) const {
        const long L = (long)i * G + c; if (L >= nwg) return false;
        int wgid = (int)L; { const int q = nwg / NXCD, r = nwg % NXCD, xcd = wgid % NXCD, off = wgid / NXCD; wgid = (xcd < r ? xcd * (q + 1) : r * (q + 1) + (xcd - r) * q) + off; }
        const int nig = WGM * nN, gid = wgid / nig, fm = gid * WGM, gsz = (nM - fm) < WGM ? (nM - fm) : WGM;
        u.pm = fm + ((wgid % nig) % gsz); u.pn = (wgid % nig) / gsz; return true;
    }
    __device__ __forceinline__ void a_ready(const Unit&) const {}
    __device__ __forceinline__ void done(const Unit&) const {}
};


template <class Epi, class Sched, bool ALIGN_EPI = false, bool SP2 = false>
__device__ __forceinline__ void gemm_phase(PG8_LAS unsigned char* lds, const Gemm g, const Sched& S, const Epi& E, const int tid) {
    const int wid = __builtin_amdgcn_readfirstlane(tid >> 6), lane = tid & 63, wr = wid >> 2, wc = wid & 3, fr = lane & 15, fq = lane >> 4;
    const int K = g.K, nt = K / BK;
    unsigned voffA[2], voffB[2];
#pragma unroll
    for (int i = 0; i < 2; ++i) { int R, C; stage_rc(tid * 16 + i * 8192, R, C); const int Rb = Epi::PERM ? ((R & ~31) + perm32(R & 31)) : R;
        voffA[i] = (unsigned)(R * K + C) * 2u; voffB[i] = (unsigned)(Rb * K + C) * 2u; }
    const size_t kstep = (size_t)(BK * 2);
    const size_t hstep = (size_t)HALF * K * 2;
    const size_t tstep = 2 * hstep;
    const unsigned ldsw = (unsigned)wid * 1024u;
    const int aoff = lds_byte(wr * 64 + fr, fq * 8), boff = lds_byte(wc * 32 + fr, fq * 8);
#define PG8_SA(b, h) (((b) * 2 + (h)) * HTB)
#define PG8_SB(b, h) ((4 + (b) * 2 + (h)) * HTB)
#define PG8_STAGE(bufoff, gbase, voff) do { _Pragma("unroll") for (int _i = 0; _i < 2; ++_i) \
        __builtin_amdgcn_global_load_lds((const unsigned*)((const char*)(gbase) + (voff)[_i]), (PG8_LAS unsigned*)(lds + (bufoff) + ldsw + _i * 8192), 16, 0, 0); } while (0)
#define PG8_LDA(dst, b, h) do { _Pragma("unroll") for (int m = 0; m < 4; ++m) _Pragma("unroll") for (int k = 0; k < 2; ++k) dst[m][k] = *(const PG8_LAS bf16x8*)(lds + PG8_SA(b, h) + aoff + m * 2048 + k * 1024); } while (0)
#define PG8_LDB(dst, b, h) do { _Pragma("unroll") for (int n = 0; n < 2; ++n) _Pragma("unroll") for (int k = 0; k < 2; ++k) dst[n][k] = *(const PG8_LAS bf16x8*)(lds + PG8_SB(b, h) + boff + n * 2048 + k * 1024); } while (0)
#define PG8_MMA(ai, bj, At, Bt) do { __builtin_amdgcn_s_setprio(1); _Pragma("unroll") for (int m = 0; m < 4; ++m) _Pragma("unroll") for (int n = 0; n < 2; ++n) _Pragma("unroll") for (int k = 0; k < 2; ++k) \
        acc[ai][bj][m][n] = __builtin_amdgcn_mfma_f32_16x16x32_bf16(Bt[n][k], At[m][k], acc[ai][bj][m][n], 0, 0, 0); __builtin_amdgcn_s_setprio(0); } while (0)
#define PG8_WAIT_V(n) asm volatile("s_waitcnt vmcnt(" #n ")" ::: "memory")
#define PG8_WAIT_L(n) asm volatile("s_waitcnt lgkmcnt(" #n ")" ::: "memory")
#define PG8_BAR __builtin_amdgcn_s_barrier()
#define PG8_SCHED __builtin_amdgcn_sched_barrier(0)
    Unit cur, nxt; int ui = 0;
    if (!S.next(0, cur)) return;
    f32x4 acc[2][2][4][2];
#pragma unroll
    for (int a = 0; a < 2; ++a)
#pragma unroll
        for (int b = 0; b < 2; ++b)
#pragma unroll
            for (int m = 0; m < 4; ++m)
#pragma unroll
                for (int n = 0; n < 2; ++n) acc[a][b][m][n] = (f32x4){0.f, 0.f, 0.f, 0.f};
    bf16x8 At[4][2], B0[2][2], B1[2][2];
    const char* cA = (const char*)g.A + (size_t)cur.pm * tstep; const char* cB = (const char*)g.Bt + (size_t)cur.pn * tstep;
    S.a_ready(cur);
    if constexpr (SP2) {
        PG8_STAGE(PG8_SB(0, 0), cB, voffB); PG8_STAGE(PG8_SB(0, 1), cB + hstep, voffB); PG8_STAGE(PG8_SA(0, 0), cA, voffA); PG8_STAGE(PG8_SA(0, 1), cA + hstep, voffA);
        if (wr == 1) PG8_BAR;
        PG8_WAIT_V(2); PG8_BAR;
        PG8_STAGE(PG8_SB(1, 0), cB + kstep, voffB); PG8_STAGE(PG8_SA(1, 0), cA + kstep, voffA); PG8_STAGE(PG8_SB(1, 1), cB + hstep + kstep, voffB);
        PG8_WAIT_V(6); PG8_BAR;
    } else {
        PG8_STAGE(PG8_SB(0, 0), cB, voffB); PG8_STAGE(PG8_SA(0, 0), cA, voffA); PG8_STAGE(PG8_SB(0, 1), cB + hstep, voffB); PG8_STAGE(PG8_SA(0, 1), cA + hstep, voffA);
        if (wr == 1) PG8_BAR;
        PG8_WAIT_V(4); PG8_BAR;
        PG8_STAGE(PG8_SB(1, 0), cB + kstep, voffB); PG8_STAGE(PG8_SA(1, 0), cA + kstep, voffA); PG8_STAGE(PG8_SB(1, 1), cB + hstep + kstep, voffB);
        PG8_WAIT_V(6); PG8_BAR;
    }
    for (;;) {
        const bool has_next = S.next(ui + 1, nxt);
        const char* nA = has_next ? (const char*)g.A + (size_t)nxt.pm * tstep : cA; const char* nB = has_next ? (const char*)g.Bt + (size_t)nxt.pn * tstep : cB;
        for (int t = 0; t < nt; t += 2) {
            const bool last = (t == nt - 2);
            const char* a1 = cA + (size_t)(t + 1) * kstep;
            const char* a2 = last ? nA : cA + (size_t)(t + 2) * kstep; const char* b2 = last ? nB : cB + (size_t)(t + 2) * kstep;
            const char* a3 = a2 + kstep; const char* b3 = b2 + kstep;
            if (last && has_next) S.a_ready(nxt);
            if constexpr (SP2) {
            PG8_LDB(B0, 0, 0); PG8_LDB(B1, 0, 1); PG8_SCHED; PG8_LDA(At, 0, 0); PG8_STAGE(PG8_SA(1, 1), a1 + hstep, voffA);
            PG8_WAIT_V(8); PG8_WAIT_L(0); PG8_BAR; PG8_MMA(0, 0, At, B0); PG8_MMA(0, 1, At, B1); PG8_BAR; PG8_SCHED;
            PG8_LDA(At, 0, 1); PG8_STAGE(PG8_SB(0, 0), b2, voffB); PG8_STAGE(PG8_SB(0, 1), b2 + hstep, voffB); PG8_STAGE(PG8_SA(0, 0), a2, voffA);
            PG8_WAIT_V(8); PG8_WAIT_L(0); PG8_BAR; PG8_MMA(1, 0, At, B0); PG8_MMA(1, 1, At, B1); PG8_BAR; PG8_SCHED;
            PG8_LDB(B0, 1, 0); PG8_LDB(B1, 1, 1); PG8_SCHED; PG8_LDA(At, 1, 0); PG8_STAGE(PG8_SA(0, 1), a2 + hstep, voffA);
            PG8_WAIT_V(8); PG8_WAIT_L(0); PG8_BAR; PG8_MMA(0, 0, At, B0); PG8_MMA(0, 1, At, B1); PG8_BAR; PG8_SCHED;
            PG8_LDA(At, 1, 1); PG8_STAGE(PG8_SB(1, 0), b3, voffB); PG8_STAGE(PG8_SB(1, 1), b3 + hstep, voffB); PG8_STAGE(PG8_SA(1, 0), a3, voffA);
            PG8_WAIT_V(8); PG8_WAIT_L(0); PG8_BAR; PG8_MMA(1, 0, At, B0); PG8_MMA(1, 1, At, B1); PG8_BAR; PG8_SCHED;
            } else {
            PG8_LDB(B0, 0, 0); PG8_SCHED; PG8_LDA(At, 0, 0); PG8_STAGE(PG8_SA(1, 1), a1 + hstep, voffA);
            PG8_WAIT_L(8); PG8_BAR; PG8_WAIT_L(0); PG8_MMA(0, 0, At, B0); PG8_BAR; PG8_SCHED;
            PG8_LDB(B1, 0, 1); PG8_STAGE(PG8_SB(0, 0), b2, voffB);
            PG8_BAR; PG8_WAIT_L(0); PG8_MMA(0, 1, At, B1); PG8_BAR;
            PG8_LDA(At, 0, 1); PG8_STAGE(PG8_SA(0, 0), a2, voffA);
            PG8_BAR; PG8_WAIT_L(0); PG8_MMA(1, 0, At, B0); PG8_BAR; PG8_SCHED;
            PG8_STAGE(PG8_SB(0, 1), b2 + hstep, voffB);
            PG8_WAIT_V(6); PG8_BAR; PG8_MMA(1, 1, At, B1); PG8_BAR;
            PG8_LDB(B0, 1, 0); PG8_SCHED; PG8_LDA(At, 1, 0); PG8_STAGE(PG8_SA(0, 1), a2 + hstep, voffA);
            PG8_WAIT_L(8); PG8_BAR; PG8_WAIT_L(0); PG8_MMA(0, 0, At, B0); PG8_BAR; PG8_SCHED;
            PG8_LDB(B1, 1, 1); PG8_STAGE(PG8_SB(1, 0), b3, voffB);
            PG8_BAR; PG8_WAIT_L(0); PG8_MMA(0, 1, At, B1); PG8_BAR;
            PG8_LDA(At, 1, 1); PG8_STAGE(PG8_SA(1, 0), a3, voffA);
            PG8_BAR; PG8_WAIT_L(0); PG8_MMA(1, 0, At, B0); PG8_BAR; PG8_SCHED;
            PG8_STAGE(PG8_SB(1, 1), b3 + hstep, voffB);
            PG8_WAIT_V(6); PG8_BAR; PG8_MMA(1, 1, At, B1); PG8_BAR;
            }
        }
        if constexpr (ALIGN_EPI) { if (wr == 0) PG8_BAR; }
        if constexpr (!Epi::AFTER_DRAIN) { E(acc, cur, wr, wc, fr, fq); S.done(cur); }
        if (!has_next) break;
#pragma unroll
        for (int a = 0; a < 2; ++a)
#pragma unroll
            for (int b = 0; b < 2; ++b)
#pragma unroll
                for (int m = 0; m < 4; ++m)
#pragma unroll
                    for (int n = 0; n < 2; ++n) acc[a][b][m][n] = (f32x4){0.f, 0.f, 0.f, 0.f};
        cur = nxt; cA = nA; cB = nB; ++ui;
        if constexpr (ALIGN_EPI) { if (wr == 1) PG8_BAR; }
    }
    PG8_WAIT_V(0);
    if constexpr (!ALIGN_EPI) { if (wr == 0) PG8_BAR; }
    PG8_BAR;
    if constexpr (Epi::AFTER_DRAIN) { E.fused(acc, cur, wr, wc, fr, fq, lds, wid, lane); S.done(cur); }
#undef PG8_SA
#undef PG8_SB
#undef PG8_STAGE
#undef PG8_LDA
#undef PG8_LDB
#undef PG8_MMA
#undef PG8_WAIT_V
#undef PG8_WAIT_L
#undef PG8_BAR
#undef PG8_SCHED
}
}

#ifndef PG8_SP2
#define PG8_SP2 true
#endif

namespace mk {
using pg8::bf16_t; using pg8::f32x4; using pg8::Unit;
#define LAS __attribute__((address_space(3)))
typedef unsigned u32x2 __attribute__((ext_vector_type(2)));
typedef unsigned u32x4 __attribute__((ext_vector_type(4)));
constexpr int D = 1024, NB = 8, T = 4096, C = 256, RB = C + T, MALL = NB * RB, NTILE = MALL / 256, TPB = RB / 256  ;
constexpr int DIN = 2176, DINP = 2304, DMIX = 1024, DFF = 2816, NMOD = 6, LW = 384;
constexpr float EPS = 1e-6f, LOG2E = 1.4426950408889634f;
constexpr float QSA = 0.17677669529663687f * LOG2E, QSB = 0.125f * LOG2E;
constexpr int O_AQ = 0, O_AK = 256, O_AV = 512, O_BQ = 768, O_BK = 1152, O_BV = 1280, O_CX = 1408, O_CG = 1792;
constexpr int NWAVES = 8, NTHREADS = 512;
constexpr size_t MiB = 1u << 20;
constexpr size_t WS_CTL = 0;
constexpr size_t WS_WIN = 1 * MiB;
constexpr size_t WS_WOUT = 10 * MiB;
constexpr size_t WS_WUP = 14 * MiB;
constexpr size_t WS_WDN = 36 * MiB;
constexpr size_t WS_MOD = 47 * MiB;
constexpr size_t WS_BIAS1 = WS_MOD + 512 * 1024;
constexpr size_t WS_BIAS2 = WS_BIAS1 + 256 * 1024;
constexpr size_t WS_TAB = WS_BIAS2 + 512 * 1024;
constexpr size_t WS_TAB64 = WS_TAB + 4096, WS_PAR = WS_TAB64 + 8192;
constexpr int PAR_STRIDE = 512, PR_GQ32 = 0, PR_GK32 = 32, PR_GQ64 = 64, PR_GK64 = 128, PR_SUBG = 192, PR_SINK = 256, PR_LAM = 272, PR_MA = 273, PR_MB = 274, PR_LI = 275;
constexpr size_t WS_GAIN = WS_PAR + 8192;
constexpr size_t WS_FFNP = WS_GAIN + 16384;
constexpr size_t WS_SS1 = 49 * MiB;
constexpr size_t WS_SS2 = WS_SS1 + 3 * MiB;
constexpr size_t WS_LRU = 55 * MiB;
constexpr size_t WS_XC = 56 * MiB;
constexpr size_t WS_SIDE = 64 * MiB;
constexpr size_t WS_VN = 73 * MiB;
constexpr size_t WS_P = 141 * MiB;
constexpr size_t WS_Y = 294 * MiB;
constexpr size_t WS_U = WS_P;
constexpr size_t WS_END = 362 * MiB;
static_assert(WS_FFNP + 2 * 4 * DFF * 4 <= WS_SS1 && WS_SS2 + (size_t)MALL * 64 <= WS_LRU && WS_SIDE + (size_t)NTILE * 6 * DFF * 4 <= WS_VN && WS_U + (size_t)MALL * DFF * 2 <= WS_END && WS_P + (size_t)MALL * DINP * 2 <= WS_Y && WS_Y + (size_t)MALL * D * 2 <= WS_END && WS_VN + (size_t)MALL * D * 2 <= WS_P, "ws map");
constexpr int LDS_BYTES = 147456;

__device__ __forceinline__ unsigned f2bf(float f) { unsigned u = __builtin_bit_cast(unsigned, f); return (u + 0x7fffu + ((u >> 16) & 1u)) >> 16; }
__device__ __forceinline__ unsigned pk2(float lo, float hi) { return f2bf(lo) | (f2bf(hi) << 16); }
__device__ __forceinline__ float bf2f(unsigned short h) { return __builtin_bit_cast(float, (unsigned)h << 16); }
__device__ __forceinline__ float sigmoidf_(float x) { return 1.f / (1.f + __expf(-x)); }
__device__ __forceinline__ float siluf_(float x) { return x * sigmoidf_(x); }
#define LDS_WAIT() asm volatile("s_waitcnt lgkmcnt(0)" ::: "memory")

struct Frame {
    LAS unsigned char* lds;
    int tid, lane, wave, vcu, G, bid;
    const float* const* inp; int zero; float* out; unsigned char* ws;
    __device__ __forceinline__ const float* in_(int k) const { return inp[k + zero]; }
};

__device__ __forceinline__ int map_in(int n) {
    const int tile = n >> 8, lc = n & 255;
    if (tile <= 1) { const int s = lc >> 5, bj = (lc >> 4) & 1, q = lc & 15; return (tile << 8) + 128 * bj + 32 * (s >> 1) + 16 * (s & 1) + q; }
    if (tile == 3 || tile == 4) { const int z = lc >> 6, bj = (lc >> 5) & 1, q = lc & 31; return (tile << 8) + 128 * bj + 32 * z + q; }
    return n;
}
__device__ __forceinline__ int map_up(int n) { if (n < DFF) return 256 * (n >> 7) + (n & 127); const int c = n - DFF; return 256 * (c >> 7) + 128 + (c & 127); }

template <int MAP> __device__ __forceinline__ void transpose_item(const float* __restrict__ W, int K, int N, bf16_t* __restrict__ WT, LAS float* scr, int item, int lane) {
    const int nblk = N / 32, kb = item / nblk, nb = item % nblk, k0 = 64 * kb, n0 = 32 * nb;
#pragma unroll 8
    for (int i = 0; i < 32; ++i) { const int kk = 2 * i + (lane >> 5); scr[kk * 33 + (lane & 31)] = W[(size_t)(k0 + kk) * N + n0 + (lane & 31)]; }
    LDS_WAIT(); asm volatile("" ::: "memory");
    const int c = lane & 7;
#pragma unroll
    for (int j = 0; j < 4; ++j) { const int n = (lane >> 3) + 8 * j; const LAS float* s = scr + (8 * c) * 33 + n;
        u32x4 o; o.x = pk2(s[0 * 33], s[1 * 33]); o.y = pk2(s[2 * 33], s[3 * 33]); o.z = pk2(s[4 * 33], s[5 * 33]); o.w = pk2(s[6 * 33], s[7 * 33]);
        const int nl = n0 + n; const int row = MAP == 1 ? map_in(nl) : (MAP == 2 ? map_up(nl) : nl);
        *(u32x4*)(WT + (size_t)row * K + k0 + 8 * c) = o; }
    LDS_WAIT(); asm volatile("" ::: "memory");
}

__device__ __forceinline__ void gemv9_item(Frame& F, LAS float* vecs, LAS float* red, const float* __restrict__ W, int ldw, int n0, float* __restrict__ out, int ldo, const float* __restrict__ addb) {
    float acc[9];
#pragma unroll
    for (int v = 0; v < 9; ++v) acc[v] = 0.f;
    const int kb = F.wave * 128;
#pragma unroll 2
    for (int k = 0; k < 128; k += 4) {
        float w[4];
#pragma unroll
        for (int i = 0; i < 4; ++i) w[i] = W[(size_t)(kb + k + i) * ldw + n0 + F.lane];
#pragma unroll
        for (int v = 0; v < 9; ++v) { const f32x4 x = *(const LAS f32x4*)(vecs + v * 1024 + kb + k); acc[v] += x[0] * w[0] + x[1] * w[1] + x[2] * w[2] + x[3] * w[3]; }
    }
#pragma unroll
    for (int v = 0; v < 9; ++v) red[(F.wave * 9 + v) * 64 + F.lane] = acc[v];
    __syncthreads();
    for (int e = F.tid; e < 9 * 64; e += NTHREADS) { const int v = e >> 6, ln = e & 63; float s = 0.f;
#pragma unroll
        for (int w8 = 0; w8 < 8; ++w8) s += red[(w8 * 9 + v) * 64 + ln];
        out[(size_t)v * ldo + n0 + ln] = s + (addb ? addb[n0 + ln] : 0.f); }
    __syncthreads();
}

__device__ const float INVF16[16] = {1.000000000e+00f, 5.623413324e-01f, 3.162277639e-01f, 1.778279394e-01f, 1.000000015e-01f, 5.623413250e-02f, 3.162277490e-02f, 1.778279431e-02f,
                                     9.999999776e-03f, 5.623413250e-03f, 3.162277630e-03f, 1.778279431e-03f, 1.000000047e-03f, 5.623413017e-04f, 3.162277571e-04f, 1.778279402e-04f};
__device__ __forceinline__ void phase_p0a(Frame& F) {
    const float* w_in = F.in_(8); const float* w_out = F.in_(26); const float* w_up = F.in_(27); const float* w_down = F.in_(30);
    bf16_t* WIN = (bf16_t*)(F.ws + WS_WIN); bf16_t* WOUT = (bf16_t*)(F.ws + WS_WOUT); bf16_t* WUP = (bf16_t*)(F.ws + WS_WUP); bf16_t* WDN = (bf16_t*)(F.ws + WS_WDN);
    LAS float* scr = (LAS float*)(F.lds + F.wave * 16384);
    const int gw = F.vcu * NWAVES + F.wave, NGW = F.G * NWAVES;
    constexpr int I_IN = 16 * (DIN / 32), I_OUT = 16 * 32, I_UP = 16 * (2 * DFF / 32), I_DN = (DFF / 64) * 32, I_L = I_IN + I_OUT + I_UP + I_DN;
    for (int it = gw; it < 2 * I_L; it += NGW) {
        const int l = it / I_L; int r = it % I_L;
        if (r < I_IN) { transpose_item<1>(w_in + (size_t)l * D * DIN, D, DIN, WIN + (size_t)l * DINP * D, scr, r, F.lane); continue; } r -= I_IN;
        if (r < I_OUT) { transpose_item<0>(w_out + (size_t)l * DMIX * D, DMIX, D, WOUT + (size_t)l * D * DMIX, scr, r, F.lane); continue; } r -= I_OUT;
        if (r < I_UP) { transpose_item<2>(w_up + (size_t)l * D * 2 * DFF, D, 2 * DFF, WUP + (size_t)l * 2 * DFF * D, scr, r, F.lane); continue; } r -= I_UP;
        transpose_item<0>(w_down + (size_t)l * DFF * D, DFF, D, WDN + (size_t)l * D * DFF, scr, r, F.lane);
    }
    { const int gt = F.vcu * NTHREADS + F.tid, NGT = F.G * NTHREADS; constexpr int PER = (DINP - DIN) * D * 2 / 16;
      for (int e = gt; e < 2 * PER; e += NGT) { const int l = e / PER, o = e % PER; *(u32x4*)((unsigned char*)(WIN + ((size_t)l * DINP + DIN) * D) + (size_t)o * 16) = (u32x4){0u, 0u, 0u, 0u}; } }
    __syncthreads();
    LAS float* vecs = (LAS float*)F.lds; LAS float* red = vecs + 9 * 1024;
    const float* cvec = F.in_(1); const float* cctx = F.in_(3); const float* w_mod = F.in_(4); const float* b_mod = F.in_(5);
    float* MOD = (float*)(F.ws + WS_MOD);
    bool staged = false;
    for (int item = F.bid; item < 2 * 96; item += F.G) {
        if (!staged) { for (int e = F.tid; e < 9 * 1024; e += NTHREADS) { const int v = e >> 10, k = e & 1023; vecs[e] = siluf_(v < 8 ? cvec[v * D + k] : cctx[k]); } __syncthreads(); staged = true; }
        const int l = item / 96, n0 = (item % 96) * 64;
        gemv9_item(F, vecs, red, w_mod + (size_t)l * D * NMOD * D, NMOD * D, n0, MOD + (size_t)l * 9 * NMOD * D, NMOD * D, b_mod + (size_t)l * NMOD * D);
    }
    if (F.bid == F.G - 1) {
        float* tab32 = (float*)(F.ws + WS_TAB); float* tab64 = (float*)(F.ws + WS_TAB64);
        for (int idx = F.tid; idx < 64 * 8 + 64 * 16; idx += NTHREADS) {
            int quarter, pos, fi; float* dst;
            if (idx < 64 * 8) { quarter = 8; pos = idx / 8; fi = idx % 8; dst = tab32 + idx * 2; }
            else { const int j = idx - 64 * 8; quarter = 16; pos = j / 16; fi = j % 16; dst = tab64 + j * 2; }
            const float invf = INVF16[fi * (16 / quarter)];
            const float x = (float)pos * invf;
            const float kf = rintf(x * 0.636619772f); const int kq = (int)kf;
            float r = fmaf(-kf, 1.5703125f, x); r = fmaf(-kf, 4.837512969970703125e-4f, r); r = fmaf(-kf, 7.54978995489188216e-8f, r);
            const float r2 = r * r;
            const float sp = r + r * r2 * (-1.6666654611e-1f + r2 * (8.3321608736e-3f + r2 * (-1.9515295891e-4f)));
            const float cp = 1.0f - 0.5f * r2 + r2 * r2 * (4.166664568298827e-2f + r2 * (-1.388731625493765e-3f + r2 * 2.443315711809948e-5f));
            const int qd = kq & 3;
            const float sv = qd == 0 ? sp : (qd == 1 ? cp : (qd == 2 ? -sp : -cp)), cv = qd == 0 ? cp : (qd == 1 ? -sp : (qd == 2 ? -cp : sp));
            dst[0] = cv; dst[1] = sv;
        }
        float* par = (float*)(F.ws + WS_PAR);
        for (int e = F.tid; e < 2 * 262; e += NTHREADS) { const int l = e / 262, i = e % 262; float v;
            if (i < 32) v = F.in_(9)[l * 32 + i]; else if (i < 64) v = F.in_(10)[l * 32 + i - 32]; else if (i < 128) v = F.in_(16)[l * 64 + i - 64]; else if (i < 192) v = F.in_(17)[l * 64 + i - 128];
            else if (i < 256) v = F.in_(15)[l * 64 + i - 192]; else v = F.in_(18)[l * 6 + i - 256];
            par[l * PAR_STRIDE + i] = v; }
        { float* gn = (float*)(F.ws + WS_GAIN); for (int e = F.tid; e < 4 * D; e += NTHREADS) gn[e] = e < 2 * D ? F.in_(6)[e] : F.in_(7)[e - 2 * D];
          float* fp = (float*)(F.ws + WS_FFNP); for (int e = F.tid; e < 2 * 4 * DFF; e += NTHREADS) { const int l = e / (4 * DFF), i = e % (4 * DFF); fp[e] = i < 3 * DFF ? F.in_(28)[(size_t)l * 3 * DFF + i] : F.in_(29)[(size_t)l * DFF + i - 3 * DFF]; } }
        if (F.tid < 2) {
            const int l = F.tid; const float li = 0.8f - 0.6f * expf(-0.3f * (float)l);
            const float* lq1 = F.in_(11) + l * 32; const float* lk1 = F.in_(12) + l * 32; const float* lq2 = F.in_(13) + l * 32; const float* lk2 = F.in_(14) + l * 32;
            float s1 = 0.f, s2 = 0.f; for (int i = 0; i < 32; ++i) { s1 += lq1[i] * lk1[i]; s2 += lq2[i] * lk2[i]; }
            float mq = 0.f, mk_ = 0.f; for (int i = 0; i < 32; ++i) { mq = fmaxf(mq, fabsf(F.in_(9)[l * 32 + i])); mk_ = fmaxf(mk_, fabsf(F.in_(10)[l * 32 + i])); }
            float nq = 0.f, nk = 0.f; for (int i = 0; i < 64; ++i) { nq = fmaxf(nq, fabsf(F.in_(16)[l * 64 + i])); nk = fmaxf(nk, fabsf(F.in_(17)[l * 64 + i])); }
            float mb = QSB * 64.f * nq * nk; for (int i = 0; i < 6; ++i) mb = fmaxf(mb, F.in_(18)[l * 6 + i] * LOG2E);
            par[l * PAR_STRIDE + PR_LAM] = expf(s1) - expf(s2) + li; par[l * PAR_STRIDE + PR_MA] = QSA * 32.f * mq * mk_; par[l * PAR_STRIDE + PR_MB] = mb; par[l * PAR_STRIDE + PR_LI] = li;
        }
    }
}

__device__ __forceinline__ void phase_p0b(Frame& F) {
    LAS float* vecs = (LAS float*)F.lds; LAS float* red = vecs + 9 * 1024;
    const float* MOD = (const float*)(F.ws + WS_MOD); float* B1 = (float*)(F.ws + WS_BIAS1); float* B2 = (float*)(F.ws + WS_BIAS2);
    const float* w_in = F.in_(8); const float* w_up = F.in_(27);
    constexpr int I1 = DIN / 64, I2 = 2 * DFF / 64, IL = I1 + I2;
    for (int item = F.bid; item < 2 * IL; item += F.G) {
        const int l = item / IL; int r = item % IL; const bool is1 = r < I1; if (!is1) r -= I1;
        __syncthreads();
        for (int e = F.tid; e < 9 * 1024; e += NTHREADS) { const int v = e >> 10, k = e & 1023; vecs[e] = MOD[((size_t)l * 9 + v) * NMOD * D + (is1 ? 0 : 3) * D + k]; }
        __syncthreads();
        if (is1) gemv9_item(F, vecs, red, w_in + (size_t)l * D * DIN, DIN, r * 64, B1 + (size_t)l * 9 * DINP, DINP, nullptr);
        else gemv9_item(F, vecs, red, w_up + (size_t)l * D * 2 * DFF, 2 * DFF, r * 64, B2 + (size_t)l * 9 * 2 * DFF, 2 * DFF, nullptr);
    }
    { const int gt = F.vcu * NTHREADS + F.tid; if (gt < 2 * 9 * (DINP - DIN)) { const int lv = gt / (DINP - DIN), n = gt % (DINP - DIN); B1[(size_t)lv * DINP + DIN + n] = 0.f; } }
    const float* x = F.in_(0); const float* ctx = F.in_(2); const float* g1 = F.in_(6);
    bf16_t* VN = (bf16_t*)(F.ws + WS_VN); float* SS1 = (float*)(F.ws + WS_SS1);
    const int gw = F.vcu * NWAVES + F.wave, NGW = F.G * NWAVES;
    for (int g = gw; g < MALL; g += NGW) {
        const int b = g / RB, r = g % RB; const int v = r < C ? 8 : b;
        const float* src = r < C ? ctx + ((size_t)b * C + r) * D : x + ((size_t)b * T + (r - C)) * D;
        const float* sc = MOD + ((size_t)0 * 9 + v) * NMOD * D + 1 * D;
        float s = 0.f;
#pragma unroll
        for (int j = 0; j < 4; ++j) { const int n = 4 * F.lane + 256 * j; const f32x4 xv = *(const f32x4*)(src + n); const f32x4 gv = *(const f32x4*)(g1 + n); const f32x4 sv = *(const f32x4*)(sc + n);
            s += xv[0] * xv[0] + xv[1] * xv[1] + xv[2] * xv[2] + xv[3] * xv[3];
            u32x2 o; o.x = pk2(xv[0] * gv[0] * (1.f + sv[0]), xv[1] * gv[1] * (1.f + sv[1])); o.y = pk2(xv[2] * gv[2] * (1.f + sv[2]), xv[3] * gv[3] * (1.f + sv[3]));
            *(u32x2*)(VN + (size_t)g * D + n) = o; }
#pragma unroll
        for (int o = 1; o < 64; o <<= 1) s += __shfl_xor(s, o);
        if (F.lane == 0) *(f32x4*)(SS1 + (size_t)g * 4) = (f32x4){s, 0.f, 0.f, 0.f};
    }
}

struct Order {
    pg8::StaticOrder so; int latent_only;
    __device__ __forceinline__ void init(int nMt, int N, int G, int c, int lat) { so.init(nMt * 256, N, G, c); latent_only = lat; }
    __device__ __forceinline__ bool next(int i, Unit& u) const { if (!so.next(i, u)) return false; if (latent_only) u.pm = (u.pm >> 4) * TPB + 1 + (u.pm & 15); return true; }
    __device__ __forceinline__ void a_ready(const Unit&) const {}
    __device__ __forceinline__ void done(const Unit&) const {}
};

struct EpiIn {
    static constexpr bool PERM = false, AFTER_DRAIN = false;
    unsigned char* ws; int l;
    __device__ __forceinline__ void operator()(const f32x4 (&acc)[2][2][4][2], const Unit& u, int wr, int wc, int fr, int fq) const {
        { const int ln = (int)__builtin_amdgcn_mbcnt_hi(~0u, __builtin_amdgcn_mbcnt_lo(~0u, 0u)); fr = ln & 15; fq = ln >> 4; asm volatile("" : "+v"(fr), "+v"(fq)); }
        bf16_t* P = (bf16_t*)(ws + WS_P); const float* SS = (const float*)(ws + WS_SS1); const float* bias = (const float*)(ws + WS_BIAS1) + (size_t)l * 9 * DINP;
        const float* tab32 = (const float*)(ws + WS_TAB); const float* tab64 = (const float*)(ws + WS_TAB64); const float* par = (const float*)(ws + WS_PAR) + l * PAR_STRIDE;
        const float* gq32 = par + PR_GQ32; const float* gk32 = par + PR_GK32; const float* gq64 = par + PR_GQ64; const float* gk64 = par + PR_GK64;
        const int b = u.pm / TPB, j = u.pm % TPB; const bool lat = j != 0; const float* bia = bias + (size_t)(lat ? b : 8) * DINP;
        const int pn = u.pn;
#pragma unroll
        for (int ai = 0; ai < 2; ++ai)
#pragma unroll
            for (int m = 0; m < 4; ++m) {
                const int rloc = ai * 128 + wr * 64 + m * 16 + fr; const size_t g = (size_t)u.pm * 256 + rloc;
                const f32x4 s4 = *(const f32x4*)(SS + g * 4);
                const float rs = 1.0f / sqrtf((s4[0] + s4[1] + s4[2] + s4[3]) * (1.0f / D) + EPS);
                const int t = (j - 1) * 256 + rloc; const int prow = t >> 6, pcol = t & 63;
                bf16_t* prow_p = P + g * DINP;
                if (pn <= 1) {
                    const float* gain = pn == 0 ? gq32 : gk32;
                    const f32x4 g1 = *(const f32x4*)(gain + 4 * fq), g2 = *(const f32x4*)(gain + 16 + 4 * fq);
                    const int pos = fq < 2 ? prow : pcol; const float* tb = tab32 + (pos * 8 + 4 * (fq & 1)) * 2;
#pragma unroll
                    for (int n = 0; n < 2; ++n) {
                        const int col = 256 * pn + 32 * (2 * wc + n) + 4 * fq;
                        f32x4 x1 = acc[ai][0][m][n] * rs + *(const f32x4*)(bia + col), x2 = acc[ai][1][m][n] * rs + *(const f32x4*)(bia + col + 16);
                        float ss = x1[0] * x1[0] + x1[1] * x1[1] + x1[2] * x1[2] + x1[3] * x1[3] + x2[0] * x2[0] + x2[1] * x2[1] + x2[2] * x2[2] + x2[3] * x2[3];
                        ss += __shfl_xor(ss, 16); ss += __shfl_xor(ss, 32);
                        const float ri = 1.0f / sqrtf(ss * (1.0f / 32.f) + EPS);
                        x1 = x1 * ri * g1; x2 = x2 * ri * g2;
                        if (lat) { const f32x4 c01 = *(const f32x4*)(tb), c23 = *(const f32x4*)(tb + 4);
                            const f32x4 cs = (f32x4){c01[0], c01[2], c23[0], c23[2]}, sn = (f32x4){c01[1], c01[3], c23[1], c23[3]};
                            const f32x4 y1 = x1 * cs - x2 * sn, y2 = x1 * sn + x2 * cs; x1 = y1; x2 = y2; }
                        if (pn == 0) { x1 = x1 * QSA; x2 = x2 * QSA; }
                        u32x2 o1, o2; o1.x = pk2(x1[0], x1[1]); o1.y = pk2(x1[2], x1[3]); o2.x = pk2(x2[0], x2[1]); o2.y = pk2(x2[2], x2[3]);
                        *(u32x2*)(prow_p + col) = o1; *(u32x2*)(prow_p + col + 16) = o2;
                    }
                } else if (pn == 3 || pn == 4) {
                    const bool isq = pn == 3 || wc < 2; const float* gain = isq ? gq64 : gk64;
                    const int colb = 256 * pn + 64 * wc;
                    f32x4 xa[2], xb[2]; float ss = 0.f;
#pragma unroll
                    for (int n = 0; n < 2; ++n) { xa[n] = acc[ai][0][m][n] * rs + *(const f32x4*)(bia + colb + 16 * n + 4 * fq); xb[n] = acc[ai][1][m][n] * rs + *(const f32x4*)(bia + colb + 32 + 16 * n + 4 * fq);
                        ss += xa[n][0] * xa[n][0] + xa[n][1] * xa[n][1] + xa[n][2] * xa[n][2] + xa[n][3] * xa[n][3] + xb[n][0] * xb[n][0] + xb[n][1] * xb[n][1] + xb[n][2] * xb[n][2] + xb[n][3] * xb[n][3]; }
                    ss += __shfl_xor(ss, 16); ss += __shfl_xor(ss, 32);
                    const float ri = 1.0f / sqrtf(ss * (1.0f / 64.f) + EPS);
#pragma unroll
                    for (int n = 0; n < 2; ++n) {
                        f32x4 x1 = xa[n] * ri * *(const f32x4*)(gain + 16 * n + 4 * fq), x2 = xb[n] * ri * *(const f32x4*)(gain + 32 + 16 * n + 4 * fq);
                        if (lat) { const float* tb = tab64 + ((n == 0 ? prow : pcol) * 16 + 4 * fq) * 2; const f32x4 c01 = *(const f32x4*)(tb), c23 = *(const f32x4*)(tb + 4);
                            const f32x4 cs = (f32x4){c01[0], c01[2], c23[0], c23[2]}, sn = (f32x4){c01[1], c01[3], c23[1], c23[3]};
                            const f32x4 y1 = x1 * cs - x2 * sn, y2 = x1 * sn + x2 * cs; x1 = y1; x2 = y2; }
                        if (isq) { x1 = x1 * QSB; x2 = x2 * QSB; }
                        u32x2 o1, o2; o1.x = pk2(x1[0], x1[1]); o1.y = pk2(x1[2], x1[3]); o2.x = pk2(x2[0], x2[1]); o2.y = pk2(x2[2], x2[3]);
                        *(u32x2*)(prow_p + colb + 16 * n + 4 * fq) = o1; *(u32x2*)(prow_p + colb + 32 + 16 * n + 4 * fq) = o2;
                    }
                } else {
#pragma unroll
                    for (int bj = 0; bj < 2; ++bj)
#pragma unroll
                        for (int n = 0; n < 2; ++n) { const int col = 256 * pn + 128 * bj + 32 * wc + 16 * n + 4 * fq;
                            if (col < DIN) { const f32x4 x1 = acc[ai][bj][m][n] * rs + *(const f32x4*)(bia + col); u32x2 o; o.x = pk2(x1[0], x1[1]); o.y = pk2(x1[2], x1[3]); *(u32x2*)(prow_p + col) = o; } }
                }
            }
    }
};

__device__ __forceinline__ void phase_p1(Frame& F, int l) {
    pg8::Gemm g{(const bf16_t*)(F.ws + WS_VN), (const bf16_t*)(F.ws + WS_WIN) + (size_t)l * DINP * D, MALL, DINP, D};
    Order S; S.init(NTILE, DINP, F.G, (int)F.bid, 0);
    EpiIn E{F.ws, l};
    pg8::gemm_phase<EpiIn, Order, true, true>(F.lds, g, S, E, F.tid);
}
struct EpiRes {
    static constexpr bool PERM = false, AFTER_DRAIN = false;
    unsigned char* ws; const float* xin; const float* ctxin; float* out; LAS float* red; int l, kind;
    __device__ __forceinline__ void operator()(const f32x4 (&acc)[2][2][4][2], const Unit& u, int wr, int wc, int fr, int fq) const {
        { const int ln = (int)__builtin_amdgcn_mbcnt_hi(~0u, __builtin_amdgcn_mbcnt_lo(~0u, 0u)); fr = ln & 15; fq = ln >> 4; asm volatile("" : "+v"(fr), "+v"(fq)); }
        const float* MOD = (const float*)(ws + WS_MOD);
        const int b = u.pm / TPB, j = u.pm % TPB; const bool lat = j != 0; const int v = lat ? b : 8;
        const float* gate = MOD + ((size_t)l * 9 + v) * NMOD * D + (kind == 0 ? 2 : 5) * D;
        const bool do_vn = kind == 0 || l == 0;
        const float* scp = kind == 0 ? MOD + ((size_t)l * 9 + v) * NMOD * D + 4 * D : MOD + ((size_t)(l + 1) * 9 + v) * NMOD * D + 1 * D;
        const float* gainp = (const float*)(ws + WS_GAIN) + (kind == 0 ? (2 + l) : (l + 1)) * D;
        float* SSd = (float*)(ws + (kind == 0 ? WS_SS2 : WS_SS1));
        bf16_t* VN = (bf16_t*)(ws + WS_VN); float* XC = (float*)(ws + WS_XC);
        const bool first = kind == 0 && l == 0;
        const float* srcb = lat ? (first ? xin : out) + (size_t)b * T * D : (first ? ctxin : XC) + (size_t)b * C * D;
        float* dstb = lat ? out + (size_t)b * T * D : XC + (size_t)b * C * D;
        const int rbase = lat ? (j - 1) * 256 : 0;
#pragma unroll
        for (int ai = 0; ai < 2; ++ai)
#pragma unroll
            for (int m = 0; m < 4; ++m) {
                const int rloc = ai * 128 + wr * 64 + m * 16 + fr; const size_t g = (size_t)u.pm * 256 + rloc; const size_t ro = (size_t)(rbase + rloc) * D;
                float ss = 0.f;
#pragma unroll
                for (int bj = 0; bj < 2; ++bj)
#pragma unroll
                    for (int n = 0; n < 2; ++n) { const int c = 256 * u.pn + 128 * bj + 32 * wc + 16 * n + 4 * fq;
                        const f32x4 xo = *(const f32x4*)(srcb + ro + c); const f32x4 gt = *(const f32x4*)(gate + c);
                        const f32x4 x = xo + gt * acc[ai][bj][m][n];
                        *(f32x4*)(dstb + ro + c) = x;
                        if (do_vn) { const f32x4 gn = *(const f32x4*)(gainp + c); const f32x4 sc = *(const f32x4*)(scp + c); const f32x4 vn = x * gn * (sc + 1.0f);
                            u32x2 o; o.x = pk2(vn[0], vn[1]); o.y = pk2(vn[2], vn[3]); *(u32x2*)(VN + g * D + c) = o;
                            ss += x[0] * x[0] + x[1] * x[1] + x[2] * x[2] + x[3] * x[3]; } }
                if (do_vn) { ss += __shfl_xor(ss, 16); ss += __shfl_xor(ss, 32); if (fq == 0) red[wc * 256 + rloc] = ss; }
            }
        if (do_vn) {
            asm volatile("s_waitcnt lgkmcnt(0)" ::: "memory"); __builtin_amdgcn_s_barrier(); asm volatile("" ::: "memory");
            const int tid = 64 * (4 * wr + wc) + 16 * fq + fr;
            if (tid < 256) SSd[((size_t)u.pm * 256 + tid) * 4 + u.pn] = (red[tid] + red[256 + tid]) + (red[512 + tid] + red[768 + tid]);
        }
    }
};

struct EpiUp {
    static constexpr bool PERM = false, AFTER_DRAIN = false;
    unsigned char* ws; LAS float* ex; int l;
    __device__ __forceinline__ void operator()(const f32x4 (&acc)[2][2][4][2], const Unit& u, int wr, int wc, int fr, int fq) const {
        { const int ln = (int)__builtin_amdgcn_mbcnt_hi(~0u, __builtin_amdgcn_mbcnt_lo(~0u, 0u)); fr = ln & 15; fq = ln >> 4; asm volatile("" : "+v"(fr), "+v"(fq)); }
        const float* SS = (const float*)(ws + WS_SS2); const float* ffp = (const float*)(ws + WS_FFNP) + (size_t)l * 4 * DFF;
        const int b = u.pm / TPB, j = u.pm % TPB; const int v = j != 0 ? b : 8;
        const float* bia = (const float*)(ws + WS_BIAS2) + ((size_t)l * 9 + v) * 2 * DFF;
        bf16_t* U = (bf16_t*)(ws + WS_U); float* SIDE = (float*)(ws + WS_SIDE) + (size_t)u.pm * 6 * DFF;
        const int lane = fr + 16 * fq;
        float rsv[2][4];
#pragma unroll
        for (int ai = 0; ai < 2; ++ai)
#pragma unroll
            for (int m = 0; m < 4; ++m) { const size_t g = (size_t)u.pm * 256 + ai * 128 + wr * 64 + m * 16 + fr; const f32x4 s4 = *(const f32x4*)(SS + g * 4);
                rsv[ai][m] = 1.0f / sqrtf((s4[0] + s4[1] + s4[2] + s4[3]) * (1.0f / D) + EPS); }
#pragma unroll
        for (int ai = 0; ai < 2; ++ai)
#pragma unroll
            for (int n = 0; n < 2; ++n) { const int q = 2 * ai + wr; const int cc = 32 * wc + 16 * n + 4 * fq; const f32x4 b4 = *(const f32x4*)(bia + 128 * u.pn + cc);
                if (fr == 0) *(LAS f32x4*)(ex + (q * 2 + 0) * 128 + cc) = acc[ai][0][0][n] * rsv[ai][0] + b4;
                if (fr == 15) *(LAS f32x4*)(ex + (q * 2 + 1) * 128 + cc) = acc[ai][0][3][n] * rsv[ai][3] + b4; }
        asm volatile("s_waitcnt lgkmcnt(0)" ::: "memory"); __builtin_amdgcn_s_barrier(); asm volatile("" ::: "memory");
        const int srcp = (lane & 48) | ((fr + 15) & 15), srcn = (lane & 48) | ((fr + 1) & 15);
#pragma unroll
        for (int ai = 0; ai < 2; ++ai) {
            const int q = 2 * ai + wr;
#pragma unroll
            for (int n = 0; n < 2; ++n) {
                const int cc = 32 * wc + 16 * n + 4 * fq; const int ch = 128 * u.pn + cc;
                const f32x4 b4 = *(const f32x4*)(bia + ch), bv4 = *(const f32x4*)(bia + DFF + ch);
                const f32x4 w0 = *(const f32x4*)(ffp + ch), w1 = *(const f32x4*)(ffp + DFF + ch), w2 = *(const f32x4*)(ffp + 2 * DFF + ch), fb = *(const f32x4*)(ffp + 3 * DFF + ch);
                f32x4 pb = (f32x4){0.f, 0.f, 0.f, 0.f}, nb = pb;
                if (q > 0) pb = *(const LAS f32x4*)(ex + ((q - 1) * 2 + 1) * 128 + cc);
                if (q < 3) nb = *(const LAS f32x4*)(ex + ((q + 1) * 2 + 0) * 128 + cc);
                f32x4 Gm[4];
#pragma unroll
                for (int m = 0; m < 4; ++m) Gm[m] = acc[ai][0][m][n] * rsv[ai][m] + b4;
#pragma unroll
                for (int m = 0; m < 4; ++m) {
                    const f32x4 sp = (fr == 15 && m > 0) ? Gm[m > 0 ? m - 1 : 0] : Gm[m], sn = (fr == 0 && m < 3) ? Gm[m < 3 ? m + 1 : 3] : Gm[m];
                    f32x4 prev, next;
#pragma unroll
                    for (int e = 0; e < 4; ++e) { prev[e] = __shfl(sp[e], srcp, 64); next[e] = __shfl(sn[e], srcn, 64); }
                    if (m == 0 && fr == 0) prev = pb;
                    if (m == 3 && fr == 15) next = nb;
                    const f32x4 pre = fb + w0 * prev + w1 * Gm[m] + w2 * next;
                    const f32x4 val = acc[ai][1][m][n] * rsv[ai][m] + bv4;
                    f32x4 uu;
#pragma unroll
                    for (int e = 0; e < 4; ++e) uu[e] = pre[e] / (1.0f + __expf(-pre[e])) * val[e];
                    const int rloc = ai * 128 + wr * 64 + m * 16 + fr; const size_t g = (size_t)u.pm * 256 + rloc;
                    u32x2 o; o.x = pk2(uu[0], uu[1]); o.y = pk2(uu[2], uu[3]); *(u32x2*)(U + g * DFF + ch) = o;
                    if (rloc == 0) { *(f32x4*)(SIDE + 0 * DFF + ch) = pre; *(f32x4*)(SIDE + 1 * DFF + ch) = val; *(f32x4*)(SIDE + 2 * DFF + ch) = Gm[m]; }
                    if (rloc == 255) { *(f32x4*)(SIDE + 3 * DFF + ch) = pre; *(f32x4*)(SIDE + 4 * DFF + ch) = val; *(f32x4*)(SIDE + 5 * DFF + ch) = Gm[m]; }
                }
                asm volatile("" ::: "memory");
            }
        }
        asm volatile("s_waitcnt lgkmcnt(0)" ::: "memory"); __builtin_amdgcn_s_barrier(); asm volatile("" ::: "memory");
    }
};

__device__ __forceinline__ void phase_p3(Frame& F, int l) {
    pg8::Gemm g{(const bf16_t*)(F.ws + WS_Y), (const bf16_t*)(F.ws + WS_WOUT) + (size_t)l * D * DMIX, MALL, D, DMIX};
    Order S; S.init(l == 0 ? NTILE : NB * 16, D, F.G, F.bid, l == 0 ? 0 : 1);
    EpiRes E{F.ws, F.in_(0), F.in_(2), F.out, (LAS float*)(F.lds + 131072 + 4096), l, 0};
    pg8::gemm_phase<EpiRes, Order, true, true>(F.lds, g, S, E, F.tid);
}
__device__ __forceinline__ void phase_p4(Frame& F, int l) {
    pg8::Gemm g{(const bf16_t*)(F.ws + WS_VN), (const bf16_t*)(F.ws + WS_WUP) + (size_t)l * 2 * DFF * D, MALL, 2 * DFF, D};
    Order S; S.init(l == 0 ? NTILE : NB * 16, 2 * DFF, F.G, F.bid, l == 0 ? 0 : 1);
    EpiUp E{F.ws, (LAS float*)(F.lds + 131072), l};
    pg8::gemm_phase<EpiUp, Order, true, true>(F.lds, g, S, E, F.tid);
}
__device__ __forceinline__ void phase_p5(Frame& F, int l) {
    Order S; S.init(l == 0 ? NTILE : NB * 16, D, F.G, F.bid, l == 0 ? 0 : 1);
    { const float* SIDE = (const float*)(F.ws + WS_SIDE); const float* ffp = (const float*)(F.ws + WS_FFNP) + (size_t)l * 4 * DFF; bf16_t* U = (bf16_t*)(F.ws + WS_U);
      Unit u;
      for (int i = 0; S.next(i, u); ++i) { const int pm = u.pm, j = pm % TPB;
          for (int ch = F.tid; ch < DFF; ch += NTHREADS) {
              if (j >= 2) { const float pre = SIDE[((size_t)pm * 6 + 0) * DFF + ch] + ffp[ch] * SIDE[((size_t)(pm - 1) * 6 + 5) * DFF + ch];
                  U[(size_t)pm * 256 * DFF + ch] = (bf16_t)f2bf(pre / (1.0f + __expf(-pre)) * SIDE[((size_t)pm * 6 + 1) * DFF + ch]); }
              if (j >= 1 && j <= 15) { const float pre = SIDE[((size_t)pm * 6 + 3) * DFF + ch] + ffp[2 * DFF + ch] * SIDE[((size_t)(pm + 1) * 6 + 2) * DFF + ch];
                  U[((size_t)pm * 256 + 255) * DFF + ch] = (bf16_t)f2bf(pre / (1.0f + __expf(-pre)) * SIDE[((size_t)pm * 6 + 4) * DFF + ch]); }
          } }
      asm volatile("s_waitcnt vmcnt(0)" ::: "memory"); __syncthreads(); }
    pg8::Gemm g{(const bf16_t*)(F.ws + WS_U), (const bf16_t*)(F.ws + WS_WDN) + (size_t)l * D * DFF, MALL, D, DFF};
    EpiRes E{F.ws, F.in_(0), F.in_(2), F.out, (LAS float*)(F.lds + 131072 + 4096), l, 1};
    pg8::gemm_phase<EpiRes, Order, true, true>(F.lds, g, S, E, F.tid);
}
typedef short bf16x8 __attribute__((ext_vector_type(8)));
typedef short s16x4 __attribute__((ext_vector_type(4)));
typedef float f32x16 __attribute__((ext_vector_type(16)));
typedef float f32x2_t __attribute__((ext_vector_type(2))); typedef __bf16 bf16x2_t __attribute__((ext_vector_type(2)));
__device__ __forceinline__ unsigned cvtpk(float lo, float hi) { f32x2_t v = {lo, hi}; bf16x2_t b = __builtin_convertvector(v, bf16x2_t); return __builtin_bit_cast(unsigned, b); }
__device__ __forceinline__ int crow(int r, int hi) { return (r & 3) + 8 * (r >> 2) + 4 * hi; }
typedef short v4i16_t __attribute__((ext_vector_type(4)));
__device__ __forceinline__ s16x4 vtr(const LAS unsigned char* p) { return __builtin_bit_cast(s16x4, __builtin_amdgcn_ds_read_tr16_b64_v4i16((LAS v4i16_t*)p)); }

constexpr int ATT_KV_BYTES = 8192;
__device__ __forceinline__ void att_stage(const bf16_t* Krow0, const bf16_t* Vrow0, LAS unsigned char* kbuf, LAS unsigned char* vbuf, int wave, int lane) {
    const bf16_t* ks = Krow0 + (size_t)lane * DINP + wave * 8;
    const bf16_t* vs = Vrow0 + (size_t)(16 * (wave & 3) + (lane >> 2)) * DINP + (wave >> 2) * 32 + (lane & 3) * 8;
    __builtin_amdgcn_global_load_lds((const unsigned*)ks, (LAS unsigned*)(kbuf + wave * 1024), 16, 0, 0);
    __builtin_amdgcn_global_load_lds((const unsigned*)vs, (LAS unsigned*)(vbuf + wave * 1024), 16, 0, 0);
}
template <int NK> __device__ __forceinline__ f32x16 att_qk(const LAS unsigned char* kbuf, int d0, int kh, const bf16x8* qr, f32x16 cinit, int r32, int hi) {
    f32x16 s = cinit;
#pragma unroll
    for (int i = 0; i < NK; ++i) { const bf16x8 kf = *(const LAS bf16x8*)(kbuf + (2 * (d0 + i) + hi) * 1024 + (kh * 32 + r32) * 16); s = __builtin_amdgcn_mfma_f32_32x32x16_bf16(kf, qr[i], s, 0, 0, 0); }
    return s;
}
__device__ __forceinline__ bf16x8 att_vfrag(const LAS unsigned char* vbuf, int dh, int ks, int lane, int hi) {
    const LAS unsigned char* p = vbuf + (dh * 4 + ks) * 1024 + ((lane >> 4) & 1) * 32 + (lane & 3) * 8 + (4 * hi + ((lane & 15) >> 2)) * 64;
    const s16x4 lo = vtr(p), hh = vtr(p + 512);
    return (bf16x8){lo[0], lo[1], lo[2], lo[3], hh[0], hh[1], hh[2], hh[3]};
}
__device__ __forceinline__ float half_swap_sum(float v) { return v + __shfl_xor(v, 32); }

__device__ __forceinline__ void da_unit(Frame& F, int l, int b, int h, int q0, int nkeys) {
    int lane_ = (int)__builtin_amdgcn_mbcnt_hi(~0u, __builtin_amdgcn_mbcnt_lo(~0u, 0u)); asm volatile("" : "+v"(lane_));
    const int lane = lane_, wave = F.wave, r32 = lane & 31, hi = lane >> 5;
    const bf16_t* P = (const bf16_t*)(F.ws + WS_P) + (size_t)b * RB * DINP;
    const float* par = (const float*)(F.ws + WS_PAR) + l * PAR_STRIDE;
    LAS unsigned char* kb0 = F.lds; LAS unsigned char* vb0 = F.lds + 2 * ATT_KV_BYTES;
    LAS float* wsf = (LAS float*)(F.lds + 4 * ATT_KV_BYTES) + wave * 128;
    const bf16_t* Kp = P + O_AK + h * 64; const bf16_t* Vp = P + O_AV + h * 64;
    const int NT = nkeys / 64;
    att_stage(Kp, Vp, kb0, vb0, wave, lane);
    bf16x8 qr[4];
#pragma unroll
    for (int d0 = 0; d0 < 4; ++d0) qr[d0] = *(const bf16x8*)(P + (size_t)(q0 + wave * 32 + r32) * DINP + O_AQ + h * 64 + d0 * 16 + hi * 8);
    const float negM = -par[PR_MA];
    f32x16 cinit;
#pragma unroll
    for (int r = 0; r < 16; ++r) cinit[r] = negM;
    f32x16 o[2][2];
#pragma unroll
    for (int m = 0; m < 2; ++m)
#pragma unroll
        for (int dh = 0; dh < 2; ++dh)
#pragma unroll
            for (int r = 0; r < 16; ++r) o[m][dh][r] = 0.f;
    float lsum[2] = {0.f, 0.f};
    asm volatile("s_waitcnt vmcnt(0)" ::: "memory"); __syncthreads();
    for (int t = 0; t < NT; ++t) {
        const int cur = t & 1;
        if (t + 1 < NT) att_stage(Kp + (size_t)(t + 1) * 64 * DINP, Vp + (size_t)(t + 1) * 64 * DINP, kb0 + (cur ^ 1) * ATT_KV_BYTES, vb0 + (cur ^ 1) * ATT_KV_BYTES, wave, lane);
        const LAS unsigned char* kb = kb0 + cur * ATT_KV_BYTES; const LAS unsigned char* vb = vb0 + cur * ATT_KV_BYTES;
        unsigned pw[2][4][4];
#pragma unroll
        for (int m = 0; m < 2; ++m)
#pragma unroll
            for (int kh = 0; kh < 2; ++kh) {
                f32x16 s = att_qk<2>(kb, 2 * m, kh, qr + 2 * m, cinit, r32, hi);
                float acc = 0.f;
#pragma unroll
                for (int r = 0; r < 16; ++r) { s[r] = __builtin_amdgcn_exp2f(s[r]); acc += s[r]; }
                lsum[m] += acc;
#pragma unroll
                for (int i = 0; i < 4; ++i) { pw[m][2 * kh][i] = cvtpk(s[2 * i], s[2 * i + 1]); pw[m][2 * kh + 1][i] = cvtpk(s[8 + 2 * i], s[8 + 2 * i + 1]); }
                __builtin_amdgcn_sched_barrier(0);
            }
#pragma unroll
        for (int dh = 0; dh < 2; ++dh)
#pragma unroll
            for (int ks = 0; ks < 4; ++ks) {
                const bf16x8 vf = att_vfrag(vb, dh, ks, lane, hi);
#pragma unroll
                for (int m = 0; m < 2; ++m) { const u32x4 pa = (u32x4){pw[m][ks][0], pw[m][ks][1], pw[m][ks][2], pw[m][ks][3]};
                    o[m][dh] = __builtin_amdgcn_mfma_f32_32x32x16_bf16(__builtin_bit_cast(bf16x8, pa), vf, o[m][dh], 0, 0, 0); }
            }
        asm volatile("s_waitcnt vmcnt(0)" ::: "memory"); __syncthreads();
    }
    const float lam = par[PR_LAM], li = par[PR_LI];
    lsum[0] = half_swap_sum(lsum[0]); lsum[1] = half_swap_sum(lsum[1]);
    if (hi == 0) { wsf[r32] = 1.0f / lsum[0]; wsf[32 + r32] = lam / lsum[1]; }
    LDS_WAIT();
    float ss[16];
#pragma unroll
    for (int r = 0; r < 16; ++r) { const int row = crow(r, hi); const float i0 = wsf[row], i1 = wsf[32 + row];
        float sq = 0.f;
#pragma unroll
        for (int dh = 0; dh < 2; ++dh) { const float v = o[0][dh][r] * i0 - o[1][dh][r] * i1; o[0][dh][r] = v; sq += v * v; }
        ss[r] = sq; }
#pragma unroll
    for (int sh = 1; sh < 32; sh <<= 1)
#pragma unroll
        for (int r = 0; r < 16; ++r) ss[r] += __shfl_xor(ss[r], sh);
    bf16_t* Y = (bf16_t*)(F.ws + WS_Y) + ((size_t)b * RB + q0 + wave * 32) * D + h * 64;
#pragma unroll
    for (int dh = 0; dh < 2; ++dh) { const float gsc = par[PR_SUBG + 32 * dh + r32] * (1.0f - li);
#pragma unroll
        for (int r = 0; r < 16; ++r) { const float rs = 1.0f / sqrtf(ss[r] * (1.0f / 64.f) + EPS);
            Y[(size_t)crow(r, hi) * D + 32 * dh + r32] = (bf16_t)f2bf(o[0][dh][r] * rs * gsc); } }
    __syncthreads();
}

__device__ __forceinline__ void sw_unit(Frame& F, int l, int b, int kv, int q0, int g) {
    int lane_ = (int)__builtin_amdgcn_mbcnt_hi(~0u, __builtin_amdgcn_mbcnt_lo(~0u, 0u)); asm volatile("" : "+v"(lane_));
    const int lane = lane_, wave = F.wave, r32 = lane & 31, hi = lane >> 5;
    const bf16_t* P = (const bf16_t*)(F.ws + WS_P) + (size_t)b * RB * DINP;
    const float* par = (const float*)(F.ws + WS_PAR) + l * PAR_STRIDE;
    LAS unsigned char* kb0 = F.lds; LAS unsigned char* vb0 = F.lds + 2 * ATT_KV_BYTES;
    LAS float* wsf = (LAS float*)(F.lds + 4 * ATT_KV_BYTES) + wave * 128;
    const bf16_t* Kp = P + O_BK + kv * 64; const bf16_t* Vp = P + O_BV + kv * 64;
    const bool lat = q0 != 0;
    const int pos0 = q0 - C;
    const int band_lo = lat ? (pos0 - 128 < 0 ? 0 : pos0 - 128) : 0, band_hi = lat ? (pos0 + 384 > T ? T : pos0 + 384) : 0;
    const int NT = 4 + (band_hi - band_lo) / 64;
    const int qpos = pos0 + wave * 32 + r32;
    att_stage(Kp, Vp, kb0, vb0, wave, lane);
    bf16x8 qr[4];
#pragma unroll
    for (int d0 = 0; d0 < 4; ++d0) qr[d0] = *(const bf16x8*)(P + (size_t)(q0 + wave * 32 + r32) * DINP + O_BQ + (kv * 3 + g) * 64 + d0 * 16 + hi * 8);
    const float negM = -par[PR_MB];
    f32x16 cinit;
#pragma unroll
    for (int r = 0; r < 16; ++r) cinit[r] = negM;
    f32x16 o[2];
    float lsum = hi == 0 ? __builtin_amdgcn_exp2f(par[PR_SINK + kv * 3 + g] * LOG2E + negM) : 0.f;
#pragma unroll
    for (int dh = 0; dh < 2; ++dh)
#pragma unroll
        for (int r = 0; r < 16; ++r) o[dh][r] = 0.f;
    asm volatile("s_waitcnt vmcnt(0)" ::: "memory"); __syncthreads();
    for (int t = 0; t < NT; ++t) {
        const int cur = t & 1;
        if (t + 1 < NT) { const int nr = (t + 1 < 4) ? (t + 1) * 64 : C + band_lo + (t + 1 - 4) * 64;
            att_stage(Kp + (size_t)nr * DINP, Vp + (size_t)nr * DINP, kb0 + (cur ^ 1) * ATT_KV_BYTES, vb0 + (cur ^ 1) * ATT_KV_BYTES, wave, lane); }
        const LAS unsigned char* kb = kb0 + cur * ATT_KV_BYTES; const LAS unsigned char* vb = vb0 + cur * ATT_KV_BYTES;
        const int kpos0 = band_lo + (t - 4) * 64;
        const int wlo = pos0 + wave * 32 - 128, whi = pos0 + wave * 32 + 31 + 128;
        const bool band = t >= 4;
        const bool active = !band || (kpos0 + 63 >= wlo && kpos0 <= whi);
        if (active) {
            const bool need_mask = band && (kpos0 < wlo + 31 || kpos0 + 63 > whi - 31);
            {
                unsigned pw[4][4];
#pragma unroll
                for (int kh = 0; kh < 2; ++kh) {
                    f32x16 s = att_qk<4>(kb, 0, kh, qr, cinit, r32, hi);
                    float acc = 0.f;
#pragma unroll
                    for (int r = 0; r < 16; ++r) { float p = __builtin_amdgcn_exp2f(s[r]);
                        if (need_mask) { const int d = qpos - (kpos0 + kh * 32 + crow(r, hi)); p = (d > 128 || d < -128) ? 0.f : p; }
                        s[r] = p; acc += p; }
                    lsum += acc;
#pragma unroll
                    for (int i = 0; i < 4; ++i) { pw[2 * kh][i] = cvtpk(s[2 * i], s[2 * i + 1]); pw[2 * kh + 1][i] = cvtpk(s[8 + 2 * i], s[8 + 2 * i + 1]); }
                }
#pragma unroll
                for (int dh = 0; dh < 2; ++dh)
#pragma unroll
                    for (int ks = 0; ks < 4; ++ks) { const bf16x8 vf = att_vfrag(vb, dh, ks, lane, hi); const u32x4 pa = (u32x4){pw[ks][0], pw[ks][1], pw[ks][2], pw[ks][3]};
                        o[dh] = __builtin_amdgcn_mfma_f32_32x32x16_bf16(__builtin_bit_cast(bf16x8, pa), vf, o[dh], 0, 0, 0); }
            }
        }
        asm volatile("s_waitcnt vmcnt(0)" ::: "memory"); __syncthreads();
    }
    { const float lt = half_swap_sum(lsum); if (hi == 0) wsf[r32] = 1.0f / lt; }
    LDS_WAIT();
    bf16_t* Y = (bf16_t*)(F.ws + WS_Y) + ((size_t)b * RB + q0 + wave * 32) * D + 256 + kv * 192;
#pragma unroll
    for (int r = 0; r < 16; ++r) { const int row = crow(r, hi); const float il = wsf[row];
#pragma unroll
        for (int dh = 0; dh < 2; ++dh) Y[(size_t)row * D + g * 64 + 32 * dh + r32] = (bf16_t)f2bf(o[dh][r] * il); }
    __syncthreads();
}

constexpr int LRU_XS = 0, LRU_XCB = 67584, LRU_WT = LRU_XCB + 32768, LRU_EXC = LRU_WT + 16384, LRU_HIN = LRU_EXC + 4096;
__device__ __forceinline__ void lru_item(Frame& F, int l, int pm, int hb, int stage) {
    int lane_ = (int)__builtin_amdgcn_mbcnt_hi(~0u, __builtin_amdgcn_mbcnt_lo(~0u, 0u)); asm volatile("" : "+v"(lane_));
    const int lane = lane_, wave = F.wave, tid = wave * 64 + lane, r32 = lane & 31, hi = lane >> 5;
    const int b = pm / TPB, j = pm % TPB; const int L = j == 0 ? C : T, t0 = j == 0 ? 0 : (j - 1) * 256;
    const bf16_t* P = (const bf16_t*)(F.ws + WS_P) + (size_t)pm * 256 * DINP;
    LAS float* XS = (LAS float*)(F.lds + LRU_XS); LAS unsigned short* XCb = (LAS unsigned short*)(F.lds + LRU_XCB); LAS unsigned short* WT = (LAS unsigned short*)(F.lds + LRU_WT);
    LAS float* EXC = (LAS float*)(F.lds + LRU_EXC); LAS float* HIN = (LAS float*)(F.lds + LRU_HIN);
    float* SUM = (float*)(F.ws + WS_LRU);
    for (int e = tid; e < 262 * 8; e += NTHREADS) { const int row = e >> 3, cc = e & 7; const int rl = row - 3, tt = t0 + rl;
        f32x4 lo = (f32x4){0.f, 0.f, 0.f, 0.f}, hh = lo;
        if (tt >= 0 && tt < L) { const u32x4 v = *(const u32x4*)(P + (ptrdiff_t)rl * DINP + O_CX + 64 * hb + 8 * cc);
            lo = (f32x4){__builtin_bit_cast(float, v.x << 16), __builtin_bit_cast(float, v.x & 0xffff0000u), __builtin_bit_cast(float, v.y << 16), __builtin_bit_cast(float, v.y & 0xffff0000u)};
            hh = (f32x4){__builtin_bit_cast(float, v.z << 16), __builtin_bit_cast(float, v.z & 0xffff0000u), __builtin_bit_cast(float, v.w << 16), __builtin_bit_cast(float, v.w & 0xffff0000u)}; }
        *(LAS f32x4*)(XS + row * 64 + 8 * cc) = lo; *(LAS f32x4*)(XS + row * 64 + 8 * cc + 4) = hh; }
    if (stage == 1 && tid < 128) { const int d = tid >> 6, ch = tid & 63; const int pm0 = b * TPB; float h = 0.f;
        if (d == 0) { for (int jj = 0; jj < j; ++jj) { const float* s = SUM + (((size_t)(pm0 + jj) * 2 + 0) * LW + 64 * hb + ch) * 2; h = s[0] * h + s[1]; } }
        else if (j != 0) { { const float* s = SUM + (((size_t)pm0 * 2 + 1) * LW + 64 * hb + ch) * 2; h = s[1]; }
            for (int jj = 16; jj > j; --jj) { const float* s = SUM + (((size_t)(pm0 + jj) * 2 + 1) * LW + 64 * hb + ch) * 2; h = s[0] * h + s[1]; } }
        HIN[tid] = h; }
    f32x16 Hf[2];
#pragma unroll
    for (int d = 0; d < 2; ++d) {
        __syncthreads();
        const float* cw = F.in_(19) + ((size_t)(l * 2 + d) * 4) * LW + 64 * hb; const float* cb = F.in_(20) + (size_t)(l * 2 + d) * LW + 64 * hb;
        { const float* wa = F.in_(21) + (size_t)((l * 2 + d) * 6 + hb) * 4096; const float* wx = F.in_(23) + (size_t)((l * 2 + d) * 6 + hb) * 4096;
          for (int e = tid; e < 8192; e += NTHREADS) { const int which = e >> 12, i = (e >> 6) & 63, o = e & 63; WT[(which * 64 + o) * 64 + i] = (unsigned short)f2bf((which ? wx : wa)[i * 64 + o]); } }
        { const int c = tid & 63; const float w0 = cw[0 * LW + c], w1 = cw[1 * LW + c], w2 = cw[2 * LW + c], w3 = cw[3 * LW + c], bb = cb[c];
          for (int i = 0; i < 32; ++i) { const int rl = (tid >> 6) + 8 * i; const LAS float* x = XS + (rl + 3) * 64 + c;
              const float v = d == 0 ? bb + w0 * x[-3 * 64] + w1 * x[-2 * 64] + w2 * x[-1 * 64] + w3 * x[0] : bb + w0 * x[3 * 64] + w1 * x[2 * 64] + w2 * x[1 * 64] + w3 * x[0];
              XCb[rl * 64 + c] = (unsigned short)f2bf(v); } }
        __syncthreads();
        f32x16 acc[4];
#pragma unroll
        for (int nt = 0; nt < 4; ++nt)
#pragma unroll
            for (int r = 0; r < 16; ++r) acc[nt][r] = 0.f;
#pragma unroll
        for (int ks = 0; ks < 4; ++ks) { const bf16x8 af = *(const LAS bf16x8*)((const LAS unsigned char*)XCb + (wave * 32 + r32) * 128 + (16 * ks + 8 * hi) * 2);
#pragma unroll
            for (int nt = 0; nt < 4; ++nt) { const bf16x8 bf = *(const LAS bf16x8*)((const LAS unsigned char*)WT + (32 * nt + r32) * 128 + (16 * ks + 8 * hi) * 2);
                acc[nt] = __builtin_amdgcn_mfma_f32_32x32x16_bf16(af, bf, acc[nt], 0, 0, 0); } }
#pragma unroll
        for (int chh = 0; chh < 2; ++chh) { const int ch = 32 * chh + r32; const int gch = (l * 2 + d) * LW + 64 * hb + ch;
            const float ba = F.in_(22)[gch], bx = F.in_(24)[gch], lp = F.in_(25)[gch];
            const float sp = lp > 0.f ? log1pf(__expf(-lp)) : -lp + log1pf(__expf(lp));
            const float w0 = cw[0 * LW + ch], w1 = cw[1 * LW + ch], w2 = cw[2 * LW + ch], w3 = cw[3 * LW + ch], bb = cb[ch];
#pragma unroll
            for (int r = 0; r < 16; ++r) { const int rl = wave * 32 + crow(r, hi); const LAS float* x = XS + (rl + 3) * 64 + ch;
                const float xc = d == 0 ? bb + w0 * x[-3 * 64] + w1 * x[-2 * 64] + w2 * x[-1 * 64] + w3 * x[0] : bb + w0 * x[3 * 64] + w1 * x[2 * 64] + w2 * x[1 * 64] + w3 * x[0];
                const float rg = 1.0f / (1.0f + __expf(-(acc[chh][r] + ba))), ig = 1.0f / (1.0f + __expf(-(acc[2 + chh][r] + bx)));
                const float av = __expf(-8.0f * rg * sp);
                acc[chh][r] = av; acc[2 + chh][r] = sqrtf(fmaxf(1.0f - av * av, 0.f)) * (ig * xc); } }
#pragma unroll
        for (int chh = 0; chh < 2; ++chh) {
            float sA[4], sB[4], pA[4], pB[4];
#pragma unroll
            for (int q = 0; q < 4; ++q) { float A_ = 1.f, B_ = 0.f;
#pragma unroll
                for (int e = 0; e < 4; ++e) { const int r = 4 * q + (d == 0 ? e : 3 - e); B_ = acc[chh][r] * B_ + acc[2 + chh][r]; A_ *= acc[chh][r]; }
                sA[q] = A_; sB[q] = B_; }
#pragma unroll
            for (int q = 0; q < 4; ++q) { pA[q] = __shfl_xor(sA[q], 32); pB[q] = __shfl_xor(sB[q], 32); }
            float blkA = 1.f, blkH = 0.f;
#pragma unroll
            for (int k = 0; k < 8; ++k) { const int s = d == 0 ? k : 7 - k; const int q = s >> 1; const bool own = (s & 1) == hi;
                const float A_ = own ? sA[q] : pA[q], B_ = own ? sB[q] : pB[q]; blkH = A_ * blkH + B_; blkA *= A_; }
            if (hi == 0) { EXC[(wave * 64 + 32 * chh + r32) * 2] = blkA; EXC[(wave * 64 + 32 * chh + r32) * 2 + 1] = blkH; }
        }
        LDS_WAIT(); __syncthreads();
#pragma unroll
        for (int chh = 0; chh < 2; ++chh) { const int ch = 32 * chh + r32;
            float h = stage == 1 ? HIN[d * 64 + ch] : 0.f;
            float totA = 1.f, totH = 0.f;
#pragma unroll
            for (int k = 0; k < 8; ++k) { const int w = d == 0 ? k : 7 - k; const float A_ = EXC[(w * 64 + ch) * 2], H_ = EXC[(w * 64 + ch) * 2 + 1];
                const bool before = d == 0 ? (w < wave) : (w > wave);
                if (before) h = A_ * h + H_;
                totH = A_ * totH + H_; totA *= A_; }
            if (stage == 0) { if (wave == 0 && hi == 0) { float* s = SUM + (((size_t)pm * 2 + d) * LW + 64 * hb + ch) * 2; s[0] = totA; s[1] = totH; } }
            else {
                float sA[4], sB[4], pA[4], pB[4];
#pragma unroll
                for (int q = 0; q < 4; ++q) { float A_ = 1.f, B_ = 0.f;
#pragma unroll
                    for (int e = 0; e < 4; ++e) { const int r = 4 * q + (d == 0 ? e : 3 - e); B_ = acc[chh][r] * B_ + acc[2 + chh][r]; A_ *= acc[chh][r]; }
                    sA[q] = A_; sB[q] = B_; }
#pragma unroll
                for (int q = 0; q < 4; ++q) { pA[q] = __shfl_xor(sA[q], 32); pB[q] = __shfl_xor(sB[q], 32); }
                float hq[4];
#pragma unroll
                for (int k = 0; k < 8; ++k) { const int s = d == 0 ? k : 7 - k; const int q = s >> 1; const bool own = (s & 1) == hi;
                    if (own) hq[q] = h;
                    const float A_ = own ? sA[q] : pA[q], B_ = own ? sB[q] : pB[q]; h = A_ * h + B_; }
#pragma unroll
                for (int q = 0; q < 4; ++q) { float hh = hq[q];
#pragma unroll
                    for (int e = 0; e < 4; ++e) { const int r = 4 * q + (d == 0 ? e : 3 - e); hh = acc[chh][r] * hh + acc[2 + chh][r]; acc[2 + chh][r] = hh; } }
                if (d == 0) Hf[chh] = acc[2 + chh];
                else {
                    bf16_t* Y = (bf16_t*)(F.ws + WS_Y) + (size_t)pm * 256 * D + 640 + 64 * hb + ch;
#pragma unroll
                    for (int r = 0; r < 16; ++r) { const int rl = wave * 32 + crow(r, hi);
                        const float g = bf2f(P[(size_t)rl * DINP + O_CG + 64 * hb + ch]);
                        const float u = 0.7978845608028654f * (g + 0.044715f * g * g * g);
                        const float ge = g / (1.0f + __expf(-2.0f * u));
                        Y[(size_t)rl * D] = (bf16_t)f2bf((Hf[chh][r] + acc[2 + chh][r]) * ge); }
                }
            }
        }
    }
    __syncthreads();
}

__device__ __forceinline__ void unit_map16(const Frame& F, int u, int& gi, int& sub) {
    if (F.G == 256) { const int bid = u & 255, rnd = u >> 8, x = bid & 7, k = bid >> 3; gi = rnd * 16 + 2 * x + (k >> 4); sub = k & 15; }
    else { gi = u >> 4; sub = u & 15; }
}
__device__ __forceinline__ void phase_p2a(Frame& F, int l) {
    for (int it = F.bid; it < NTILE * 6; it += F.G) lru_item(F, l, it / 6, it % 6, 0);
    for (int u = F.bid; u < NB * 2 * 16; u += F.G) { int gi, pb; unit_map16(F, u, gi, pb); for (int g = 0; g < 3; ++g) sw_unit(F, l, gi >> 1, gi & 1, C + pb * 256, g); }
    if (l == 0) for (int u = F.bid; u < NB * 2; u += F.G) for (int g = 0; g < 3; ++g) sw_unit(F, l, u >> 1, u & 1, 0, g);
}
__device__ __forceinline__ void phase_p2b(Frame& F, int l) {
    for (int it = F.bid; it < NTILE * 6; it += F.G) { const int pm = it / 6; if (l == 1 && pm % TPB == 0) continue; lru_item(F, l, pm, it % 6, 1); }
    for (int u = F.bid; u < NB * 4 * 16; u += F.G) { int gi, qb; unit_map16(F, u, gi, qb); da_unit(F, l, gi >> 2, gi & 3, C + qb * 256, RB); }
    if (l == 0) for (int u = F.bid; u < NB * 4; u += F.G) da_unit(F, l, u >> 2, u & 3, 0, C);
}
#define XB_TMO      128
#define XB_XCNT(j)  (256  + 64 * (j))
#define XB_XSUB(j)  (1280 + 64 * (j))
#define XB_XGEN(j)  (2304 + 64 * (j))
#define XB_TOP      3328
#define XB_TOPGEN   3392
#define XCD_BAR_WORDS 3456
#define XB_SPIN_CAP (1u << 18)

__device__ __forceinline__ unsigned xb_ld(unsigned* p)              { return __hip_atomic_load(p, __ATOMIC_RELAXED, __HIP_MEMORY_SCOPE_AGENT); }
__device__ __forceinline__ unsigned xb_add(unsigned* p, unsigned v) { return __hip_atomic_fetch_add(p, v, __ATOMIC_RELAXED, __HIP_MEMORY_SCOPE_AGENT); }
__device__ __forceinline__ unsigned xb_xcc_id() { return (unsigned)__builtin_amdgcn_s_getreg((3 << 11) | 20) & 0xFu; }
#define XB_SPIN(cond, bar) do { unsigned _sp = 0; while (cond) { __builtin_amdgcn_s_sleep(1); \
    if ((++_sp & 255u) == 0u) { if (xb_ld(&(bar)[XB_TMO])) break; if (_sp > XB_SPIN_CAP) { atomicAdd(&(bar)[XB_TMO], 1u); break; } } } } while (0)

struct XcdBarrier {
    unsigned* bar; unsigned x;
    volatile LAS unsigned* st;
};

__device__ __forceinline__ XcdBarrier xcd_barrier_post(unsigned* bar, volatile LAS unsigned* st, int tid) {
    XcdBarrier b; b.bar = bar; b.x = xb_xcc_id(); b.st = st;
    if (tid == 0) (void)xb_add(&bar[XB_XCNT(b.x)], 1u);
    return b;
}
__device__ __forceinline__ void xcd_barrier_complete(unsigned* bar, unsigned x, unsigned& nloc, unsigned& nx) {
    const unsigned G = gridDim.x * gridDim.y * gridDim.z;
    unsigned sum, cnt, mine, sp = 0u;
    for (;;) {
        sum = 0u; cnt = 0u; mine = 0u;
#pragma unroll
        for (unsigned j = 0; j < 16; ++j) { const unsigned c = xb_ld(&bar[XB_XCNT(j)]); sum += c; cnt += (c > 0u) ? 1u : 0u; mine = (j == x) ? c : mine; }
        if (sum == G) break;
        __builtin_amdgcn_s_sleep(1);
        if ((++sp & 255u) == 0u) { if (xb_ld(&bar[XB_TMO])) break; if (sp > XB_SPIN_CAP) { atomicAdd(&bar[XB_TMO], 1u); break; } }
    }
    nloc = mine > 0u ? mine : 1u; nx = cnt > 0u ? cnt : 1u;
}

__device__ __forceinline__ void xcd_barrier(const XcdBarrier& b, int tid) {
    asm volatile("s_waitcnt vmcnt(0)" ::: "memory");
    __syncthreads();
    if (tid == 0) {
        unsigned* bar = b.bar;
        __builtin_amdgcn_s_waitcnt(0);
        unsigned nloc = b.st[0], nx = b.st[1];
        if (nloc == 0u) { xcd_barrier_complete(bar, b.x, nloc, nx); b.st[0] = nloc; b.st[1] = nx; }
        const unsigned old = xb_add(&bar[XB_XSUB(b.x)], 1u);
        const unsigned gen = old / nloc;
        if (old + 1u == (gen + 1u) * nloc) {
            __builtin_amdgcn_fence(__ATOMIC_RELEASE, "agent");
            asm volatile("s_waitcnt vmcnt(0)" ::: "memory");
            const unsigned og = xb_add(&bar[XB_TOP], 1u);
            const unsigned tg = og / nx;
            if (og + 1u == (tg + 1u) * nx) xb_add(&bar[XB_TOPGEN], 1u);
            else XB_SPIN(xb_ld(&bar[XB_TOPGEN]) == tg, bar);
            __builtin_amdgcn_fence(__ATOMIC_ACQUIRE, "agent");
            xb_add(&bar[XB_XGEN(b.x)], 1u);
            asm volatile("s_waitcnt vmcnt(0)" ::: "memory");
        } else {
            XB_SPIN(xb_ld(&bar[XB_XGEN(b.x)]) == gen, bar);
            __builtin_amdgcn_fence(__ATOMIC_ACQUIRE, "agent");
            asm volatile("s_waitcnt vmcnt(0)" ::: "memory");
        }
    }
    __syncthreads();
}

constexpr int CW_BAR = 4096;
constexpr int LDS_MISC = 131072 + 8192;
struct Args { const float* in[31]; float* out; unsigned char* ws; int ph_lo, ph_hi; };
constexpr int N_PHASES = 14;
__global__ void __launch_bounds__(NTHREADS, 2) mk_fwd(Args args) {
    extern __shared__ __attribute__((aligned(16))) unsigned char lds_raw[];
    cg::grid_group grid = cg::this_grid();
    Frame F;
    F.lds = (LAS unsigned char*)lds_raw;
    F.G = gridDim.x;
    F.inp = args.in; F.out = args.out;
    const int lo = args.ph_lo, hi = args.ph_hi;
    volatile LAS unsigned* bst = (volatile LAS unsigned*)(F.lds + LDS_MISC);
    if (threadIdx.x < 2) bst[threadIdx.x] = 0u;
    __syncthreads();
    XcdBarrier xbar = xcd_barrier_post((unsigned*)args.ws + CW_BAR, bst, (int)threadIdx.x);
    const int wave0 = __builtin_amdgcn_readfirstlane((int)threadIdx.x >> 6);
#define MK_PHASE(k, CALL) do { if (lo <= (k) && (k) < hi) { \
        { int ln_ = (int)__builtin_amdgcn_mbcnt_hi(~0u, __builtin_amdgcn_mbcnt_lo(~0u, 0u)); asm volatile("" : "+v"(ln_)); int wv_ = wave0; asm volatile("" : "+s"(wv_)); F.lane = ln_; F.wave = wv_; F.tid = wv_ * 64 + ln_; } \
        { int bx = blockIdx.x; asm volatile("" : "+s"(bx)); F.bid = bx; F.vcu = (F.G % 8 == 0) ? (bx % 8) * (F.G / 8) + bx / 8 : bx; } \
        { unsigned char* w_ = args.ws; asm volatile("" : "+s"(w_)); F.ws = w_; int z_ = 0; asm volatile("" : "+s"(z_)); F.zero = z_; } \
        CALL; if ((k) + 1 < hi) { if ((k) == 0) grid.sync(); else xcd_barrier(xbar, wave0 * 64 + (int)__builtin_amdgcn_mbcnt_hi(~0u, __builtin_amdgcn_mbcnt_lo(~0u, 0u))); } } } while (0)
    MK_PHASE(0, phase_p0a(F));
    MK_PHASE(1, phase_p0b(F));
    MK_PHASE(2, phase_p1(F, 0));
    MK_PHASE(3, phase_p2a(F, 0));
    MK_PHASE(4, phase_p2b(F, 0));
    MK_PHASE(5, phase_p3(F, 0));
    MK_PHASE(6, phase_p4(F, 0));
    MK_PHASE(7, phase_p5(F, 0));
    MK_PHASE(8, phase_p1(F, 1));
    MK_PHASE(9, phase_p2a(F, 1));
    MK_PHASE(10, phase_p2b(F, 1));
    MK_PHASE(11, phase_p3(F, 1));
    MK_PHASE(12, phase_p4(F, 1));
    MK_PHASE(13, phase_p5(F, 1));
#undef MK_PHASE
}
}

static int mk_setup() {
    static int grid = 0;
    if (grid == 0) {
        int dev = 0, cus = 0, per_cu = 0;
        hipGetDevice(&dev); hipDeviceGetAttribute(&cus, hipDeviceAttributeMultiprocessorCount, dev);
        hipFuncSetAttribute((const void*)mk::mk_fwd, hipFuncAttributeMaxDynamicSharedMemorySize, mk::LDS_BYTES);
        hipOccupancyMaxActiveBlocksPerMultiprocessor(&per_cu, (const void*)mk::mk_fwd, mk::NTHREADS, mk::LDS_BYTES);
        (void)hipGetLastError();
        if (per_cu < 1) { fprintf(stderr, "mk_setup: occupancy query says %d blocks/CU\n", per_cu); per_cu = 1; }
        grid = cus;
        fprintf(stderr, "mk_setup: cus %d per_cu %d grid %d\n", cus, per_cu, grid);
    }
    return grid;
}
static void mk_run(void* const* d_in, void* d_out, void* d_ws, hipStream_t stream, int lo, int hi, bool coop) {
    const int grid = mk_setup();
    mk::Args a{};
    for (int i = 0; i < 31; ++i) a.in[i] = (const float*)d_in[i];
    a.out = (float*)d_out; a.ws = (unsigned char*)d_ws; a.ph_lo = lo; a.ph_hi = hi;
    if (coop) { void* params[] = {&a}; hipError_t e = hipLaunchCooperativeKernel((const void*)mk::mk_fwd, dim3(grid), dim3(mk::NTHREADS), params, mk::LDS_BYTES, stream);
        if (e != hipSuccess) fprintf(stderr, "coop launch failed: %s\n", hipGetErrorString(e)); }
    else hipLaunchKernelGGL(mk::mk_fwd, dim3(grid), dim3(mk::NTHREADS), mk::LDS_BYTES, stream, a);
}

extern "C" void kernel_launch(void* const* d_in, const int* in_sizes, int n_in, void* d_out, int out_size, void* d_ws, size_t ws_size, hipStream_t stream) {
    if (ws_size < mk::WS_END) { fprintf(stderr, "ws too small\n"); return; }
    hipMemsetAsync(d_ws, 0, mk::MiB, stream);
    for (int ph = 0; ph < mk::N_PHASES; ++ph) mk_run(d_in, d_out, d_ws, stream, ph, ph + 1, false);
}
```

```cpp
#include <hip/hip_runtime.h>
#include <hip/hip_cooperative_groups.h>
#include <math.h>
#include <stdint.h>
#include <cstdio>
namespace cg = cooperative_groups;
namespace pg8 {
#define PG8_LAS __attribute__((address_space(3)))
typedef unsigned short bf16_t;
typedef short bf16x8 __attribute__((ext_vector_type(8)));
typedef float f32x4 __attribute__((ext_vector_type(4)));
typedef unsigned u32x4 __attribute__((ext_vector_type(4)));
constexpr int BM = 256, BK = 64, HALF = 128, HTB = HALF * BK * 2  , STAGE_BYTES = 8 * HTB, NXCD = 8, WGM = 8;

__host__ __device__ __forceinline__ int lds_byte(int r, int c) { const int st = (r >> 4) * 2 + (c >> 5), rr = r & 15, cc = c & 31, ob = rr * 64 + cc * 2; return st * 1024 + (ob ^ (((ob >> 9) & 1) << 5)); }
__host__ __device__ __forceinline__ void stage_rc(int b, int& R, int& C) { const int st = b / 1024, sb = b % 1024, swz = sb ^ (((sb >> 9) & 1) << 5); R = (st >> 1) * 16 + swz / 64; C = (st & 1) * 32 + (swz % 64) / 2; }
__host__ __device__ __forceinline__ int perm32(int rho) { const int n = rho >> 4, i = rho & 15; return 8 * (i >> 2) + 4 * n + (i & 3); }

struct Unit { int pm, pn; };
struct Gemm { const bf16_t* A; const bf16_t* Bt; int M, N, K; };

struct StaticOrder {
    int nM, nN, nwg, G, c;
    __host__ __device__ void init(int M, int N, int G_, int c_) { nM = M / BM; nN = N / BM; nwg = nM * nN; G = G_; c = c_; }
    __host__ __device__ bool next(int i, Unit& u) const {
        const long L = (long)i * G + c; if (L >= nwg) return false;
        int wgid = (int)L; { const int q = nwg / NXCD, r = nwg % NXCD, xcd = wgid % NXCD, off = wgid / NXCD; wgid = (xcd < r ? xcd * (q + 1) : r * (q + 1) + (xcd - r) * q) + off; }
        const int nig = WGM * nN, gid = wgid / nig, fm = gid * WGM, gsz = (nM - fm) < WGM ? (nM - fm) : WGM;
        u.pm = fm + ((wgid % nig) % gsz); u.pn = (wgid % nig) / gsz; return true;
    }
    __device__ __forceinline__ void a_ready(const Unit&) const {}
    __device__ __forceinline__ void done(const Unit&) const {}
};


template <class Epi, class Sched, bool ALIGN_EPI = false, bool SP2 = false>
__device__ __forceinline__ void gemm_phase(PG8_LAS unsigned char* lds, const Gemm g, const Sched& S, const Epi& E, const int tid) {
    const int wid = __builtin_amdgcn_readfirstlane(tid >> 6), lane = tid & 63, wr = wid >> 2, wc = wid & 3, fr = lane & 15, fq = lane >> 4;
    const int K = g.K, nt = K / BK;
    unsigned voffA[2], voffB[2];
#pragma unroll
    for (int i = 0; i < 2; ++i) { int R, C; stage_rc(tid * 16 + i * 8192, R, C); const int Rb = Epi::PERM ? ((R & ~31) + perm32(R & 31)) : R;
        voffA[i] = (unsigned)(R * K + C) * 2u; voffB[i] = (unsigned)(Rb * K + C) * 2u; }
    const size_t kstep = (size_t)(BK * 2);
    const size_t hstep = (size_t)HALF * K * 2;
    const size_t tstep = 2 * hstep;
    const unsigned ldsw = (unsigned)wid * 1024u;
    const int aoff = lds_byte(wr * 64 + fr, fq * 8), boff = lds_byte(wc * 32 + fr, fq * 8);
#define PG8_SA(b, h) (((b) * 2 + (h)) * HTB)
#define PG8_SB(b, h) ((4 + (b) * 2 + (h)) * HTB)
#define PG8_STAGE(bufoff, gbase, voff) do { _Pragma("unroll") for (int _i = 0; _i < 2; ++_i) \
        __builtin_amdgcn_global_load_lds((const unsigned*)((const char*)(gbase) + (voff)[_i]), (PG8_LAS unsigned*)(lds + (bufoff) + ldsw + _i * 8192), 16, 0, 0); } while (0)
#define PG8_LDA(dst, b, h) do { _Pragma("unroll") for (int m = 0; m < 4; ++m) _Pragma("unroll") for (int k = 0; k < 2; ++k) dst[m][k] = *(const PG8_LAS bf16x8*)(lds + PG8_SA(b, h) + aoff + m * 2048 + k * 1024); } while (0)
#define PG8_LDB(dst, b, h) do { _Pragma("unroll") for (int n = 0; n < 2; ++n) _Pragma("unroll") for (int k = 0; k < 2; ++k) dst[n][k] = *(const PG8_LAS bf16x8*)(lds + PG8_SB(b, h) + boff + n * 2048 + k * 1024); } while (0)
#define PG8_MMA(ai, bj, At, Bt) do { __builtin_amdgcn_s_setprio(1); _Pragma("unroll") for (int m = 0; m < 4; ++m) _Pragma("unroll") for (int n = 0; n < 2; ++n) _Pragma("unroll") for (int k = 0; k < 2; ++k) \
        acc[ai][bj][m][n] = __builtin_amdgcn_mfma_f32_16x16x32_bf16(Bt[n][k], At[m][k], acc[ai][bj][m][n], 0, 0, 0); __builtin_amdgcn_s_setprio(0); } while (0)
#define PG8_WAIT_V(n) asm volatile("s_waitcnt vmcnt(" #n ")" ::: "memory")
#define PG8_WAIT_L(n) asm volatile("s_waitcnt lgkmcnt(" #n ")" ::: "memory")
#define PG8_BAR __builtin_amdgcn_s_barrier()
#define PG8_SCHED __builtin_amdgcn_sched_barrier(0)
    Unit cur, nxt; int ui = 0;
    if (!S.next(0, cur)) return;
    f32x4 acc[2][2][4][2];
#pragma unroll
    for (int a = 0; a < 2; ++a)
#pragma unroll
        for (int b = 0; b < 2; ++b)
#pragma unroll
            for (int m = 0; m < 4; ++m)
#pragma unroll
                for (int n = 0; n < 2; ++n) acc[a][b][m][n] = (f32x4){0.f, 0.f, 0.f, 0.f};
    bf16x8 At[4][2], B0[2][2], B1[2][2];
    const char* cA = (const char*)g.A + (size_t)cur.pm * tstep; const char* cB = (const char*)g.Bt + (size_t)cur.pn * tstep;
    S.a_ready(cur);
    if constexpr (SP2) {
        PG8_STAGE(PG8_SB(0, 0), cB, voffB); PG8_STAGE(PG8_SB(0, 1), cB + hstep, voffB); PG8_STAGE(PG8_SA(0, 0), cA, voffA); PG8_STAGE(PG8_SA(0, 1), cA + hstep, voffA);
        if (wr == 1) PG8_BAR;
        PG8_WAIT_V(2); PG8_BAR;
        PG8_STAGE(PG8_SB(1, 0), cB + kstep, voffB); PG8_STAGE(PG8_SA(1, 0), cA + kstep, voffA); PG8_STAGE(PG8_SB(1, 1), cB + hstep + kstep, voffB);
        PG8_WAIT_V(6); PG8_BAR;
    } else {
        PG8_STAGE(PG8_SB(0, 0), cB, voffB); PG8_STAGE(PG8_SA(0, 0), cA, voffA); PG8_STAGE(PG8_SB(0, 1), cB + hstep, voffB); PG8_STAGE(PG8_SA(0, 1), cA + hstep, voffA);
        if (wr == 1) PG8_BAR;
        PG8_WAIT_V(4); PG8_BAR;
        PG8_STAGE(PG8_SB(1, 0), cB + kstep, voffB); PG8_STAGE(PG8_SA(1, 0), cA + kstep, voffA); PG8_STAGE(PG8_SB(1, 1), cB + hstep + kstep, voffB);
        PG8_WAIT_V(6); PG8_BAR;
    }
    for (;;) {
        const bool has_next = S.next(ui + 1, nxt);
        const char* nA = has_next ? (const char*)g.A + (size_t)nxt.pm * tstep : cA; const char* nB = has_next ? (const char*)g.Bt + (size_t)nxt.pn * tstep : cB;
        for (int t = 0; t < nt; t += 2) {
            const bool last = (t == nt - 2);
            const char* a1 = cA + (size_t)(t + 1) * kstep;
            const char* a2 = last ? nA : cA + (size_t)(t + 2) * kstep; const char* b2 = last ? nB : cB + (size_t)(t + 2) * kstep;
            const char* a3 = a2 + kstep; const char* b3 = b2 + kstep;
            if (last && has_next) S.a_ready(nxt);
            if constexpr (SP2) {
            PG8_LDB(B0, 0, 0); PG8_LDB(B1, 0, 1); PG8_SCHED; PG8_LDA(At, 0, 0); PG8_STAGE(PG8_SA(1, 1), a1 + hstep, voffA);
            PG8_WAIT_V(8); PG8_WAIT_L(0); PG8_BAR; PG8_MMA(0, 0, At, B0); PG8_MMA(0, 1, At, B1); PG8_BAR; PG8_SCHED;
            PG8_LDA(At, 0, 1); PG8_STAGE(PG8_SB(0, 0), b2, voffB); PG8_STAGE(PG8_SB(0, 1), b2 + hstep, voffB); PG8_STAGE(PG8_SA(0, 0), a2, voffA);
            PG8_WAIT_V(8); PG8_WAIT_L(0); PG8_BAR; PG8_MMA(1, 0, At, B0); PG8_MMA(1, 1, At, B1); PG8_BAR; PG8_SCHED;
            PG8_LDB(B0, 1, 0); PG8_LDB(B1, 1, 1); PG8_SCHED; PG8_LDA(At, 1, 0); PG8_STAGE(PG8_SA(0, 1), a2 + hstep, voffA);
            PG8_WAIT_V(8); PG8_WAIT_L(0); PG8_BAR; PG8_MMA(0, 0, At, B0); PG8_MMA(0, 1, At, B1); PG8_BAR; PG8_SCHED;
            PG8_LDA(At, 1, 1); PG8_STAGE(PG8_SB(1, 0), b3, voffB); PG8_STAGE(PG8_SB(1, 1), b3 + hstep, voffB); PG8_STAGE(PG8_SA(1, 0), a3, voffA);
            PG8_WAIT_V(8); PG8_WAIT_L(0); PG8_BAR; PG8_MMA(1, 0, At, B0); PG8_MMA(1, 1, At, B1); PG8_BAR; PG8_SCHED;
            } else {
            PG8_LDB(B0, 0, 0); PG8_SCHED; PG8_LDA(At, 0, 0); PG8_STAGE(PG8_SA(1, 1), a1 + hstep, voffA);
            PG8_WAIT_L(8); PG8_BAR; PG8_WAIT_L(0); PG8_MMA(0, 0, At, B0); PG8_BAR; PG8_SCHED;
            PG8_LDB(B1, 0, 1); PG8_STAGE(PG8_SB(0, 0), b2, voffB);
            PG8_BAR; PG8_WAIT_L(0); PG8_MMA(0, 1, At, B1); PG8_BAR;
            PG8_LDA(At, 0, 1); PG8_STAGE(PG8_SA(0, 0), a2, voffA);
            PG8_BAR; PG8_WAIT_L(0); PG8_MMA(1, 0, At, B0); PG8_BAR; PG8_SCHED;
            PG8_STAGE(PG8_SB(0, 1), b2 + hstep, voffB);
            PG8_WAIT_V(6); PG8_BAR; PG8_MMA(1, 1, At, B1); PG8_BAR;
            PG8_LDB(B0, 1, 0); PG8_SCHED; PG8_LDA(At, 1, 0); PG8_STAGE(PG8_SA(0, 1), a2 + hstep, voffA);
            PG8_WAIT_L(8); PG8_BAR; PG8_WAIT_L(0); PG8_MMA(0, 0, At, B0); PG8_BAR; PG8_SCHED;
            PG8_LDB(B1, 1, 1); PG8_STAGE(PG8_SB(1, 0), b3, voffB);
            PG8_BAR; PG8_WAIT_L(0); PG8_MMA(0, 1, At, B1); PG8_BAR;
            PG8_LDA(At, 1, 1); PG8_STAGE(PG8_SA(1, 0), a3, voffA);
            PG8_BAR; PG8_WAIT_L(0); PG8_MMA(1, 0, At, B0); PG8_BAR; PG8_SCHED;
            PG8_STAGE(PG8_SB(1, 1), b3 + hstep, voffB);
            PG8_WAIT_V(6); PG8_BAR; PG8_MMA(1, 1, At, B1); PG8_BAR;
            }
        }
        if constexpr (ALIGN_EPI) { if (wr == 0) PG8_BAR; }
        if constexpr (!Epi::AFTER_DRAIN) { E(acc, cur, wr, wc, fr, fq); S.done(cur); }
        if (!has_next) break;
#pragma unroll
        for (int a = 0; a < 2; ++a)
#pragma unroll
            for (int b = 0; b < 2; ++b)
#pragma unroll
                for (int m = 0; m < 4; ++m)
#pragma unroll
                    for (int n = 0; n < 2; ++n) acc[a][b][m][n] = (f32x4){0.f, 0.f, 0.f, 0.f};
        cur = nxt; cA = nA; cB = nB; ++ui;
        if constexpr (ALIGN_EPI) { if (wr == 1) PG8_BAR; }
    }
    PG8_WAIT_V(0);
    if constexpr (!ALIGN_EPI) { if (wr == 0) PG8_BAR; }
    PG8_BAR;
    if constexpr (Epi::AFTER_DRAIN) { E.fused(acc, cur, wr, wc, fr, fq, lds, wid, lane); S.done(cur); }
#undef PG8_SA
#undef PG8_SB
#undef PG8_STAGE
#undef PG8_LDA
#undef PG8_LDB
#undef PG8_MMA
#undef PG8_WAIT_V
#undef PG8_WAIT_L
#undef PG8_BAR
#undef PG8_SCHED
}
}

#ifndef PG8_SP2
#define PG8_SP2 true
#endif

namespace mk {
using pg8::bf16_t; using pg8::f32x4; using pg8::Unit;
#define LAS __attribute__((address_space(3)))
typedef unsigned u32x2 __attribute__((ext_vector_type(2)));
typedef unsigned u32x4 __attribute__((ext_vector_type(4)));
constexpr int D = 1024, NB = 8, T = 4096, C = 256, RB = C + T, MALL = NB * RB, NTILE = MALL / 256, TPB = RB / 256  ;
constexpr int DIN = 2176, DINP = 2304, DMIX = 1024, DFF = 2816, NMOD = 6, LW = 384;
constexpr float EPS = 1e-6f, LOG2E = 1.4426950408889634f;
constexpr float QSA = 0.17677669529663687f * LOG2E, QSB = 0.125f * LOG2E;
constexpr int O_AQ = 0, O_AK = 256, O_AV = 512, O_BQ = 768, O_BK = 1152, O_BV = 1280, O_CX = 1408, O_CG = 1792;
constexpr int NWAVES = 8, NTHREADS = 512;
constexpr size_t MiB = 1u << 20;
constexpr size_t WS_CTL = 0;
constexpr size_t WS_WIN = 1 * MiB;
constexpr size_t WS_WOUT = 10 * MiB;
constexpr size_t WS_WUP = 14 * MiB;
constexpr size_t WS_WDN = 36 * MiB;
constexpr size_t WS_MOD = 47 * MiB;
constexpr size_t WS_BIAS1 = WS_MOD + 512 * 1024;
constexpr size_t WS_BIAS2 = WS_BIAS1 + 256 * 1024;
constexpr size_t WS_TAB = WS_BIAS2 + 512 * 1024;
constexpr size_t WS_TAB64 = WS_TAB + 4096, WS_PAR = WS_TAB64 + 8192;
constexpr int PAR_STRIDE = 512, PR_GQ32 = 0, PR_GK32 = 32, PR_GQ64 = 64, PR_GK64 = 128, PR_SUBG = 192, PR_SINK = 256, PR_LAM = 272, PR_MA = 273, PR_MB = 274, PR_LI = 275;
constexpr size_t WS_GAIN = WS_PAR + 8192;
constexpr size_t WS_FFNP = WS_GAIN + 16384;
constexpr size_t WS_SS1 = 49 * MiB;
constexpr size_t WS_SS2 = WS_SS1 + 3 * MiB;
constexpr size_t WS_LRU = 55 * MiB;
constexpr size_t WS_XC = 56 * MiB;
constexpr size_t WS_SIDE = 64 * MiB;
constexpr size_t WS_VN = 73 * MiB;
constexpr size_t WS_P = 141 * MiB;
constexpr size_t WS_Y = 294 * MiB;
constexpr size_t WS_U = WS_P;
constexpr size_t WS_END = 362 * MiB;
static_assert(WS_FFNP + 2 * 4 * DFF * 4 <= WS_SS1 && WS_SS2 + (size_t)MALL * 64 <= WS_LRU && WS_SIDE + (size_t)NTILE * 6 * DFF * 4 <= WS_VN && WS_U + (size_t)MALL * DFF * 2 <= WS_END && WS_P + (size_t)MALL * DINP * 2 <= WS_Y && WS_Y + (size_t)MALL * D * 2 <= WS_END && WS_VN + (size_t)MALL * D * 2 <= WS_P, "ws map");
constexpr int LDS_BYTES = 147456;

__device__ __forceinline__ unsigned f2bf(float f) { unsigned u = __builtin_bit_cast(unsigned, f); return (u + 0x7fffu + ((u >> 16) & 1u)) >> 16; }
__device__ __forceinline__ unsigned pk2(float lo, float hi) { return f2bf(lo) | (f2bf(hi) << 16); }
__device__ __forceinline__ float bf2f(unsigned short h) { return __builtin_bit_cast(float, (unsigned)h << 16); }
__device__ __forceinline__ float sigmoidf_(float x) { return 1.f / (1.f + __expf(-x)); }
__device__ __forceinline__ float siluf_(float x) { return x * sigmoidf_(x); }
#define LDS_WAIT() asm volatile("s_waitcnt lgkmcnt(0)" ::: "memory")

struct Frame {
    LAS unsigned char* lds;
    int tid, lane, wave, vcu, G, bid;
    const float* const* inp; int zero; float* out; unsigned char* ws;
    __device__ __forceinline__ const float* in_(int k) const { return inp[k + zero]; }
};

__device__ __forceinline__ int map_in(int n) {
    const int tile = n >> 8, lc = n & 255;
    if (tile <= 1) { const int s = lc >> 5, bj = (lc >> 4) & 1, q = lc & 15; return (tile << 8) + 128 * bj + 32 * (s >> 1) + 16 * (s & 1) + q; }
    if (tile == 3 || tile == 4) { const int z = lc >> 6, bj = (lc >> 5) & 1, q = lc & 31; return (tile << 8) + 128 * bj + 32 * z + q; }
    return n;
}
__device__ __forceinline__ int map_up(int n) { if (n < DFF) return 256 * (n >> 7) + (n & 127); const int c = n - DFF; return 256 * (c >> 7) + 128 + (c & 127); }

template <int MAP> __device__ __forceinline__ void transpose_item(const float* __restrict__ W, int K, int N, bf16_t* __restrict__ WT, LAS float* scr, int item, int lane) {
    const int nblk = N / 32, kb = item / nblk, nb = item % nblk, k0 = 64 * kb, n0 = 32 * nb;
#pragma unroll 8
    for (int i = 0; i < 32; ++i) { const int kk = 2 * i + (lane >> 5); scr[kk * 33 + (lane & 31)] = W[(size_t)(k0 + kk) * N + n0 + (lane & 31)]; }
    LDS_WAIT(); asm volatile("" ::: "memory");
    const int c = lane & 7;
#pragma unroll
    for (int j = 0; j < 4; ++j) { const int n = (lane >> 3) + 8 * j; const LAS float* s = scr + (8 * c) * 33 + n;
        u32x4 o; o.x = pk2(s[0 * 33], s[1 * 33]); o.y = pk2(s[2 * 33], s[3 * 33]); o.z = pk2(s[4 * 33], s[5 * 33]); o.w = pk2(s[6 * 33], s[7 * 33]);
        const int nl = n0 + n; const int row = MAP == 1 ? map_in(nl) : (MAP == 2 ? map_up(nl) : nl);
        *(u32x4*)(WT + (size_t)row * K + k0 + 8 * c) = o; }
    LDS_WAIT(); asm volatile("" ::: "memory");
}

__device__ __forceinline__ void gemv9_item(Frame& F, LAS float* vecs, LAS float* red, const float* __restrict__ W, int ldw, int n0, float* __restrict__ out, int ldo, const float* __restrict__ addb) {
    float acc[9];
#pragma unroll
    for (int v = 0; v < 9; ++v) acc[v] = 0.f;
    const int kb = F.wave * 128;
#pragma unroll 2
    for (int k = 0; k < 128; k += 4) {
        float w[4];
#pragma unroll
        for (int i = 0; i < 4; ++i) w[i] = W[(size_t)(kb + k + i) * ldw + n0 + F.lane];
#pragma unroll
        for (int v = 0; v < 9; ++v) { const f32x4 x = *(const LAS f32x4*)(vecs + v * 1024 + kb + k); acc[v] += x[0] * w[0] + x[1] * w[1] + x[2] * w[2] + x[3] * w[3]; }
    }
#pragma unroll
    for (int v = 0; v < 9; ++v) red[(F.wave * 9 + v) * 64 + F.lane] = acc[v];
    __syncthreads();
    for (int e = F.tid; e < 9 * 64; e += NTHREADS) { const int v = e >> 6, ln = e & 63; float s = 0.f;
#pragma unroll
        for (int w8 = 0; w8 < 8; ++w8) s += red[(w8 * 9 + v) * 64 + ln];
        out[(size_t)v * ldo + n0 + ln] = s + (addb ? addb[n0 + ln] : 0.f); }
    __syncthreads();
}

__device__ const float INVF16[16] = {1.000000000e+00f, 5.623413324e-01f, 3.162277639e-01f, 1.778279394e-01f, 1.000000015e-01f, 5.623413250e-02f, 3.162277490e-02f, 1.778279431e-02f,
                                     9.999999776e-03f, 5.623413250e-03f, 3.162277630e-03f, 1.778279431e-03f, 1.000000047e-03f, 5.623413017e-04f, 3.162277571e-04f, 1.778279402e-04f};
__device__ __forceinline__ void phase_p0a(Frame& F) {
    const float* w_in = F.in_(8); const float* w_out = F.in_(26); const float* w_up = F.in_(27); const float* w_down = F.in_(30);
    bf16_t* WIN = (bf16_t*)(F.ws + WS_WIN); bf16_t* WOUT = (bf16_t*)(F.ws + WS_WOUT); bf16_t* WUP = (bf16_t*)(F.ws + WS_WUP); bf16_t* WDN = (bf16_t*)(F.ws + WS_WDN);
    LAS float* scr = (LAS float*)(F.lds + F.wave * 16384);
    const int gw = F.vcu * NWAVES + F.wave, NGW = F.G * NWAVES;
    constexpr int I_IN = 16 * (DIN / 32), I_OUT = 16 * 32, I_UP = 16 * (2 * DFF / 32), I_DN = (DFF / 64) * 32, I_L = I_IN + I_OUT + I_UP + I_DN;
    for (int it = gw; it < 2 * I_L; it += NGW) {
        const int l = it / I_L; int r = it % I_L;
        if (r < I_IN) { transpose_item<1>(w_in + (size_t)l * D * DIN, D, DIN, WIN + (size_t)l * DINP * D, scr, r, F.lane); continue; } r -= I_IN;
        if (r < I_OUT) { transpose_item<0>(w_out + (size_t)l * DMIX * D, DMIX, D, WOUT + (size_t)l * D * DMIX, scr, r, F.lane); continue; } r -= I_OUT;
        if (r < I_UP) { transpose_item<2>(w_up + (size_t)l * D * 2 * DFF, D, 2 * DFF, WUP + (size_t)l * 2 * DFF * D, scr, r, F.lane); continue; } r -= I_UP;
        transpose_item<0>(w_down + (size_t)l * DFF * D, DFF, D, WDN + (size_t)l * D * DFF, scr, r, F.lane);
    }
    { const int gt = F.vcu * NTHREADS + F.tid, NGT = F.G * NTHREADS; constexpr int PER = (DINP - DIN) * D * 2 / 16;
      for (int e = gt; e < 2 * PER; e += NGT) { const int l = e / PER, o = e % PER; *(u32x4*)((unsigned char*)(WIN + ((size_t)l * DINP + DIN) * D) + (size_t)o * 16) = (u32x4){0u, 0u, 0u, 0u}; } }
    __syncthreads();
    LAS float* vecs = (LAS float*)F.lds; LAS float* red = vecs + 9 * 1024;
    const float* cvec = F.in_(1); const float* cctx = F.in_(3); const float* w_mod = F.in_(4); const float* b_mod = F.in_(5);
    float* MOD = (float*)(F.ws + WS_MOD);
    bool staged = false;
    for (int item = F.bid; item < 2 * 96; item += F.G) {
        if (!staged) { for (int e = F.tid; e < 9 * 1024; e += NTHREADS) { const int v = e >> 10, k = e & 1023; vecs[e] = siluf_(v < 8 ? cvec[v * D + k] : cctx[k]); } __syncthreads(); staged = true; }
        const int l = item / 96, n0 = (item % 96) * 64;
        gemv9_item(F, vecs, red, w_mod + (size_t)l * D * NMOD * D, NMOD * D, n0, MOD + (size_t)l * 9 * NMOD * D, NMOD * D, b_mod + (size_t)l * NMOD * D);
    }
    if (F.bid == F.G - 1) {
        float* tab32 = (float*)(F.ws + WS_TAB); float* tab64 = (float*)(F.ws + WS_TAB64);
        for (int idx = F.tid; idx < 64 * 8 + 64 * 16; idx += NTHREADS) {
            int quarter, pos, fi; float* dst;
            if (idx < 64 * 8) { quarter = 8; pos = idx / 8; fi = idx % 8; dst = tab32 + idx * 2; }
            else { const int j = idx - 64 * 8; quarter = 16; pos = j / 16; fi = j % 16; dst = tab64 + j * 2; }
            const float invf = INVF16[fi * (16 / quarter)];
            const float x = (float)pos * invf;
            const float kf = rintf(x * 0.636619772f); const int kq = (int)kf;
            float r = fmaf(-kf, 1.5703125f, x); r = fmaf(-kf, 4.837512969970703125e-4f, r); r = fmaf(-kf, 7.54978995489188216e-8f, r);
            const float r2 = r * r;
            const float sp = r + r * r2 * (-1.6666654611e-1f + r2 * (8.3321608736e-3f + r2 * (-1.9515295891e-4f)));
            const float cp = 1.0f - 0.5f * r2 + r2 * r2 * (4.166664568298827e-2f + r2 * (-1.388731625493765e-3f + r2 * 2.443315711809948e-5f));
            const int qd = kq & 3;
            const float sv = qd == 0 ? sp : (qd == 1 ? cp : (qd == 2 ? -sp : -cp)), cv = qd == 0 ? cp : (qd == 1 ? -sp : (qd == 2 ? -cp : sp));
            dst[0] = cv; dst[1] = sv;
        }
        float* par = (float*)(F.ws + WS_PAR);
        for (int e = F.tid; e < 2 * 262; e += NTHREADS) { const int l = e / 262, i = e % 262; float v;
            if (i < 32) v = F.in_(9)[l * 32 + i]; else if (i < 64) v = F.in_(10)[l * 32 + i - 32]; else if (i < 128) v = F.in_(16)[l * 64 + i - 64]; else if (i < 192) v = F.in_(17)[l * 64 + i - 128];
            else if (i < 256) v = F.in_(15)[l * 64 + i - 192]; else v = F.in_(18)[l * 6 + i - 256];
            par[l * PAR_STRIDE + i] = v; }
        { float* gn = (float*)(F.ws + WS_GAIN); for (int e = F.tid; e < 4 * D; e += NTHREADS) gn[e] = e < 2 * D ? F.in_(6)[e] : F.in_(7)[e - 2 * D];
          float* fp = (float*)(F.ws + WS_FFNP); for (int e = F.tid; e < 2 * 4 * DFF; e += NTHREADS) { const int l = e / (4 * DFF), i = e % (4 * DFF); fp[e] = i < 3 * DFF ? F.in_(28)[(size_t)l * 3 * DFF + i] : F.in_(29)[(size_t)l * DFF + i - 3 * DFF]; } }
        if (F.tid < 2) {
            const int l = F.tid; const float li = 0.8f - 0.6f * expf(-0.3f * (float)l);
            const float* lq1 = F.in_(11) + l * 32; const float* lk1 = F.in_(12) + l * 32; const float* lq2 = F.in_(13) + l * 32; const float* lk2 = F.in_(14) + l * 32;
            float s1 = 0.f, s2 = 0.f; for (int i = 0; i < 32; ++i) { s1 += lq1[i] * lk1[i]; s2 += lq2[i] * lk2[i]; }
            float mq = 0.f, mk_ = 0.f; for (int i = 0; i < 32; ++i) { mq = fmaxf(mq, fabsf(F.in_(9)[l * 32 + i])); mk_ = fmaxf(mk_, fabsf(F.in_(10)[l * 32 + i])); }
            float nq = 0.f, nk = 0.f; for (int i = 0; i < 64; ++i) { nq = fmaxf(nq, fabsf(F.in_(16)[l * 64 + i])); nk = fmaxf(nk, fabsf(F.in_(17)[l * 64 + i])); }
            float mb = QSB * 64.f * nq * nk; for (int i = 0; i < 6; ++i) mb = fmaxf(mb, F.in_(18)[l * 6 + i] * LOG2E);
            par[l * PAR_STRIDE + PR_LAM] = expf(s1) - expf(s2) + li; par[l * PAR_STRIDE + PR_MA] = QSA * 32.f * mq * mk_; par[l * PAR_STRIDE + PR_MB] = mb; par[l * PAR_STRIDE + PR_LI] = li;
        }
    }
}

__device__ __forceinline__ void phase_p0b(Frame& F) {
    LAS float* vecs = (LAS float*)F.lds; LAS float* red = vecs + 9 * 1024;
    const float* MOD = (const float*)(F.ws + WS_MOD); float* B1 = (float*)(F.ws + WS_BIAS1); float* B2 = (float*)(F.ws + WS_BIAS2);
    const float* w_in = F.in_(8); const float* w_up = F.in_(27);
    constexpr int I1 = DIN / 64, I2 = 2 * DFF / 64, IL = I1 + I2;
    for (int item = F.bid; item < 2 * IL; item += F.G) {
        const int l = item / IL; int r = item % IL; const bool is1 = r < I1; if (!is1) r -= I1;
        __syncthreads();
        for (int e = F.tid; e < 9 * 1024; e += NTHREADS) { const int v = e >> 10, k = e & 1023; vecs[e] = MOD[((size_t)l * 9 + v) * NMOD * D + (is1 ? 0 : 3) * D + k]; }
        __syncthreads();
        if (is1) gemv9_item(F, vecs, red, w_in + (size_t)l * D * DIN, DIN, r * 64, B1 + (size_t)l * 9 * DINP, DINP, nullptr);
        else gemv9_item(F, vecs, red, w_up + (size_t)l * D * 2 * DFF, 2 * DFF, r * 64, B2 + (size_t)l * 9 * 2 * DFF, 2 * DFF, nullptr);
    }
    { const int gt = F.vcu * NTHREADS + F.tid; if (gt < 2 * 9 * (DINP - DIN)) { const int lv = gt / (DINP - DIN), n = gt % (DINP - DIN); B1[(size_t)lv * DINP + DIN + n] = 0.f; } }
    const float* x = F.in_(0); const float* ctx = F.in_(2); const float* g1 = F.in_(6);
    bf16_t* VN = (bf16_t*)(F.ws + WS_VN); float* SS1 = (float*)(F.ws + WS_SS1);
    const int gw = F.vcu * NWAVES + F.wave, NGW = F.G * NWAVES;
    for (int g = gw; g < MALL; g += NGW) {
        const int b = g / RB, r = g % RB; const int v = r < C ? 8 : b;
        const float* src = r < C ? ctx + ((size_t)b * C + r) * D : x + ((size_t)b * T + (r - C)) * D;
        const float* sc = MOD + ((size_t)0 * 9 + v) * NMOD * D + 1 * D;
        float s = 0.f;
#pragma unroll
        for (int j = 0; j < 4; ++j) { const int n = 4 * F.lane + 256 * j; const f32x4 xv = *(const f32x4*)(src + n); const f32x4 gv = *(const f32x4*)(g1 + n); const f32x4 sv = *(const f32x4*)(sc + n);
            s += xv[0] * xv[0] + xv[1] * xv[1] + xv[2] * xv[2] + xv[3] * xv[3];
            u32x2 o; o.x = pk2(xv[0] * gv[0] * (1.f + sv[0]), xv[1] * gv[1] * (1.f + sv[1])); o.y = pk2(xv[2] * gv[2] * (1.f + sv[2]), xv[3] * gv[3] * (1.f + sv[3]));
            *(u32x2*)(VN + (size_t)g * D + n) = o; }
#pragma unroll
        for (int o = 1; o < 64; o <<= 1) s += __shfl_xor(s, o);
        if (F.lane == 0) *(f32x4*)(SS1 + (size_t)g * 4) = (f32x4){s, 0.f, 0.f, 0.f};
    }
}

struct Order {
    pg8::StaticOrder so; int latent_only;
    __device__ __forceinline__ void init(int nMt, int N, int G, int c, int lat) { so.init(nMt * 256, N, G, c); latent_only = lat; }
    __device__ __forceinline__ bool next(int i, Unit& u) const { if (!so.next(i, u)) return false; if (latent_only) u.pm = (u.pm >> 4) * TPB + 1 + (u.pm & 15); return true; }
    __device__ __forceinline__ void a_ready(const Unit&) const {}
    __device__ __forceinline__ void done(const Unit&) const {}
};

struct EpiIn {
    static constexpr bool PERM = false, AFTER_DRAIN = false;
    unsigned char* ws; int l;
    __device__ __forceinline__ void operator()(const f32x4 (&acc)[2][2][4][2], const Unit& u, int wr, int wc, int fr, int fq) const {
        { const int ln = (int)__builtin_amdgcn_mbcnt_hi(~0u, __builtin_amdgcn_mbcnt_lo(~0u, 0u)); fr = ln & 15; fq = ln >> 4; asm volatile("" : "+v"(fr), "+v"(fq)); }
        bf16_t* P = (bf16_t*)(ws + WS_P); const float* SS = (const float*)(ws + WS_SS1); const float* bias = (const float*)(ws + WS_BIAS1) + (size_t)l * 9 * DINP;
        const float* tab32 = (const float*)(ws + WS_TAB); const float* tab64 = (const float*)(ws + WS_TAB64); const float* par = (const float*)(ws + WS_PAR) + l * PAR_STRIDE;
        const float* gq32 = par + PR_GQ32; const float* gk32 = par + PR_GK32; const float* gq64 = par + PR_GQ64; const float* gk64 = par + PR_GK64;
        const int b = u.pm / TPB, j = u.pm % TPB; const bool lat = j != 0; const float* bia = bias + (size_t)(lat ? b : 8) * DINP;
        const int pn = u.pn;
#pragma unroll
        for (int ai = 0; ai < 2; ++ai)
#pragma unroll
            for (int m = 0; m < 4; ++m) {
                const int rloc = ai * 128 + wr * 64 + m * 16 + fr; const size_t g = (size_t)u.pm * 256 + rloc;
                const f32x4 s4 = *(const f32x4*)(SS + g * 4);
                const float rs = 1.0f / sqrtf((s4[0] + s4[1] + s4[2] + s4[3]) * (1.0f / D) + EPS);
                const int t = (j - 1) * 256 + rloc; const int prow = t >> 6, pcol = t & 63;
                bf16_t* prow_p = P + g * DINP;
                if (pn <= 1) {
                    const float* gain = pn == 0 ? gq32 : gk32;
                    const f32x4 g1 = *(const f32x4*)(gain + 4 * fq), g2 = *(const f32x4*)(gain + 16 + 4 * fq);
                    const int pos = fq < 2 ? prow : pcol; const float* tb = tab32 + (pos * 8 + 4 * (fq & 1)) * 2;
#pragma unroll
                    for (int n = 0; n < 2; ++n) {
                        const int col = 256 * pn + 32 * (2 * wc + n) + 4 * fq;
                        f32x4 x1 = acc[ai][0][m][n] * rs + *(const f32x4*)(bia + col), x2 = acc[ai][1][m][n] * rs + *(const f32x4*)(bia + col + 16);
                        float ss = x1[0] * x1[0] + x1[1] * x1[1] + x1[2] * x1[2] + x1[3] * x1[3] + x2[0] * x2[0] + x2[1] * x2[1] + x2[2] * x2[2] + x2[3] * x2[3];
                        ss += __shfl_xor(ss, 16); ss += __shfl_xor(ss, 32);
                        const float ri = 1.0f / sqrtf(ss * (1.0f / 32.f) + EPS);
                        x1 = x1 * ri * g1; x2 = x2 * ri * g2;
                        if (lat) { const f32x4 c01 = *(const f32x4*)(tb), c23 = *(const f32x4*)(tb + 4);
                            const f32x4 cs = (f32x4){c01[0], c01[2], c23[0], c23[2]}, sn = (f32x4){c01[1], c01[3], c23[1], c23[3]};
                            const f32x4 y1 = x1 * cs - x2 * sn, y2 = x1 * sn + x2 * cs; x1 = y1; x2 = y2; }
                        if (pn == 0) { x1 = x1 * QSA; x2 = x2 * QSA; }
                        u32x2 o1, o2; o1.x = pk2(x1[0], x1[1]); o1.y = pk2(x1[2], x1[3]); o2.x = pk2(x2[0], x2[1]); o2.y = pk2(x2[2], x2[3]);
                        *(u32x2*)(prow_p + col) = o1; *(u32x2*)(prow_p + col + 16) = o2;
                    }
                } else if (pn == 3 || pn == 4) {
                    const bool isq = pn == 3 || wc < 2; const float* gain = isq ? gq64 : gk64;
                    const int colb = 256 * pn + 64 * wc;
                    f32x4 xa[2], xb[2]; float ss = 0.f;
#pragma unroll
                    for (int n = 0; n < 2; ++n) { xa[n] = acc[ai][0][m][n] * rs + *(const f32x4*)(bia + colb + 16 * n + 4 * fq); xb[n] = acc[ai][1][m][n] * rs + *(const f32x4*)(bia + colb + 32 + 16 * n + 4 * fq);
                        ss += xa[n][0] * xa[n][0] + xa[n][1] * xa[n][1] + xa[n][2] * xa[n][2] + xa[n][3] * xa[n][3] + xb[n][0] * xb[n][0] + xb[n][1] * xb[n][1] + xb[n][2] * xb[n][2] + xb[n][3] * xb[n][3]; }
                    ss += __shfl_xor(ss, 16); ss += __shfl_xor(ss, 32);
                    const float ri = 1.0f / sqrtf(ss * (1.0f / 64.f) + EPS);
#pragma unroll
                    for (int n = 0; n < 2; ++n) {
                        f32x4 x1 = xa[n] * ri * *(const f32x4*)(gain + 16 * n + 4 * fq), x2 = xb[n] * ri * *(const f32x4*)(gain + 32 + 16 * n + 4 * fq);
                        if (lat) { const float* tb = tab64 + ((n == 0 ? prow : pcol) * 16 + 4 * fq) * 2; const f32x4 c01 = *(const f32x4*)(tb), c23 = *(const f32x4*)(tb + 4);
                            const f32x4 cs = (f32x4){c01[0], c01[2], c23[0], c23[2]}, sn = (f32x4){c01[1], c01[3], c23[1], c23[3]};
                            const f32x4 y1 = x1 * cs - x2 * sn, y2 = x1 * sn + x2 * cs; x1 = y1; x2 = y2; }
                        if (isq) { x1 = x1 * QSB; x2 = x2 * QSB; }
                        u32x2 o1, o2; o1.x = pk2(x1[0], x1[1]); o1.y = pk2(x1[2], x1[3]); o2.x = pk2(x2[0], x2[1]); o2.y = pk2(x2[2], x2[3]);
                        *(u32x2*)(prow_p + colb + 16 * n + 4 * fq) = o1; *(u32x2*)(prow_p + colb + 32 + 16 * n + 4 * fq) = o2;
                    }
                } else {
#pragma unroll
                    for (int bj = 0; bj < 2; ++bj)
#pragma unroll
                        for (int n = 0; n < 2; ++n) { const int col = 256 * pn + 128 * bj + 32 * wc + 16 * n + 4 * fq;
                            if (col < DIN) { const f32x4 x1 = acc[ai][bj][m][n] * rs + *(const f32x4*)(bia + col); u32x2 o; o.x = pk2(x1[0], x1[1]); o.y = pk2(x1[2], x1[3]); *(u32x2*)(prow_p + col) = o; } }
                }
            }
    }
};

__device__ __forceinline__ void phase_p1(Frame& F, int l) {
    pg8::Gemm g{(const bf16_t*)(F.ws + WS_VN), (const bf16_t*)(F.ws + WS_WIN) + (size_t)l * DINP * D, MALL, DINP, D};
    Order S; S.init(NTILE, DINP, F.G, (int)F.bid, 0);
    EpiIn E{F.ws, l};
    pg8::gemm_phase<EpiIn, Order, true, true>(F.lds, g, S, E, F.tid);
}
struct EpiRes {
    static constexpr bool PERM = false, AFTER_DRAIN = false;
    unsigned char* ws; const float* xin; const float* ctxin; float* out; LAS float* red; int l, kind;
    __device__ __forceinline__ void operator()(const f32x4 (&acc)[2][2][4][2], const Unit& u, int wr, int wc, int fr, int fq) const {
        { const int ln = (int)__builtin_amdgcn_mbcnt_hi(~0u, __builtin_amdgcn_mbcnt_lo(~0u, 0u)); fr = ln & 15; fq = ln >> 4; asm volatile("" : "+v"(fr), "+v"(fq)); }
        const float* MOD = (const float*)(ws + WS_MOD);
        const int b = u.pm / TPB, j = u.pm % TPB; const bool lat = j != 0; const int v = lat ? b : 8;
        const float* gate = MOD + ((size_t)l * 9 + v) * NMOD * D + (kind == 0 ? 2 : 5) * D;
        const bool do_vn = kind == 0 || l == 0;
        const float* scp = kind == 0 ? MOD + ((size_t)l * 9 + v) * NMOD * D + 4 * D : MOD + ((size_t)(l + 1) * 9 + v) * NMOD * D + 1 * D;
        const float* gainp = (const float*)(ws + WS_GAIN) + (kind == 0 ? (2 + l) : (l + 1)) * D;
        float* SSd = (float*)(ws + (kind == 0 ? WS_SS2 : WS_SS1));
        bf16_t* VN = (bf16_t*)(ws + WS_VN); float* XC = (float*)(ws + WS_XC);
        const bool first = kind == 0 && l == 0;
        const float* srcb = lat ? (first ? xin : out) + (size_t)b * T * D : (first ? ctxin : XC) + (size_t)b * C * D;
        float* dstb = lat ? out + (size_t)b * T * D : XC + (size_t)b * C * D;
        const int rbase = lat ? (j - 1) * 256 : 0;
#pragma unroll
        for (int ai = 0; ai < 2; ++ai)
#pragma unroll
            for (int m = 0; m < 4; ++m) {
                const int rloc = ai * 128 + wr * 64 + m * 16 + fr; const size_t g = (size_t)u.pm * 256 + rloc; const size_t ro = (size_t)(rbase + rloc) * D;
                float ss = 0.f;
#pragma unroll
                for (int bj = 0; bj < 2; ++bj)
#pragma unroll
                    for (int n = 0; n < 2; ++n) { const int c = 256 * u.pn + 128 * bj + 32 * wc + 16 * n + 4 * fq;
                        const f32x4 xo = *(const f32x4*)(srcb + ro + c); const f32x4 gt = *(const f32x4*)(gate + c);
                        const f32x4 x = xo + gt * acc[ai][bj][m][n];
                        *(f32x4*)(dstb + ro + c) = x;
                        if (do_vn) { const f32x4 gn = *(const f32x4*)(gainp + c); const f32x4 sc = *(const f32x4*)(scp + c); const f32x4 vn = x * gn * (sc + 1.0f);
                            u32x2 o; o.x = pk2(vn[0], vn[1]); o.y = pk2(vn[2], vn[3]); *(u32x2*)(VN + g * D + c) = o;
                            ss += x[0] * x[0] + x[1] * x[1] + x[2] * x[2] + x[3] * x[3]; } }
                if (do_vn) { ss += __shfl_xor(ss, 16); ss += __shfl_xor(ss, 32); if (fq == 0) red[wc * 256 + rloc] = ss; }
            }
        if (do_vn) {
            asm volatile("s_waitcnt lgkmcnt(0)" ::: "memory"); __builtin_amdgcn_s_barrier(); asm volatile("" ::: "memory");
            const int tid = 64 * (4 * wr + wc) + 16 * fq + fr;
            if (tid < 256) SSd[((size_t)u.pm * 256 + tid) * 4 + u.pn] = (red[tid] + red[256 + tid]) + (red[512 + tid] + red[768 + tid]);
        }
    }
};

struct EpiUp {
    static constexpr bool PERM = false, AFTER_DRAIN = false;
    unsigned char* ws; LAS float* ex; int l;
    __device__ __forceinline__ void operator()(const f32x4 (&acc)[2][2][4][2], const Unit& u, int wr, int wc, int fr, int fq) const {
        { const int ln = (int)__builtin_amdgcn_mbcnt_hi(~0u, __builtin_amdgcn_mbcnt_lo(~0u, 0u)); fr = ln & 15; fq = ln >> 4; asm volatile("" : "+v"(fr), "+v"(fq)); }
        const float* SS = (const float*)(ws + WS_SS2); const float* ffp = (const float*)(ws + WS_FFNP) + (size_t)l * 4 * DFF;
        const int b = u.pm / TPB, j = u.pm % TPB; const int v = j != 0 ? b : 8;
        const float* bia = (const float*)(ws + WS_BIAS2) + ((size_t)l * 9 + v) * 2 * DFF;
        bf16_t* U = (bf16_t*)(ws + WS_U); float* SIDE = (float*)(ws + WS_SIDE) + (size_t)u.pm * 6 * DFF;
        const int lane = fr + 16 * fq;
        float rsv[2][4];
#pragma unroll
        for (int ai = 0; ai < 2; ++ai)
#pragma unroll
            for (int m = 0; m < 4; ++m) { const size_t g = (size_t)u.pm * 256 + ai * 128 + wr * 64 + m * 16 + fr; const f32x4 s4 = *(const f32x4*)(SS + g * 4);
                rsv[ai][m] = 1.0f / sqrtf((s4[0] + s4[1] + s4[2] + s4[3]) * (1.0f / D) + EPS); }
#pragma unroll
        for (int ai = 0; ai < 2; ++ai)
#pragma unroll
            for (int n = 0; n < 2; ++n) { const int q = 2 * ai + wr; const int cc = 32 * wc + 16 * n + 4 * fq; const f32x4 b4 = *(const f32x4*)(bia + 128 * u.pn + cc);
                if (fr == 0) *(LAS f32x4*)(ex + (q * 2 + 0) * 128 + cc) = acc[ai][0][0][n] * rsv[ai][0] + b4;
                if (fr == 15) *(LAS f32x4*)(ex + (q * 2 + 1) * 128 + cc) = acc[ai][0][3][n] * rsv[ai][3] + b4; }
        asm volatile("s_waitcnt lgkmcnt(0)" ::: "memory"); __builtin_amdgcn_s_barrier(); asm volatile("" ::: "memory");
        const int srcp = (lane & 48) | ((fr + 15) & 15), srcn = (lane & 48) | ((fr + 1) & 15);
#pragma unroll
        for (int ai = 0; ai < 2; ++ai) {
            const int q = 2 * ai + wr;
#pragma unroll
            for (int n = 0; n < 2; ++n) {
                const int cc = 32 * wc + 16 * n + 4 * fq; const int ch = 128 * u.pn + cc;
                const f32x4 b4 = *(const f32x4*)(bia + ch), bv4 = *(const f32x4*)(bia + DFF + ch);
                const f32x4 w0 = *(const f32x4*)(ffp + ch), w1 = *(const f32x4*)(ffp + DFF + ch), w2 = *(const f32x4*)(ffp + 2 * DFF + ch), fb = *(const f32x4*)(ffp + 3 * DFF + ch);
                f32x4 pb = (f32x4){0.f, 0.f, 0.f, 0.f}, nb = pb;
                if (q > 0) pb = *(const LAS f32x4*)(ex + ((q - 1) * 2 + 1) * 128 + cc);
                if (q < 3) nb = *(const LAS f32x4*)(ex + ((q + 1) * 2 + 0) * 128 + cc);
                f32x4 Gm[4];
#pragma unroll
                for (int m = 0; m < 4; ++m) Gm[m] = acc[ai][0][m][n] * rsv[ai][m] + b4;
#pragma unroll
                for (int m = 0; m < 4; ++m) {
                    const f32x4 sp = (fr == 15 && m > 0) ? Gm[m > 0 ? m - 1 : 0] : Gm[m], sn = (fr == 0 && m < 3) ? Gm[m < 3 ? m + 1 : 3] : Gm[m];
                    f32x4 prev, next;
#pragma unroll
                    for (int e = 0; e < 4; ++e) { prev[e] = __shfl(sp[e], srcp, 64); next[e] = __shfl(sn[e], srcn, 64); }
                    if (m == 0 && fr == 0) prev = pb;
                    if (m == 3 && fr == 15) next = nb;
                    const f32x4 pre = fb + w0 * prev + w1 * Gm[m] + w2 * next;
                    const f32x4 val = acc[ai][1][m][n] * rsv[ai][m] + bv4;
                    f32x4 uu;
#pragma unroll
                    for (int e = 0; e < 4; ++e) uu[e] = pre[e] / (1.0f + __expf(-pre[e])) * val[e];
                    const int rloc = ai * 128 + wr * 64 + m * 16 + fr; const size_t g = (size_t)u.pm * 256 + rloc;
                    u32x2 o; o.x = pk2(uu[0], uu[1]); o.y = pk2(uu[2], uu[3]); *(u32x2*)(U + g * DFF + ch) = o;
                    if (rloc == 0) { *(f32x4*)(SIDE + 0 * DFF + ch) = pre; *(f32x4*)(SIDE + 1 * DFF + ch) = val; *(f32x4*)(SIDE + 2 * DFF + ch) = Gm[m]; }
                    if (rloc == 255) { *(f32x4*)(SIDE + 3 * DFF + ch) = pre; *(f32x4*)(SIDE + 4 * DFF + ch) = val; *(f32x4*)(SIDE + 5 * DFF + ch) = Gm[m]; }
                }
                asm volatile("" ::: "memory");
            }
        }
        asm volatile("s_waitcnt lgkmcnt(0)" ::: "memory"); __builtin_amdgcn_s_barrier(); asm volatile("" ::: "memory");
    }
};

__device__ __forceinline__ void phase_p3(Frame& F, int l) {
    pg8::Gemm g{(const bf16_t*)(F.ws + WS_Y), (const bf16_t*)(F.ws + WS_WOUT) + (size_t)l * D * DMIX, MALL, D, DMIX};
    Order S; S.init(l == 0 ? NTILE : NB * 16, D, F.G, F.bid, l == 0 ? 0 : 1);
    EpiRes E{F.ws, F.in_(0), F.in_(2), F.out, (LAS float*)(F.lds + 131072 + 4096), l, 0};
    pg8::gemm_phase<EpiRes, Order, true, true>(F.lds, g, S, E, F.tid);
}
__device__ __forceinline__ void phase_p4(Frame& F, int l) {
    pg8::Gemm g{(const bf16_t*)(F.ws + WS_VN), (const bf16_t*)(F.ws + WS_WUP) + (size_t)l * 2 * DFF * D, MALL, 2 * DFF, D};
    Order S; S.init(l == 0 ? NTILE : NB * 16, 2 * DFF, F.G, F.bid, l == 0 ? 0 : 1);
    EpiUp E{F.ws, (LAS float*)(F.lds + 131072), l};
    pg8::gemm_phase<EpiUp, Order, true, true>(F.lds, g, S, E, F.tid);
}
__device__ __forceinline__ void phase_p5(Frame& F, int l) {
    Order S; S.init(l == 0 ? NTILE : NB * 16, D, F.G, F.bid, l == 0 ? 0 : 1);
    { const float* SIDE = (const float*)(F.ws + WS_SIDE); const float* ffp = (const float*)(F.ws + WS_FFNP) + (size_t)l * 4 * DFF; bf16_t* U = (bf16_t*)(F.ws + WS_U);
      Unit u;
      for (int i = 0; S.next(i, u); ++i) { const int pm = u.pm, j = pm % TPB;
          for (int ch = F.tid; ch < DFF; ch += NTHREADS) {
              if (j >= 2) { const float pre = SIDE[((size_t)pm * 6 + 0) * DFF + ch] + ffp[ch] * SIDE[((size_t)(pm - 1) * 6 + 5) * DFF + ch];
                  U[(size_t)pm * 256 * DFF + ch] = (bf16_t)f2bf(pre / (1.0f + __expf(-pre)) * SIDE[((size_t)pm * 6 + 1) * DFF + ch]); }
              if (j >= 1 && j <= 15) { const float pre = SIDE[((size_t)pm * 6 + 3) * DFF + ch] + ffp[2 * DFF + ch] * SIDE[((size_t)(pm + 1) * 6 + 2) * DFF + ch];
                  U[((size_t)pm * 256 + 255) * DFF + ch] = (bf16_t)f2bf(pre / (1.0f + __expf(-pre)) * SIDE[((size_t)pm * 6 + 4) * DFF + ch]); }
          } }
      asm volatile("s_waitcnt vmcnt(0)" ::: "memory"); __syncthreads(); }
    pg8::Gemm g{(const bf16_t*)(F.ws + WS_U), (const bf16_t*)(F.ws + WS_WDN) + (size_t)l * D * DFF, MALL, D, DFF};
    EpiRes E{F.ws, F.in_(0), F.in_(2), F.out, (LAS float*)(F.lds + 131072 + 4096), l, 1};
    pg8::gemm_phase<EpiRes, Order, true, true>(F.lds, g, S, E, F.tid);
}
typedef short bf16x8 __attribute__((ext_vector_type(8)));
typedef short s16x4 __attribute__((ext_vector_type(4)));
typedef float f32x16 __attribute__((ext_vector_type(16)));
typedef float f32x2_t __attribute__((ext_vector_type(2))); typedef __bf16 bf16x2_t __attribute__((ext_vector_type(2)));
__device__ __forceinline__ unsigned cvtpk(float lo, float hi) { f32x2_t v = {lo, hi}; bf16x2_t b = __builtin_convertvector(v, bf16x2_t); return __builtin_bit_cast(unsigned, b); }
__device__ __forceinline__ int crow(int r, int hi) { return (r & 3) + 8 * (r >> 2) + 4 * hi; }
typedef short v4i16_t __attribute__((ext_vector_type(4)));
__device__ __forceinline__ s16x4 vtr(const LAS unsigned char* p) { return __builtin_bit_cast(s16x4, __builtin_amdgcn_ds_read_tr16_b64_v4i16((LAS v4i16_t*)p)); }

constexpr int ATT_KV_BYTES = 8192;
__device__ __forceinline__ void att_stage(const bf16_t* Krow0, const bf16_t* Vrow0, LAS unsigned char* kbuf, LAS unsigned char* vbuf, int wave, int lane) {
    const bf16_t* ks = Krow0 + (size_t)lane * DINP + wave * 8;
    const bf16_t* vs = Vrow0 + (size_t)(16 * (wave & 3) + (lane >> 2)) * DINP + (wave >> 2) * 32 + (lane & 3) * 8;
    __builtin_amdgcn_global_load_lds((const unsigned*)ks, (LAS unsigned*)(kbuf + wave * 1024), 16, 0, 0);
    __builtin_amdgcn_global_load_lds((const unsigned*)vs, (LAS unsigned*)(vbuf + wave * 1024), 16, 0, 0);
}
template <int NK> __device__ __forceinline__ f32x16 att_qk(const LAS unsigned char* kbuf, int d0, int kh, const bf16x8* qr, f32x16 cinit, int r32, int hi) {
    f32x16 s = cinit;
#pragma unroll
    for (int i = 0; i < NK; ++i) { const bf16x8 kf = *(const LAS bf16x8*)(kbuf + (2 * (d0 + i) + hi) * 1024 + (kh * 32 + r32) * 16); s = __builtin_amdgcn_mfma_f32_32x32x16_bf16(kf, qr[i], s, 0, 0, 0); }
    return s;
}
__device__ __forceinline__ bf16x8 att_vfrag(const LAS unsigned char* vbuf, int dh, int ks, int lane, int hi) {
    const LAS unsigned char* p = vbuf + (dh * 4 + ks) * 1024 + ((lane >> 4) & 1) * 32 + (lane & 3) * 8 + (4 * hi + ((lane & 15) >> 2)) * 64;
    const s16x4 lo = vtr(p), hh = vtr(p + 512);
    return (bf16x8){lo[0], lo[1], lo[2], lo[3], hh[0], hh[1], hh[2], hh[3]};
}
__device__ __forceinline__ float half_swap_sum(float v) { return v + __shfl_xor(v, 32); }

__device__ __forceinline__ void da_unit(Frame& F, int l, int b, int h, int q0, int nkeys) {
    int lane_ = (int)__builtin_amdgcn_mbcnt_hi(~0u, __builtin_amdgcn_mbcnt_lo(~0u, 0u)); asm volatile("" : "+v"(lane_));
    const int lane = lane_, wave = F.wave, r32 = lane & 31, hi = lane >> 5;
    const bf16_t* P = (const bf16_t*)(F.ws + WS_P) + (size_t)b * RB * DINP;
    const float* par = (const float*)(F.ws + WS_PAR) + l * PAR_STRIDE;
    LAS unsigned char* kb0 = F.lds; LAS unsigned char* vb0 = F.lds + 2 * ATT_KV_BYTES;
    LAS float* wsf = (LAS float*)(F.lds + 4 * ATT_KV_BYTES) + wave * 128;
    const bf16_t* Kp = P + O_AK + h * 64; const bf16_t* Vp = P + O_AV + h * 64;
    const int NT = nkeys / 64;
    att_stage(Kp, Vp, kb0, vb0, wave, lane);
    bf16x8 qr[4];
#pragma unroll
    for (int d0 = 0; d0 < 4; ++d0) qr[d0] = *(const bf16x8*)(P + (size_t)(q0 + wave * 32 + r32) * DINP + O_AQ + h * 64 + d0 * 16 + hi * 8);
    const float negM = -par[PR_MA];
    f32x16 cinit;
#pragma unroll
    for (int r = 0; r < 16; ++r) cinit[r] = negM;
    f32x16 o[2][2];
#pragma unroll
    for (int m = 0; m < 2; ++m)
#pragma unroll
        for (int dh = 0; dh < 2; ++dh)
#pragma unroll
            for (int r = 0; r < 16; ++r) o[m][dh][r] = 0.f;
    float lsum[2] = {0.f, 0.f};
    asm volatile("s_waitcnt vmcnt(0)" ::: "memory"); __syncthreads();
    for (int t = 0; t < NT; ++t) {
        const int cur = t & 1;
        if (t + 1 < NT) att_stage(Kp + (size_t)(t + 1) * 64 * DINP, Vp + (size_t)(t + 1) * 64 * DINP, kb0 + (cur ^ 1) * ATT_KV_BYTES, vb0 + (cur ^ 1) * ATT_KV_BYTES, wave, lane);
        const LAS unsigned char* kb = kb0 + cur * ATT_KV_BYTES; const LAS unsigned char* vb = vb0 + cur * ATT_KV_BYTES;
        unsigned pw[2][4][4];
#pragma unroll
        for (int m = 0; m < 2; ++m)
#pragma unroll
            for (int kh = 0; kh < 2; ++kh) {
                f32x16 s = att_qk<2>(kb, 2 * m, kh, qr + 2 * m, cinit, r32, hi);
                float acc = 0.f;
#pragma unroll
                for (int r = 0; r < 16; ++r) { s[r] = __builtin_amdgcn_exp2f(s[r]); acc += s[r]; }
                lsum[m] += acc;
#pragma unroll
                for (int i = 0; i < 4; ++i) { pw[m][2 * kh][i] = cvtpk(s[2 * i], s[2 * i + 1]); pw[m][2 * kh + 1][i] = cvtpk(s[8 + 2 * i], s[8 + 2 * i + 1]); }
                __builtin_amdgcn_sched_barrier(0);
            }
#pragma unroll
        for (int dh = 0; dh < 2; ++dh)
#pragma unroll
            for (int ks = 0; ks < 4; ++ks) {
                const bf16x8 vf = att_vfrag(vb, dh, ks, lane, hi);
#pragma unroll
                for (int m = 0; m < 2; ++m) { const u32x4 pa = (u32x4){pw[m][ks][0], pw[m][ks][1], pw[m][ks][2], pw[m][ks][3]};
                    o[m][dh] = __builtin_amdgcn_mfma_f32_32x32x16_bf16(__builtin_bit_cast(bf16x8, pa), vf, o[m][dh], 0, 0, 0); }
            }
        asm volatile("s_waitcnt vmcnt(0)" ::: "memory"); __syncthreads();
    }
    const float lam = par[PR_LAM], li = par[PR_LI];
    lsum[0] = half_swap_sum(lsum[0]); lsum[1] = half_swap_sum(lsum[1]);
    if (hi == 0) { wsf[r32] = 1.0f / lsum[0]; wsf[32 + r32] = lam / lsum[1]; }
    LDS_WAIT();
    float ss[16];
#pragma unroll
    for (int r = 0; r < 16; ++r) { const int row = crow(r, hi); const float i0 = wsf[row], i1 = wsf[32 + row];
        float sq = 0.f;
#pragma unroll
        for (int dh = 0; dh < 2; ++dh) { const float v = o[0][dh][r] * i0 - o[1][dh][r] * i1; o[0][dh][r] = v; sq += v * v; }
        ss[r] = sq; }
#pragma unroll
    for (int sh = 1; sh < 32; sh <<= 1)
#pragma unroll
        for (int r = 0; r < 16; ++r) ss[r] += __shfl_xor(ss[r], sh);
    bf16_t* Y = (bf16_t*)(F.ws + WS_Y) + ((size_t)b * RB + q0 + wave * 32) * D + h * 64;
#pragma unroll
    for (int dh = 0; dh < 2; ++dh) { const float gsc = par[PR_SUBG + 32 * dh + r32] * (1.0f - li);
#pragma unroll
        for (int r = 0; r < 16; ++r) { const float rs = 1.0f / sqrtf(ss[r] * (1.0f / 64.f) + EPS);
            Y[(size_t)crow(r, hi) * D + 32 * dh + r32] = (bf16_t)f2bf(o[0][dh][r] * rs * gsc); } }
    __syncthreads();
}

__device__ __forceinline__ void sw_unit(Frame& F, int l, int b, int kv, int q0, int g) {
    int lane_ = (int)__builtin_amdgcn_mbcnt_hi(~0u, __builtin_amdgcn_mbcnt_lo(~0u, 0u)); asm volatile("" : "+v"(lane_));
    const int lane = lane_, wave = F.wave, r32 = lane & 31, hi = lane >> 5;
    const bf16_t* P = (const bf16_t*)(F.ws + WS_P) + (size_t)b * RB * DINP;
    const float* par = (const float*)(F.ws + WS_PAR) + l * PAR_STRIDE;
    LAS unsigned char* kb0 = F.lds; LAS unsigned char* vb0 = F.lds + 2 * ATT_KV_BYTES;
    LAS float* wsf = (LAS float*)(F.lds + 4 * ATT_KV_BYTES) + wave * 128;
    const bf16_t* Kp = P + O_BK + kv * 64; const bf16_t* Vp = P + O_BV + kv * 64;
    const bool lat = q0 != 0;
    const int pos0 = q0 - C;
    const int band_lo = lat ? (pos0 - 128 < 0 ? 0 : pos0 - 128) : 0, band_hi = lat ? (pos0 + 384 > T ? T : pos0 + 384) : 0;
    const int NT = 4 + (band_hi - band_lo) / 64;
    const int qpos = pos0 + wave * 32 + r32;
    att_stage(Kp, Vp, kb0, vb0, wave, lane);
    bf16x8 qr[4];
#pragma unroll
    for (int d0 = 0; d0 < 4; ++d0) qr[d0] = *(const bf16x8*)(P + (size_t)(q0 + wave * 32 + r32) * DINP + O_BQ + (kv * 3 + g) * 64 + d0 * 16 + hi * 8);
    const float negM = -par[PR_MB];
    f32x16 cinit;
#pragma unroll
    for (int r = 0; r < 16; ++r) cinit[r] = negM;
    f32x16 o[2];
    float lsum = hi == 0 ? __builtin_amdgcn_exp2f(par[PR_SINK + kv * 3 + g] * LOG2E + negM) : 0.f;
#pragma unroll
    for (int dh = 0; dh < 2; ++dh)
#pragma unroll
        for (int r = 0; r < 16; ++r) o[dh][r] = 0.f;
    asm volatile("s_waitcnt vmcnt(0)" ::: "memory"); __syncthreads();
    for (int t = 0; t < NT; ++t) {
        const int cur = t & 1;
        if (t + 1 < NT) { const int nr = (t + 1 < 4) ? (t + 1) * 64 : C + band_lo + (t + 1 - 4) * 64;
            att_stage(Kp + (size_t)nr * DINP, Vp + (size_t)nr * DINP, kb0 + (cur ^ 1) * ATT_KV_BYTES, vb0 + (cur ^ 1) * ATT_KV_BYTES, wave, lane); }
        const LAS unsigned char* kb = kb0 + cur * ATT_KV_BYTES; const LAS unsigned char* vb = vb0 + cur * ATT_KV_BYTES;
        const int kpos0 = band_lo + (t - 4) * 64;
        const int wlo = pos0 + wave * 32 - 128, whi = pos0 + wave * 32 + 31 + 128;
        const bool band = t >= 4;
        const bool active = !band || (kpos0 + 63 >= wlo && kpos0 <= whi);
        if (active) {
            const bool need_mask = band && (kpos0 < wlo + 31 || kpos0 + 63 > whi - 31);
            {
                unsigned pw[4][4];
#pragma unroll
                for (int kh = 0; kh < 2; ++kh) {
                    f32x16 s = att_qk<4>(kb, 0, kh, qr, cinit, r32, hi);
                    float acc = 0.f;
#pragma unroll
                    for (int r = 0; r < 16; ++r) { float p = __builtin_amdgcn_exp2f(s[r]);
                        if (need_mask) { const int d = qpos - (kpos0 + kh * 32 + crow(r, hi)); p = (d > 128 || d < -128) ? 0.f : p; }
                        s[r] = p; acc += p; }
                    lsum += acc;
#pragma unroll
                    for (int i = 0; i < 4; ++i) { pw[2 * kh][i] = cvtpk(s[2 * i], s[2 * i + 1]); pw[2 * kh + 1][i] = cvtpk(s[8 + 2 * i], s[8 + 2 * i + 1]); }
                }
#pragma unroll
                for (int dh = 0; dh < 2; ++dh)
#pragma unroll
                    for (int ks = 0; ks < 4; ++ks) { const bf16x8 vf = att_vfrag(vb, dh, ks, lane, hi); const u32x4 pa = (u32x4){pw[ks][0], pw[ks][1], pw[ks][2], pw[ks][3]};
                        o[dh] = __builtin_amdgcn_mfma_f32_32x32x16_bf16(__builtin_bit_cast(bf16x8, pa), vf, o[dh], 0, 0, 0); }
            }
        }
        asm volatile("s_waitcnt vmcnt(0)" ::: "memory"); __syncthreads();
    }
    { const float lt = half_swap_sum(lsum); if (hi == 0) wsf[r32] = 1.0f / lt; }
    LDS_WAIT();
    bf16_t* Y = (bf16_t*)(F.ws + WS_Y) + ((size_t)b * RB + q0 + wave * 32) * D + 256 + kv * 192;
#pragma unroll
    for (int r = 0; r < 16; ++r) { const int row = crow(r, hi); const float il = wsf[row];
#pragma unroll
        for (int dh = 0; dh < 2; ++dh) Y[(size_t)row * D + g * 64 + 32 * dh + r32] = (bf16_t)f2bf(o[dh][r] * il); }
    __syncthreads();
}

constexpr int LRU_XS = 0, LRU_XCB = 67584, LRU_WT = LRU_XCB + 32768, LRU_EXC = LRU_WT + 16384, LRU_HIN = LRU_EXC + 4096;
__device__ __forceinline__ void lru_item(Frame& F, int l, int pm, int hb, int stage) {
    int lane_ = (int)__builtin_amdgcn_mbcnt_hi(~0u, __builtin_amdgcn_mbcnt_lo(~0u, 0u)); asm volatile("" : "+v"(lane_));
    const int lane = lane_, wave = F.wave, tid = wave * 64 + lane, r32 = lane & 31, hi = lane >> 5;
    const int b = pm / TPB, j = pm % TPB; const int L = j == 0 ? C : T, t0 = j == 0 ? 0 : (j - 1) * 256;
    const bf16_t* P = (const bf16_t*)(F.ws + WS_P) + (size_t)pm * 256 * DINP;
    LAS float* XS = (LAS float*)(F.lds + LRU_XS); LAS unsigned short* XCb = (LAS unsigned short*)(F.lds + LRU_XCB); LAS unsigned short* WT = (LAS unsigned short*)(F.lds + LRU_WT);
    LAS float* EXC = (LAS float*)(F.lds + LRU_EXC); LAS float* HIN = (LAS float*)(F.lds + LRU_HIN);
    float* SUM = (float*)(F.ws + WS_LRU);
    for (int e = tid; e < 262 * 8; e += NTHREADS) { const int row = e >> 3, cc = e & 7; const int rl = row - 3, tt = t0 + rl;
        f32x4 lo = (f32x4){0.f, 0.f, 0.f, 0.f}, hh = lo;
        if (tt >= 0 && tt < L) { const u32x4 v = *(const u32x4*)(P + (ptrdiff_t)rl * DINP + O_CX + 64 * hb + 8 * cc);
            lo = (f32x4){__builtin_bit_cast(float, v.x << 16), __builtin_bit_cast(float, v.x & 0xffff0000u), __builtin_bit_cast(float, v.y << 16), __builtin_bit_cast(float, v.y & 0xffff0000u)};
            hh = (f32x4){__builtin_bit_cast(float, v.z << 16), __builtin_bit_cast(float, v.z & 0xffff0000u), __builtin_bit_cast(float, v.w << 16), __builtin_bit_cast(float, v.w & 0xffff0000u)}; }
        *(LAS f32x4*)(XS + row * 64 + 8 * cc) = lo; *(LAS f32x4*)(XS + row * 64 + 8 * cc + 4) = hh; }
    if (stage == 1 && tid < 128) { const int d = tid >> 6, ch = tid & 63; const int pm0 = b * TPB; float h = 0.f;
        if (d == 0) { for (int jj = 0; jj < j; ++jj) { const float* s = SUM + (((size_t)(pm0 + jj) * 2 + 0) * LW + 64 * hb + ch) * 2; h = s[0] * h + s[1]; } }
        else if (j != 0) { { const float* s = SUM + (((size_t)pm0 * 2 + 1) * LW + 64 * hb + ch) * 2; h = s[1]; }
            for (int jj = 16; jj > j; --jj) { const float* s = SUM + (((size_t)(pm0 + jj) * 2 + 1) * LW + 64 * hb + ch) * 2; h = s[0] * h + s[1]; } }
        HIN[tid] = h; }
    f32x16 Hf[2];
#pragma unroll
    for (int d = 0; d < 2; ++d) {
        __syncthreads();
        const float* cw = F.in_(19) + ((size_t)(l * 2 + d) * 4) * LW + 64 * hb; const float* cb = F.in_(20) + (size_t)(l * 2 + d) * LW + 64 * hb;
        { const float* wa = F.in_(21) + (size_t)((l * 2 + d) * 6 + hb) * 4096; const float* wx = F.in_(23) + (size_t)((l * 2 + d) * 6 + hb) * 4096;
          for (int e = tid; e < 8192; e += NTHREADS) { const int which = e >> 12, i = (e >> 6) & 63, o = e & 63; WT[(which * 64 + o) * 64 + i] = (unsigned short)f2bf((which ? wx : wa)[i * 64 + o]); } }
        { const int c = tid & 63; const float w0 = cw[0 * LW + c], w1 = cw[1 * LW + c], w2 = cw[2 * LW + c], w3 = cw[3 * LW + c], bb = cb[c];
          for (int i = 0; i < 32; ++i) { const int rl = (tid >> 6) + 8 * i; const LAS float* x = XS + (rl + 3) * 64 + c;
              const float v = d == 0 ? bb + w0 * x[-3 * 64] + w1 * x[-2 * 64] + w2 * x[-1 * 64] + w3 * x[0] : bb + w0 * x[3 * 64] + w1 * x[2 * 64] + w2 * x[1 * 64] + w3 * x[0];
              XCb[rl * 64 + c] = (unsigned short)f2bf(v); } }
        __syncthreads();
        f32x16 acc[4];
#pragma unroll
        for (int nt = 0; nt < 4; ++nt)
#pragma unroll
            for (int r = 0; r < 16; ++r) acc[nt][r] = 0.f;
#pragma unroll
        for (int ks = 0; ks < 4; ++ks) { const bf16x8 af = *(const LAS bf16x8*)((const LAS unsigned char*)XCb + (wave * 32 + r32) * 128 + (16 * ks + 8 * hi) * 2);
#pragma unroll
            for (int nt = 0; nt < 4; ++nt) { const bf16x8 bf = *(const LAS bf16x8*)((const LAS unsigned char*)WT + (32 * nt + r32) * 128 + (16 * ks + 8 * hi) * 2);
                acc[nt] = __builtin_amdgcn_mfma_f32_32x32x16_bf16(af, bf, acc[nt], 0, 0, 0); } }
#pragma unroll
        for (int chh = 0; chh < 2; ++chh) { const int ch = 32 * chh + r32; const int gch = (l * 2 + d) * LW + 64 * hb + ch;
            const float ba = F.in_(22)[gch], bx = F.in_(24)[gch], lp = F.in_(25)[gch];
            const float sp = lp > 0.f ? log1pf(__expf(-lp)) : -lp + log1pf(__expf(lp));
            const float w0 = cw[0 * LW + ch], w1 = cw[1 * LW + ch], w2 = cw[2 * LW + ch], w3 = cw[3 * LW + ch], bb = cb[ch];
#pragma unroll
            for (int r = 0; r < 16; ++r) { const int rl = wave * 32 + crow(r, hi); const LAS float* x = XS + (rl + 3) * 64 + ch;
                const float xc = d == 0 ? bb + w0 * x[-3 * 64] + w1 * x[-2 * 64] + w2 * x[-1 * 64] + w3 * x[0] : bb + w0 * x[3 * 64] + w1 * x[2 * 64] + w2 * x[1 * 64] + w3 * x[0];
                const float rg = 1.0f / (1.0f + __expf(-(acc[chh][r] + ba))), ig = 1.0f / (1.0f + __expf(-(acc[2 + chh][r] + bx)));
                const float av = __expf(-8.0f * rg * sp);
                acc[chh][r] = av; acc[2 + chh][r] = sqrtf(fmaxf(1.0f - av * av, 0.f)) * (ig * xc); } }
#pragma unroll
        for (int chh = 0; chh < 2; ++chh) {
            float sA[4], sB[4], pA[4], pB[4];
#pragma unroll
            for (int q = 0; q < 4; ++q) { float A_ = 1.f, B_ = 0.f;
#pragma unroll
                for (int e = 0; e < 4; ++e) { const int r = 4 * q + (d == 0 ? e : 3 - e); B_ = acc[chh][r] * B_ + acc[2 + chh][r]; A_ *= acc[chh][r]; }
                sA[q] = A_; sB[q] = B_; }
#pragma unroll
            for (int q = 0; q < 4; ++q) { pA[q] = __shfl_xor(sA[q], 32); pB[q] = __shfl_xor(sB[q], 32); }
            float blkA = 1.f, blkH = 0.f;
#pragma unroll
            for (int k = 0; k < 8; ++k) { const int s = d == 0 ? k : 7 - k; const int q = s >> 1; const bool own = (s & 1) == hi;
                const float A_ = own ? sA[q] : pA[q], B_ = own ? sB[q] : pB[q]; blkH = A_ * blkH + B_; blkA *= A_; }
            if (hi == 0) { EXC[(wave * 64 + 32 * chh + r32) * 2] = blkA; EXC[(wave * 64 + 32 * chh + r32) * 2 + 1] = blkH; }
        }
        LDS_WAIT(); __syncthreads();
#pragma unroll
        for (int chh = 0; chh < 2; ++chh) { const int ch = 32 * chh + r32;
            float h = stage == 1 ? HIN[d * 64 + ch] : 0.f;
            float totA = 1.f, totH = 0.f;
#pragma unroll
            for (int k = 0; k < 8; ++k) { const int w = d == 0 ? k : 7 - k; const float A_ = EXC[(w * 64 + ch) * 2], H_ = EXC[(w * 64 + ch) * 2 + 1];
                const bool before = d == 0 ? (w < wave) : (w > wave);
                if (before) h = A_ * h + H_;
                totH = A_ * totH + H_; totA *= A_; }
            if (stage == 0) { if (wave == 0 && hi == 0) { float* s = SUM + (((size_t)pm * 2 + d) * LW + 64 * hb + ch) * 2; s[0] = totA; s[1] = totH; } }
            else {
                float sA[4], sB[4], pA[4], pB[4];
#pragma unroll
                for (int q = 0; q < 4; ++q) { float A_ = 1.f, B_ = 0.f;
#pragma unroll
                    for (int e = 0; e < 4; ++e) { const int r = 4 * q + (d == 0 ? e : 3 - e); B_ = acc[chh][r] * B_ + acc[2 + chh][r]; A_ *= acc[chh][r]; }
                    sA[q] = A_; sB[q] = B_; }
#pragma unroll
                for (int q = 0; q < 4; ++q) { pA[q] = __shfl_xor(sA[q], 32); pB[q] = __shfl_xor(sB[q], 32); }
                float hq[4];
#pragma unroll
                for (int k = 0; k < 8; ++k) { const int s = d == 0 ? k : 7 - k; const int q = s >> 1; const bool own = (s & 1) == hi;
                    if (own) hq[q] = h;
                    const float A_ = own ? sA[q] : pA[q], B_ = own ? sB[q] : pB[q]; h = A_ * h + B_; }
#pragma unroll
                for (int q = 0; q < 4; ++q) { float hh = hq[q];
#pragma unroll
                    for (int e = 0; e < 4; ++e) { const int r = 4 * q + (d == 0 ? e : 3 - e); hh = acc[chh][r] * hh + acc[2 + chh][r]; acc[2 + chh][r] = hh; } }
                if (d == 0) Hf[chh] = acc[2 + chh];
                else {
                    bf16_t* Y = (bf16_t*)(F.ws + WS_Y) + (size_t)pm * 256 * D + 640 + 64 * hb + ch;
#pragma unroll
                    for (int r = 0; r < 16; ++r) { const int rl = wave * 32 + crow(r, hi);
                        const float g = bf2f(P[(size_t)rl * DINP + O_CG + 64 * hb + ch]);
                        const float u = 0.7978845608028654f * (g + 0.044715f * g * g * g);
                        const float ge = g / (1.0f + __expf(-2.0f * u));
                        Y[(size_t)rl * D] = (bf16_t)f2bf((Hf[chh][r] + acc[2 + chh][r]) * ge); }
                }
            }
        }
    }
    __syncthreads();
}

__device__ __forceinline__ void unit_map16(const Frame& F, int u, int& gi, int& sub) {
    if (F.G == 256) { const int bid = u & 255, rnd = u >> 8, x = bid & 7, k = bid >> 3; gi = rnd * 16 + 2 * x + (k >> 4); sub = k & 15; }
    else { gi = u >> 4; sub = u & 15; }
}
__device__ __forceinline__ void phase_p2a(Frame& F, int l) {
    for (int it = F.bid; it < NTILE * 6; it += F.G) lru_item(F, l, it / 6, it % 6, 0);
    for (int u = F.bid; u < NB * 2 * 16; u += F.G) { int gi, pb; unit_map16(F, u, gi, pb); for (int g = 0; g < 3; ++g) sw_unit(F, l, gi >> 1, gi & 1, C + pb * 256, g); }
    if (l == 0) for (int u = F.bid; u < NB * 2; u += F.G) for (int g = 0; g < 3; ++g) sw_unit(F, l, u >> 1, u & 1, 0, g);
}
__device__ __forceinline__ void phase_p2b(Frame& F, int l) {
    for (int it = F.bid; it < NTILE * 6; it += F.G) { const int pm = it / 6; if (l == 1 && pm % TPB == 0) continue; lru_item(F, l, pm, it % 6, 1); }
    for (int u = F.bid; u < NB * 4 * 16; u += F.G) { int gi, qb; unit_map16(F, u, gi, qb); da_unit(F, l, gi >> 2, gi & 3, C + qb * 256, RB); }
    if (l == 0) for (int u = F.bid; u < NB * 4; u += F.G) da_unit(F, l, u >> 2, u & 3, 0, C);
}
#define XB_TMO      128
#define XB_XCNT(j)  (256  + 64 * (j))
#define XB_XSUB(j)  (1280 + 64 * (j))
#define XB_XGEN(j)  (2304 + 64 * (j))
#define XB_TOP      3328
#define XB_TOPGEN   3392
#define XCD_BAR_WORDS 3456
#define XB_SPIN_CAP (1u << 18)

__device__ __forceinline__ unsigned xb_ld(unsigned* p)              { return __hip_atomic_load(p, __ATOMIC_RELAXED, __HIP_MEMORY_SCOPE_AGENT); }
__device__ __forceinline__ unsigned xb_add(unsigned* p, unsigned v) { return __hip_atomic_fetch_add(p, v, __ATOMIC_RELAXED, __HIP_MEMORY_SCOPE_AGENT); }
__device__ __forceinline__ unsigned xb_xcc_id() { return (unsigned)__builtin_amdgcn_s_getreg((3 << 11) | 20) & 0xFu; }
#define XB_SPIN(cond, bar) do { unsigned _sp = 0; while (cond) { __builtin_amdgcn_s_sleep(1); \
    if ((++_sp & 255u) == 0u) { if (xb_ld(&(bar)[XB_TMO])) break; if (_sp > XB_SPIN_CAP) { atomicAdd(&(bar)[XB_TMO], 1u); break; } } } } while (0)

struct XcdBarrier {
    unsigned* bar; unsigned x;
    volatile LAS unsigned* st;
};

__device__ __forceinline__ XcdBarrier xcd_barrier_post(unsigned* bar, volatile LAS unsigned* st, int tid) {
    XcdBarrier b; b.bar = bar; b.x = xb_xcc_id(); b.st = st;
    if (tid == 0) (void)xb_add(&bar[XB_XCNT(b.x)], 1u);
    return b;
}
__device__ __forceinline__ void xcd_barrier_complete(unsigned* bar, unsigned x, unsigned& nloc, unsigned& nx) {
    const unsigned G = gridDim.x * gridDim.y * gridDim.z;
    unsigned sum, cnt, mine, sp = 0u;
    for (;;) {
        sum = 0u; cnt = 0u; mine = 0u;
#pragma unroll
        for (unsigned j = 0; j < 16; ++j) { const unsigned c = xb_ld(&bar[XB_XCNT(j)]); sum += c; cnt += (c > 0u) ? 1u : 0u; mine = (j == x) ? c : mine; }
        if (sum == G) break;
        __builtin_amdgcn_s_sleep(1);
        if ((++sp & 255u) == 0u) { if (xb_ld(&bar[XB_TMO])) break; if (sp > XB_SPIN_CAP) { atomicAdd(&bar[XB_TMO], 1u); break; } }
    }
    nloc = mine > 0u ? mine : 1u; nx = cnt > 0u ? cnt : 1u;
}

__device__ __forceinline__ void xcd_barrier(const XcdBarrier& b, int tid) {
    asm volatile("s_waitcnt vmcnt(0)" ::: "memory");
    __syncthreads();
    if (tid == 0) {
        unsigned* bar = b.bar;
        __builtin_amdgcn_s_waitcnt(0);
        unsigned nloc = b.st[0], nx = b.st[1];
        if (nloc == 0u) { xcd_barrier_complete(bar, b.x, nloc, nx); b.st[0] = nloc; b.st[1] = nx; }
        const unsigned old = xb_add(&bar[XB_XSUB(b.x)], 1u);
        const unsigned gen = old / nloc;
        if (old + 1u == (gen + 1u) * nloc) {
            __builtin_amdgcn_fence(__ATOMIC_RELEASE, "agent");
            asm volatile("s_waitcnt vmcnt(0)" ::: "memory");
            const unsigned og = xb_add(&bar[XB_TOP], 1u);
            const unsigned tg = og / nx;
            if (og + 1u == (tg + 1u) * nx) xb_add(&bar[XB_TOPGEN], 1u);
            else XB_SPIN(xb_ld(&bar[XB_TOPGEN]) == tg, bar);
            __builtin_amdgcn_fence(__ATOMIC_ACQUIRE, "agent");
            xb_add(&bar[XB_XGEN(b.x)], 1u);
            asm volatile("s_waitcnt vmcnt(0)" ::: "memory");
        } else {
            XB_SPIN(xb_ld(&bar[XB_XGEN(b.x)]) == gen, bar);
            __builtin_amdgcn_fence(__ATOMIC_ACQUIRE, "agent");
            asm volatile("s_waitcnt vmcnt(0)" ::: "memory");
        }
    }
    __syncthreads();
}

constexpr int CW_BAR = 4096;
constexpr int LDS_MISC = 131072 + 8192;
struct Args { const float* in[31]; float* out; unsigned char* ws; int ph_lo, ph_hi; };
constexpr int N_PHASES = 14;
__global__ void __launch_bounds__(NTHREADS, 2) mk_fwd(Args args) {
    extern __shared__ __attribute__((aligned(16))) unsigned char lds_raw[];
    cg::grid_group grid = cg::this_grid();
    Frame F;
    F.lds = (LAS unsigned char*)lds_raw;
    F.G = gridDim.x;
    F.inp = args.in; F.out = args.out;
    const int lo = args.ph_lo, hi = args.ph_hi;
    volatile LAS unsigned* bst = (volatile LAS unsigned*)(F.lds + LDS_MISC);
    if (threadIdx.x < 2) bst[threadIdx.x] = 0u;
    __syncthreads();
    XcdBarrier xbar = xcd_barrier_post((unsigned*)args.ws + CW_BAR, bst, (int)threadIdx.x);
    const int wave0 = __builtin_amdgcn_readfirstlane((int)threadIdx.x >> 6);
#define MK_PHASE(k, CALL) do { if (lo <= (k) && (k) < hi) { \
        { int ln_ = (int)__builtin_amdgcn_mbcnt_hi(~0u, __builtin_amdgcn_mbcnt_lo(~0u, 0u)); asm volatile("" : "+v"(ln_)); int wv_ = wave0; asm volatile("" : "+s"(wv_)); F.lane = ln_; F.wave = wv_; F.tid = wv_ * 64 + ln_; } \
        { int bx = blockIdx.x; asm volatile("" : "+s"(bx)); F.bid = bx; F.vcu = (F.G % 8 == 0) ? (bx % 8) * (F.G / 8) + bx / 8 : bx; } \
        { unsigned char* w_ = args.ws; asm volatile("" : "+s"(w_)); F.ws = w_; int z_ = 0; asm volatile("" : "+s"(z_)); F.zero = z_; } \
        CALL; if ((k) + 1 < hi) { if ((k) == 0) grid.sync(); else xcd_barrier(xbar, wave0 * 64 + (int)__builtin_amdgcn_mbcnt_hi(~0u, __builtin_amdgcn_mbcnt_lo(~0u, 0u))); } } } while (0)
    MK_PHASE(0, phase_p0a(F));
    MK_PHASE(1, phase_p0b(F));
    MK_PHASE(2, phase_p1(F, 0));
    MK_PHASE(3, phase_p2a(F, 0));
    MK_PHASE(4, phase_p2b(F, 0));
    MK_PHASE(5, phase_p3(F, 0));
    MK_PHASE(6, phase_p4(F, 0));
    MK_PHASE(7, phase_p5(F, 0));
    MK_PHASE(8, phase_p1(F, 1));
    MK_PHASE(9, phase_p2a(F, 1));
    MK_PHASE(10, phase_p2b(F, 1));
    MK_PHASE(11, phase_p3(F, 1));
    MK_PHASE(12, phase_p4(F, 1));
    MK_PHASE(13, phase_p5(F, 1));
#undef MK_PHASE
}
}

static int mk_setup() {
    static int grid = 0;
    if (grid == 0) {
        int dev = 0, cus = 0, per_cu = 0;
        hipGetDevice(&dev); hipDeviceGetAttribute(&cus, hipDeviceAttributeMultiprocessorCount, dev);
        hipFuncSetAttribute((const void*)mk::mk_fwd, hipFuncAttributeMaxDynamicSharedMemorySize, mk::LDS_BYTES);
        hipOccupancyMaxActiveBlocksPerMultiprocessor(&per_cu, (const void*)mk::mk_fwd, mk::NTHREADS, mk::LDS_BYTES);
        (void)hipGetLastError();
        if (per_cu < 1) { fprintf(stderr, "mk_setup: occupancy query says %d blocks/CU\n", per_cu); per_cu = 1; }
        grid = cus;
        fprintf(stderr, "mk_setup: cus %d per_cu %d grid %d\n", cus, per_cu, grid);
    }
    return grid;
}
static void mk_run(void* const* d_in, void* d_out, void* d_ws, hipStream_t stream, int lo, int hi, bool coop) {
    const int grid = mk_setup();
    mk::Args a{};
    for (int i = 0; i < 31; ++i) a.in[i] = (const float*)d_in[i];
    a.out = (float*)d_out; a.ws = (unsigned char*)d_ws; a.ph_lo = lo; a.ph_hi = hi;
    if (coop) { void* params[] = {&a}; hipError_t e = hipLaunchCooperativeKernel((const void*)mk::mk_fwd, dim3(grid), dim3(mk::NTHREADS), params, mk::LDS_BYTES, stream);
        if (e != hipSuccess) fprintf(stderr, "coop launch failed: %s\n", hipGetErrorString(e)); }
    else hipLaunchKernelGGL(mk::mk_fwd, dim3(grid), dim3(mk::NTHREADS), mk::LDS_BYTES, stream, a);
}

extern "C" void kernel_launch(void* const* d_in, const int* in_sizes, int n_in, void* d_out, int out_size, void* d_ws, size_t ws_size, hipStream_t stream) {
    if (ws_size < mk::WS_END) { fprintf(stderr, "ws too small\n"); return; }
    hipMemsetAsync(d_ws, 0, mk::MiB, stream);
    mk_run(d_in, d_out, d_ws, stream, 0, mk::N_PHASES, true);
}
```

```cpp
#include <hip/hip_runtime.h>
#include <hip/hip_cooperative_groups.h>
#include <math.h>
#include <stdint.h>
#include <cstdio>
namespace cg = cooperative_groups;
namespace pg8 {
#define PG8_LAS __attribute__((address_space(3)))
typedef unsigned short bf16_t;
typedef short bf16x8 __attribute__((ext_vector_type(8)));
typedef float f32x4 __attribute__((ext_vector_type(4)));
typedef unsigned u32x4 __attribute__((ext_vector_type(4)));
constexpr int BM = 256, BK = 64, HALF = 128, HTB = HALF * BK * 2  , STAGE_BYTES = 8 * HTB, NXCD = 8, WGM = 8;

__host__ __device__ __forceinline__ int lds_byte(int r, int c) { const int st = (r >> 4) * 2 + (c >> 5), rr = r & 15, cc = c & 31, ob = rr * 64 + cc * 2; return st * 1024 + (ob ^ (((ob >> 9) & 1) << 5)); }
__host__ __device__ __forceinline__ void stage_rc(int b, int& R, int& C) { const int st = b / 1024, sb = b % 1024, swz = sb ^ (((sb >> 9) & 1) << 5); R = (st >> 1) * 16 + swz / 64; C = (st & 1) * 32 + (swz % 64) / 2; }
__host__ __device__ __forceinline__ int perm32(int rho) { const int n = rho >> 4, i = rho & 15; return 8 * (i >> 2) + 4 * n + (i & 3); }

struct Unit { int pm, pn; };
struct Gemm { const bf16_t* A; const bf16_t* Bt; int M, N, K; };

struct StaticOrder {
    int nM, nN, nwg, G, c;
    __host__ __device__ void init(int M, int N, int G_, int c_) { nM = M / BM; nN = N / BM; nwg = nM * nN; G = G_; c = c_; }
    __host__ __device__ bool next(int i, Unit& u) const {
        const long L = (long)i * G + c; if (L >= nwg) return false;
        int wgid = (int)L; { const int q = nwg / NXCD, r = nwg % NXCD, xcd = wgid % NXCD, off = wgid / NXCD; wgid = (xcd < r ? xcd * (q + 1) : r * (q + 1) + (xcd - r) * q) + off; }
        const int nig = WGM * nN, gid = wgid / nig, fm = gid * WGM, gsz = (nM - fm) < WGM ? (nM - fm) : WGM;
        u.pm = fm + ((wgid % nig) % gsz); u.pn = (wgid % nig) / gsz; return true;
    }
    __device__ __forceinline__ void a_ready(const Unit&) const {}
    __device__ __forceinline__ void done(const Unit&) const {}
};


template <class Epi, class Sched, bool ALIGN_EPI = false, bool SP2 = false>
__device__ __forceinline__ void gemm_phase(PG8_LAS unsigned char* lds, const Gemm g, const Sched& S, const Epi& E, const int tid) {
    const int wid = __builtin_amdgcn_readfirstlane(tid >> 6), lane = tid & 63, wr = wid >> 2, wc = wid & 3, fr = lane & 15, fq = lane >> 4;
    const int K = g.K, nt = K / BK;
    unsigned voffA[2], voffB[2];
#pragma unroll
    for (int i = 0; i < 2; ++i) { int R, C; stage_rc(tid * 16 + i * 8192, R, C); const int Rb = Epi::PERM ? ((R & ~31) + perm32(R & 31)) : R;
        voffA[i] = (unsigned)(R * K + C) * 2u; voffB[i] = (unsigned)(Rb * K + C) * 2u; }
    const size_t kstep = (size_t)(BK * 2);
    const size_t hstep = (size_t)HALF * K * 2;
    const size_t tstep = 2 * hstep;
    const unsigned ldsw = (unsigned)wid * 1024u;
    const int aoff = lds_byte(wr * 64 + fr, fq * 8), boff = lds_byte(wc * 32 + fr, fq * 8);
#define PG8_SA(b, h) (((b) * 2 + (h)) * HTB)
#define PG8_SB(b, h) ((4 + (b) * 2 + (h)) * HTB)
#define PG8_STAGE(bufoff, gbase, voff) do { _Pragma("unroll") for (int _i = 0; _i < 2; ++_i) \
        __builtin_amdgcn_global_load_lds((const unsigned*)((const char*)(gbase) + (voff)[_i]), (PG8_LAS unsigned*)(lds + (bufoff) + ldsw + _i * 8192), 16, 0, 0); } while (0)
#define PG8_LDA(dst, b, h) do { _Pragma("unroll") for (int m = 0; m < 4; ++m) _Pragma("unroll") for (int k = 0; k < 2; ++k) dst[m][k] = *(const PG8_LAS bf16x8*)(lds + PG8_SA(b, h) + aoff + m * 2048 + k * 1024); } while (0)
#define PG8_LDB(dst, b, h) do { _Pragma("unroll") for (int n = 0; n < 2; ++n) _Pragma("unroll") for (int k = 0; k < 2; ++k) dst[n][k] = *(const PG8_LAS bf16x8*)(lds + PG8_SB(b, h) + boff + n * 2048 + k * 1024); } while (0)
#define PG8_MMA(ai, bj, At, Bt) do { __builtin_amdgcn_s_setprio(1); _Pragma("unroll") for (int m = 0; m < 4; ++m) _Pragma("unroll") for (int n = 0; n < 2; ++n) _Pragma("unroll") for (int k = 0; k < 2; ++k) \
        acc[ai][bj][m][n] = __builtin_amdgcn_mfma_f32_16x16x32_bf16(Bt[n][k], At[m][k], acc[ai][bj][m][n], 0, 0, 0); __builtin_amdgcn_s_setprio(0); } while (0)
#define PG8_WAIT_V(n) asm volatile("s_waitcnt vmcnt(" #n ")" ::: "memory")
#define PG8_WAIT_L(n) asm volatile("s_waitcnt lgkmcnt(" #n ")" ::: "memory")
#define PG8_BAR __builtin_amdgcn_s_barrier()
#define PG8_SCHED __builtin_amdgcn_sched_barrier(0)
    Unit cur, nxt; int ui = 0;
    if (!S.next(0, cur)) return;
    f32x4 acc[2][2][4][2];
#pragma unroll
    for (int a = 0; a < 2; ++a)
#pragma unroll
        for (int b = 0; b < 2; ++b)
#pragma unroll
            for (int m = 0; m < 4; ++m)
#pragma unroll
                for (int n = 0; n < 2; ++n) acc[a][b][m][n] = (f32x4){0.f, 0.f, 0.f, 0.f};
    bf16x8 At[4][2], B0[2][2], B1[2][2];
    const char* cA = (const char*)g.A + (size_t)cur.pm * tstep; const char* cB = (const char*)g.Bt + (size_t)cur.pn * tstep;
    S.a_ready(cur);
    if constexpr (SP2) {
        PG8_STAGE(PG8_SB(0, 0), cB, voffB); PG8_STAGE(PG8_SB(0, 1), cB + hstep, voffB); PG8_STAGE(PG8_SA(0, 0), cA, voffA); PG8_STAGE(PG8_SA(0, 1), cA + hstep, voffA);
        if (wr == 1) PG8_BAR;
        PG8_WAIT_V(2); PG8_BAR;
        PG8_STAGE(PG8_SB(1, 0), cB + kstep, voffB); PG8_STAGE(PG8_SA(1, 0), cA + kstep, voffA); PG8_STAGE(PG8_SB(1, 1), cB + hstep + kstep, voffB);
        PG8_WAIT_V(6); PG8_BAR;
    } else {
        PG8_STAGE(PG8_SB(0, 0), cB, voffB); PG8_STAGE(PG8_SA(0, 0), cA, voffA); PG8_STAGE(PG8_SB(0, 1), cB + hstep, voffB); PG8_STAGE(PG8_SA(0, 1), cA + hstep, voffA);
        if (wr == 1) PG8_BAR;
        PG8_WAIT_V(4); PG8_BAR;
        PG8_STAGE(PG8_SB(1, 0), cB + kstep, voffB); PG8_STAGE(PG8_SA(1, 0), cA + kstep, voffA); PG8_STAGE(PG8_SB(1, 1), cB + hstep + kstep, voffB);
        PG8_WAIT_V(6); PG8_BAR;
    }
    for (;;) {
        const bool has_next = S.next(ui + 1, nxt);
        const char* nA = has_next ? (const char*)g.A + (size_t)nxt.pm * tstep : cA; const char* nB = has_next ? (const char*)g.Bt + (size_t)nxt.pn * tstep : cB;
        for (int t = 0; t < nt; t += 2) {
            const bool last = (t == nt - 2);
            const char* a1 = cA + (size_t)(t + 1) * kstep;
            const char* a2 = last ? nA : cA + (size_t)(t + 2) * kstep; const char* b2 = last ? nB : cB + (size_t)(t + 2) * kstep;
            const char* a3 = a2 + kstep; const char* b3 = b2 + kstep;
            if (last && has_next) S.a_ready(nxt);
            if constexpr (SP2) {
            PG8_LDB(B0, 0, 0); PG8_LDB(B1, 0, 1); PG8_SCHED; PG8_LDA(At, 0, 0); PG8_STAGE(PG8_SA(1, 1), a1 + hstep, voffA);
            PG8_WAIT_V(8); PG8_WAIT_L(0); PG8_BAR; PG8_MMA(0, 0, At, B0); PG8_MMA(0, 1, At, B1); PG8_BAR; PG8_SCHED;
            PG8_LDA(At, 0, 1); PG8_STAGE(PG8_SB(0, 0), b2, voffB); PG8_STAGE(PG8_SB(0, 1), b2 + hstep, voffB); PG8_STAGE(PG8_SA(0, 0), a2, voffA);
            PG8_WAIT_V(8); PG8_WAIT_L(0); PG8_BAR; PG8_MMA(1, 0, At, B0); PG8_MMA(1, 1, At, B1); PG8_BAR; PG8_SCHED;
            PG8_LDB(B0, 1, 0); PG8_LDB(B1, 1, 1); PG8_SCHED; PG8_LDA(At, 1, 0); PG8_STAGE(PG8_SA(0, 1), a2 + hstep, voffA);
            PG8_WAIT_V(8); PG8_WAIT_L(0); PG8_BAR; PG8_MMA(0, 0, At, B0); PG8_MMA(0, 1, At, B1); PG8_BAR; PG8_SCHED;
            PG8_LDA(At, 1, 1); PG8_STAGE(PG8_SB(1, 0), b3, voffB); PG8_STAGE(PG8_SB(1, 1), b3 + hstep, voffB); PG8_STAGE(PG8_SA(1, 0), a3, voffA);
            PG8_WAIT_V(8); PG8_WAIT_L(0); PG8_BAR; PG8_MMA(1, 0, At, B0); PG8_MMA(1, 1, At, B1); PG8_BAR; PG8_SCHED;
            } else {
            PG8_LDB(B0, 0, 0); PG8_SCHED; PG8_LDA(At, 0, 0); PG8_STAGE(PG8_SA(1, 1), a1 + hstep, voffA);
            PG8_WAIT_L(8); PG8_BAR; PG8_WAIT_L(0); PG8_MMA(0, 0, At, B0); PG8_BAR; PG8_SCHED;
            PG8_LDB(B1, 0, 1); PG8_STAGE(PG8_SB(0, 0), b2, voffB);
            PG8_BAR; PG8_WAIT_L(0); PG8_MMA(0, 1, At, B1); PG8_BAR;
            PG8_LDA(At, 0, 1); PG8_STAGE(PG8_SA(0, 0), a2, voffA);
            PG8_BAR; PG8_WAIT_L(0); PG8_MMA(1, 0, At, B0); PG8_BAR; PG8_SCHED;
            PG8_STAGE(PG8_SB(0, 1), b2 + hstep, voffB);
            PG8_WAIT_V(6); PG8_BAR; PG8_MMA(1, 1, At, B1); PG8_BAR;
            PG8_LDB(B0, 1, 0); PG8_SCHED; PG8_LDA(At, 1, 0); PG8_STAGE(PG8_SA(0, 1), a2 + hstep, voffA);
            PG8_WAIT_L(8); PG8_BAR; PG8_WAIT_L(0); PG8_MMA(0, 0, At, B0); PG8_BAR; PG8_SCHED;
            PG8_LDB(B1, 1, 1); PG8_STAGE(PG8_SB(1, 0), b3, voffB);
            PG8_BAR; PG8_WAIT_L(0); PG8_MMA(0, 1, At, B1); PG8_BAR;
            PG8_LDA(At, 1, 1); PG8_STAGE(PG8_SA(1, 0), a3, voffA);
            PG8_BAR; PG8_WAIT_L(0); PG8_MMA(1, 0, At, B0); PG8_BAR; PG8_SCHED;
            PG8_STAGE(PG8_SB(1, 1), b3 + hstep, voffB);
            PG8_WAIT_V(6); PG8_BAR; PG8_MMA(1, 1, At, B1); PG8_BAR;
            }
        }
        if constexpr (ALIGN_EPI) { if (wr == 0) PG8_BAR; }
        if constexpr (!Epi::AFTER_DRAIN) { E(acc, cur, wr, wc, fr, fq); S.done(cur); }
        if (!has_next) break;
#pragma unroll
        for (int a = 0; a < 2; ++a)
#pragma unroll
            for (int b = 0; b < 2; ++b)
#pragma unroll
                for (int m = 0; m < 4; ++m)
#pragma unroll
                    for (int n = 0; n < 2; ++n) acc[a][b][m][n] = (f32x4){0.f, 0.f, 0.f, 0.f};
        cur = nxt; cA = nA; cB = nB; ++ui;
        if constexpr (ALIGN_EPI) { if (wr == 1) PG8_BAR; }
    }
    PG8_WAIT_V(0);
    if constexpr (!ALIGN_EPI) { if (wr == 0) PG8_BAR; }
    PG8_BAR;
    if constexpr (Epi::AFTER_DRAIN) { E.fused(acc, cur, wr, wc, fr, fq, lds, wid, lane); S.done(cur); }
#undef PG8_SA
#undef PG8_SB
#undef PG8_STAGE
#undef PG8_LDA
#undef PG8_LDB
#undef PG8_MMA
#undef PG8_WAIT_V
#undef PG8_WAIT_L
#undef PG8_BAR
#undef PG8_SCHED
}
}

#ifndef PG8_SP2
#define PG8_SP2 true
#endif

namespace mk {
using pg8::bf16_t; using pg8::f32x4; using pg8::Unit;
#define LAS __attribute__((address_space(3)))
typedef unsigned u32x2 __attribute__((ext_vector_type(2)));
typedef unsigned u32x4 __attribute__((ext_vector_type(4)));
constexpr int D = 1024, NB = 8, T = 4096, C = 256, RB = C + T, MALL = NB * RB, NTILE = MALL / 256, TPB = RB / 256  ;
constexpr int DIN = 2176, DINP = 2304, DMIX = 1024, DFF = 2816, NMOD = 6, LW = 384;
constexpr float EPS = 1e-6f, LOG2E = 1.4426950408889634f;
constexpr float QSA = 0.17677669529663687f * LOG2E, QSB = 0.125f * LOG2E;
constexpr int O_AQ = 0, O_AK = 256, O_AV = 512, O_BQ = 768, O_BK = 1152, O_BV = 1280, O_CX = 1408, O_CG = 1792;
constexpr int NWAVES = 8, NTHREADS = 512;
constexpr size_t MiB = 1u << 20;
constexpr size_t WS_CTL = 0;
constexpr size_t WS_WIN = 1 * MiB;
constexpr size_t WS_WOUT = 10 * MiB;
constexpr size_t WS_WUP = 14 * MiB;
constexpr size_t WS_WDN = 36 * MiB;
constexpr size_t WS_MOD = 47 * MiB;
constexpr size_t WS_BIAS1 = WS_MOD + 512 * 1024;
constexpr size_t WS_BIAS2 = WS_BIAS1 + 256 * 1024;
constexpr size_t WS_TAB = WS_BIAS2 + 512 * 1024;
constexpr size_t WS_TAB64 = WS_TAB + 4096, WS_PAR = WS_TAB64 + 8192;
constexpr int PAR_STRIDE = 512, PR_GQ32 = 0, PR_GK32 = 32, PR_GQ64 = 64, PR_GK64 = 128, PR_SUBG = 192, PR_SINK = 256, PR_LAM = 272, PR_MA = 273, PR_MB = 274, PR_LI = 275;
constexpr size_t WS_GAIN = WS_PAR + 8192;
constexpr size_t WS_FFNP = WS_GAIN + 16384;
constexpr size_t WS_LRUP = WS_FFNP + 96 * 1024;
constexpr size_t WS_LRUW = WS_LRUP + 32 * 1024;
constexpr size_t WS_SS1 = 49 * MiB;
constexpr size_t WS_SS2 = WS_SS1 + 3 * MiB;
constexpr size_t WS_LRU = 55 * MiB;
constexpr size_t WS_XC = 56 * MiB;
constexpr size_t WS_SIDE = 64 * MiB;
constexpr size_t WS_VN = 73 * MiB;
constexpr size_t WS_P = 141 * MiB;
constexpr size_t WS_Y = 294 * MiB;
constexpr size_t WS_U = WS_P;
constexpr size_t WS_END = 362 * MiB;
static_assert(WS_FFNP + 2 * 4 * DFF * 4 <= WS_LRUP && WS_LRUW + 2 * 2 * 6 * 128 * 64 * 2 <= WS_SS1 && WS_SS2 + (size_t)MALL * 64 <= WS_LRU && WS_SIDE + (size_t)NTILE * 6 * DFF * 4 <= WS_VN && WS_U + (size_t)MALL * DFF * 2 <= WS_END && WS_P + (size_t)MALL * DINP * 2 <= WS_Y && WS_Y + (size_t)MALL * D * 2 <= WS_END && WS_VN + (size_t)MALL * D * 2 <= WS_P, "ws map");
constexpr int LDS_BYTES = 147456;

__device__ __forceinline__ unsigned f2bf(float f) { unsigned u = __builtin_bit_cast(unsigned, f); return (u + 0x7fffu + ((u >> 16) & 1u)) >> 16; }
__device__ __forceinline__ unsigned pk2(float lo, float hi) { return f2bf(lo) | (f2bf(hi) << 16); }
__device__ __forceinline__ float bf2f(unsigned short h) { return __builtin_bit_cast(float, (unsigned)h << 16); }
__device__ __forceinline__ float sigmoidf_(float x) { return 1.f / (1.f + __expf(-x)); }
__device__ __forceinline__ float siluf_(float x) { return x * sigmoidf_(x); }
#define LDS_WAIT() asm volatile("s_waitcnt lgkmcnt(0)" ::: "memory")
__device__ __forceinline__ int fresh_lane() { unsigned z = 0u; asm volatile("" : "+v"(z)); return (int)__builtin_amdgcn_mbcnt_hi(~0u, __builtin_amdgcn_mbcnt_lo(~0u, z)); }

struct Frame {
    LAS unsigned char* lds;
    int tid, lane, wave, vcu, G, bid, flags;
    const float* const* inp; int zero; float* out; unsigned char* ws;
    __device__ __forceinline__ const float* in_(int k) const { return inp[k + zero]; }
};

__device__ __forceinline__ int map_in(int n) {
    const int tile = n >> 8, lc = n & 255;
    if (tile <= 1) { const int s = lc >> 5, bj = (lc >> 4) & 1, q = lc & 15; return (tile << 8) + 128 * bj + 32 * (s >> 1) + 16 * (s & 1) + q; }
    if (tile == 3 || tile == 4) { const int z = lc >> 6, bj = (lc >> 5) & 1, q = lc & 31; return (tile << 8) + 128 * bj + 32 * z + q; }
    return n;
}
__device__ __forceinline__ int map_up(int n) { if (n < DFF) return 256 * (n >> 7) + (n & 127); const int c = n - DFF; return 256 * (c >> 7) + 128 + (c & 127); }

template <int MAP> __device__ __forceinline__ void transpose_item(const float* __restrict__ W, int K, int N, bf16_t* __restrict__ WT, LAS float* scr, int item, int lane) {
    const int nblk = N / 32, kb = item / nblk, nb = item % nblk, k0 = 64 * kb, n0 = 32 * nb;
#pragma unroll 8
    for (int i = 0; i < 32; ++i) { const int kk = 2 * i + (lane >> 5); scr[kk * 33 + (lane & 31)] = W[(size_t)(k0 + kk) * N + n0 + (lane & 31)]; }
    LDS_WAIT(); asm volatile("" ::: "memory");
    const int c = lane & 7;
#pragma unroll
    for (int j = 0; j < 4; ++j) { const int n = (lane >> 3) + 8 * j; const LAS float* s = scr + (8 * c) * 33 + n;
        u32x4 o; o.x = pk2(s[0 * 33], s[1 * 33]); o.y = pk2(s[2 * 33], s[3 * 33]); o.z = pk2(s[4 * 33], s[5 * 33]); o.w = pk2(s[6 * 33], s[7 * 33]);
        const int nl = n0 + n; const int row = MAP == 1 ? map_in(nl) : (MAP == 2 ? map_up(nl) : nl);
        *(u32x4*)(WT + (size_t)row * K + k0 + 8 * c) = o; }
    LDS_WAIT(); asm volatile("" ::: "memory");
}

__device__ __forceinline__ void gemv9_item(Frame& F, LAS float* vecs, LAS float* red, const float* __restrict__ W, int ldw, int n0, float* __restrict__ out, int ldo, const float* __restrict__ addb) {
    float acc[9];
#pragma unroll
    for (int v = 0; v < 9; ++v) acc[v] = 0.f;
    const int kb = F.wave * 128;
#pragma unroll 2
    for (int k = 0; k < 128; k += 4) {
        float w[4];
#pragma unroll
        for (int i = 0; i < 4; ++i) w[i] = W[(size_t)(kb + k + i) * ldw + n0 + F.lane];
#pragma unroll
        for (int v = 0; v < 9; ++v) { const f32x4 x = *(const LAS f32x4*)(vecs + v * 1024 + kb + k); acc[v] += x[0] * w[0] + x[1] * w[1] + x[2] * w[2] + x[3] * w[3]; }
    }
#pragma unroll
    for (int v = 0; v < 9; ++v) red[(F.wave * 9 + v) * 64 + F.lane] = acc[v];
    __syncthreads();
    for (int e = F.tid; e < 9 * 64; e += NTHREADS) { const int v = e >> 6, ln = e & 63; float s = 0.f;
#pragma unroll
        for (int w8 = 0; w8 < 8; ++w8) s += red[(w8 * 9 + v) * 64 + ln];
        out[(size_t)v * ldo + n0 + ln] = s + (addb ? addb[n0 + ln] : 0.f); }
    __syncthreads();
}

__device__ const float INVF16[16] = {1.000000000e+00f, 5.623413324e-01f, 3.162277639e-01f, 1.778279394e-01f, 1.000000015e-01f, 5.623413250e-02f, 3.162277490e-02f, 1.778279431e-02f,
                                     9.999999776e-03f, 5.623413250e-03f, 3.162277630e-03f, 1.778279431e-03f, 1.000000047e-03f, 5.623413017e-04f, 3.162277571e-04f, 1.778279402e-04f};
__device__ __forceinline__ void phase_p0a(Frame& F) {
    const float* w_in = F.in_(8); const float* w_out = F.in_(26); const float* w_up = F.in_(27); const float* w_down = F.in_(30);
    bf16_t* WIN = (bf16_t*)(F.ws + WS_WIN); bf16_t* WOUT = (bf16_t*)(F.ws + WS_WOUT); bf16_t* WUP = (bf16_t*)(F.ws + WS_WUP); bf16_t* WDN = (bf16_t*)(F.ws + WS_WDN);
    LAS float* scr = (LAS float*)(F.lds + F.wave * 16384);
    const int gw = F.vcu * NWAVES + F.wave, NGW = F.G * NWAVES;
    constexpr int I_IN = 16 * (DIN / 32), I_OUT = 16 * 32, I_UP = 16 * (2 * DFF / 32), I_DN = (DFF / 64) * 32, I_L = I_IN + I_OUT + I_UP + I_DN;
    for (int it = gw; it < 2 * I_L; it += NGW) {
        const int l = it / I_L; int r = it % I_L;
        if (r < I_IN) { transpose_item<1>(w_in + (size_t)l * D * DIN, D, DIN, WIN + (size_t)l * DINP * D, scr, r, F.lane); continue; } r -= I_IN;
        if (r < I_OUT) { transpose_item<0>(w_out + (size_t)l * DMIX * D, DMIX, D, WOUT + (size_t)l * D * DMIX, scr, r, F.lane); continue; } r -= I_OUT;
        if (r < I_UP) { transpose_item<2>(w_up + (size_t)l * D * 2 * DFF, D, 2 * DFF, WUP + (size_t)l * 2 * DFF * D, scr, r, F.lane); continue; } r -= I_UP;
        transpose_item<0>(w_down + (size_t)l * DFF * D, DFF, D, WDN + (size_t)l * D * DFF, scr, r, F.lane);
    }
    { const int gt = F.vcu * NTHREADS + F.tid, NGT = F.G * NTHREADS; bf16_t* LW_ = (bf16_t*)(F.ws + WS_LRUW);
      for (int e = gt; e < 2 * 2 * 6 * 128 * 64; e += NGT) { const int i = e & 63, o = (e >> 6) & 127, blk = e >> 13;
          LW_[e] = (bf16_t)f2bf((o < 64 ? F.in_(21) : F.in_(23))[(size_t)blk * 4096 + i * 64 + (o & 63)]); } }
    { const int gt = F.vcu * NTHREADS + F.tid, NGT = F.G * NTHREADS; constexpr int PER = (DINP - DIN) * D * 2 / 16;
      for (int e = gt; e < 2 * PER; e += NGT) { const int l = e / PER, o = e % PER; *(u32x4*)((unsigned char*)(WIN + ((size_t)l * DINP + DIN) * D) + (size_t)o * 16) = (u32x4){0u, 0u, 0u, 0u}; } }
    __syncthreads();
    LAS float* vecs = (LAS float*)F.lds; LAS float* red = vecs + 9 * 1024;
    const float* cvec = F.in_(1); const float* cctx = F.in_(3); const float* w_mod = F.in_(4); const float* b_mod = F.in_(5);
    float* MOD = (float*)(F.ws + WS_MOD);
    bool staged = false;
    for (int item = F.bid; item < 2 * 96; item += F.G) {
        if (!staged) { for (int e = F.tid; e < 9 * 1024; e += NTHREADS) { const int v = e >> 10, k = e & 1023; vecs[e] = siluf_(v < 8 ? cvec[v * D + k] : cctx[k]); } __syncthreads(); staged = true; }
        const int l = item / 96, n0 = (item % 96) * 64;
        gemv9_item(F, vecs, red, w_mod + (size_t)l * D * NMOD * D, NMOD * D, n0, MOD + (size_t)l * 9 * NMOD * D, NMOD * D, b_mod + (size_t)l * NMOD * D);
    }
    if (F.bid == F.G - 1) {
        float* tab32 = (float*)(F.ws + WS_TAB); float* tab64 = (float*)(F.ws + WS_TAB64);
        for (int idx = F.tid; idx < 64 * 8 + 64 * 16; idx += NTHREADS) {
            int quarter, pos, fi; float* dst;
            if (idx < 64 * 8) { quarter = 8; pos = idx / 8; fi = idx % 8; dst = tab32 + idx * 2; }
            else { const int j = idx - 64 * 8; quarter = 16; pos = j / 16; fi = j % 16; dst = tab64 + j * 2; }
            const float invf = INVF16[fi * (16 / quarter)];
            const float x = (float)pos * invf;
            const float kf = rintf(x * 0.636619772f); const int kq = (int)kf;
            float r = fmaf(-kf, 1.5703125f, x); r = fmaf(-kf, 4.837512969970703125e-4f, r); r = fmaf(-kf, 7.54978995489188216e-8f, r);
            const float r2 = r * r;
            const float sp = r + r * r2 * (-1.6666654611e-1f + r2 * (8.3321608736e-3f + r2 * (-1.9515295891e-4f)));
            const float cp = 1.0f - 0.5f * r2 + r2 * r2 * (4.166664568298827e-2f + r2 * (-1.388731625493765e-3f + r2 * 2.443315711809948e-5f));
            const int qd = kq & 3;
            const float sv = qd == 0 ? sp : (qd == 1 ? cp : (qd == 2 ? -sp : -cp)), cv = qd == 0 ? cp : (qd == 1 ? -sp : (qd == 2 ? -cp : sp));
            dst[0] = cv; dst[1] = sv;
        }
        float* par = (float*)(F.ws + WS_PAR);
        for (int e = F.tid; e < 2 * 262; e += NTHREADS) { const int l = e / 262, i = e % 262; float v;
            if (i < 32) v = F.in_(9)[l * 32 + i]; else if (i < 64) v = F.in_(10)[l * 32 + i - 32]; else if (i < 128) v = F.in_(16)[l * 64 + i - 64]; else if (i < 192) v = F.in_(17)[l * 64 + i - 128];
            else if (i < 256) v = F.in_(15)[l * 64 + i - 192]; else v = F.in_(18)[l * 6 + i - 256];
            par[l * PAR_STRIDE + i] = v; }
        { float* gn = (float*)(F.ws + WS_GAIN); for (int e = F.tid; e < 4 * D; e += NTHREADS) gn[e] = e < 2 * D ? F.in_(6)[e] : F.in_(7)[e - 2 * D];
          float* fp = (float*)(F.ws + WS_FFNP); for (int e = F.tid; e < 2 * 4 * DFF; e += NTHREADS) { const int l = e / (4 * DFF), i = e % (4 * DFF); fp[e] = i < 3 * DFF ? F.in_(28)[(size_t)l * 3 * DFF + i] : F.in_(29)[(size_t)l * DFF + i - 3 * DFF]; } }
        { float* lp = (float*)(F.ws + WS_LRUP);
          for (int e = F.tid; e < 2 * 2 * LW; e += NTHREADS) { const int ld = e / LW, ch = e % LW;
              lp[(ld * 4 + 0) * LW + ch] = F.in_(22)[e]; lp[(ld * 4 + 1) * LW + ch] = F.in_(24)[e];
              const float lam = F.in_(25)[e]; const float sp = lam > 0.f ? log1pf(expf(-lam)) : -lam + log1pf(expf(lam));
              lp[(ld * 4 + 2) * LW + ch] = 8.0f * LOG2E * sp; lp[(ld * 4 + 3) * LW + ch] = F.in_(20)[e]; } }
        if (F.tid < 2) {
            const int l = F.tid; const float li = 0.8f - 0.6f * expf(-0.3f * (float)l);
            const float* lq1 = F.in_(11) + l * 32; const float* lk1 = F.in_(12) + l * 32; const float* lq2 = F.in_(13) + l * 32; const float* lk2 = F.in_(14) + l * 32;
            float s1 = 0.f, s2 = 0.f; for (int i = 0; i < 32; ++i) { s1 += lq1[i] * lk1[i]; s2 += lq2[i] * lk2[i]; }
            float mq = 0.f, mk_ = 0.f; for (int i = 0; i < 32; ++i) { mq = fmaxf(mq, fabsf(F.in_(9)[l * 32 + i])); mk_ = fmaxf(mk_, fabsf(F.in_(10)[l * 32 + i])); }
            float nq = 0.f, nk = 0.f; for (int i = 0; i < 64; ++i) { nq = fmaxf(nq, fabsf(F.in_(16)[l * 64 + i])); nk = fmaxf(nk, fabsf(F.in_(17)[l * 64 + i])); }
            float mb = QSB * 64.f * nq * nk; for (int i = 0; i < 6; ++i) mb = fmaxf(mb, F.in_(18)[l * 6 + i] * LOG2E);
            par[l * PAR_STRIDE + PR_LAM] = expf(s1) - expf(s2) + li; par[l * PAR_STRIDE + PR_MA] = QSA * 32.f * mq * mk_; par[l * PAR_STRIDE + PR_MB] = mb; par[l * PAR_STRIDE + PR_LI] = li;
        }
    }
}

__device__ __forceinline__ void phase_p0b(Frame& F) {
    LAS float* vecs = (LAS float*)F.lds; LAS float* red = vecs + 9 * 1024;
    const float* MOD = (const float*)(F.ws + WS_MOD); float* B1 = (float*)(F.ws + WS_BIAS1); float* B2 = (float*)(F.ws + WS_BIAS2);
    const float* w_in = F.in_(8); const float* w_up = F.in_(27);
    constexpr int I1 = DIN / 64, I2 = 2 * DFF / 64, IL = I1 + I2;
    for (int item = F.bid; item < 2 * IL; item += F.G) {
        const int l = item / IL; int r = item % IL; const bool is1 = r < I1; if (!is1) r -= I1;
        __syncthreads();
        for (int e = F.tid; e < 9 * 1024; e += NTHREADS) { const int v = e >> 10, k = e & 1023; vecs[e] = MOD[((size_t)l * 9 + v) * NMOD * D + (is1 ? 0 : 3) * D + k]; }
        __syncthreads();
        if (is1) gemv9_item(F, vecs, red, w_in + (size_t)l * D * DIN, DIN, r * 64, B1 + (size_t)l * 9 * DINP, DINP, nullptr);
        else gemv9_item(F, vecs, red, w_up + (size_t)l * D * 2 * DFF, 2 * DFF, r * 64, B2 + (size_t)l * 9 * 2 * DFF, 2 * DFF, nullptr);
    }
    { const int gt = F.vcu * NTHREADS + F.tid; if (gt < 2 * 9 * (DINP - DIN)) { const int lv = gt / (DINP - DIN), n = gt % (DINP - DIN); B1[(size_t)lv * DINP + DIN + n] = 0.f; } }
    const float* x = F.in_(0); const float* ctx = F.in_(2); const float* g1 = F.in_(6);
    bf16_t* VN = (bf16_t*)(F.ws + WS_VN); float* SS1 = (float*)(F.ws + WS_SS1);
    const int gw = F.vcu * NWAVES + F.wave, NGW = F.G * NWAVES;
    for (int g = gw; g < MALL; g += NGW) {
        const int b = g / RB, r = g % RB; const int v = r < C ? 8 : b;
        const float* src = r < C ? ctx + ((size_t)b * C + r) * D : x + ((size_t)b * T + (r - C)) * D;
        const float* sc = MOD + ((size_t)0 * 9 + v) * NMOD * D + 1 * D;
        float s = 0.f;
#pragma unroll
        for (int j = 0; j < 4; ++j) { const int n = 4 * F.lane + 256 * j; const f32x4 xv = *(const f32x4*)(src + n); const f32x4 gv = *(const f32x4*)(g1 + n); const f32x4 sv = *(const f32x4*)(sc + n);
            s += xv[0] * xv[0] + xv[1] * xv[1] + xv[2] * xv[2] + xv[3] * xv[3];
            u32x2 o; o.x = pk2(xv[0] * gv[0] * (1.f + sv[0]), xv[1] * gv[1] * (1.f + sv[1])); o.y = pk2(xv[2] * gv[2] * (1.f + sv[2]), xv[3] * gv[3] * (1.f + sv[3]));
            *(u32x2*)(VN + (size_t)g * D + n) = o; }
#pragma unroll
        for (int o = 1; o < 64; o <<= 1) s += __shfl_xor(s, o);
        if (F.lane == 0) *(f32x4*)(SS1 + (size_t)g * 4) = (f32x4){s, 0.f, 0.f, 0.f};
    }
}

struct Order {
    pg8::StaticOrder so; int latent_only;
    __device__ __forceinline__ void init(int nMt, int N, int G, int c, int lat) { so.init(nMt * 256, N, G, c); latent_only = lat; }
    __device__ __forceinline__ bool next(int i, Unit& u) const { if (!so.next(i, u)) return false; if (latent_only) u.pm = (u.pm >> 4) * TPB + 1 + (u.pm & 15); return true; }
    __device__ __forceinline__ void a_ready(const Unit&) const {}
    __device__ __forceinline__ void done(const Unit&) const {}
};

struct EpiIn {
    static constexpr bool PERM = false, AFTER_DRAIN = false;
    unsigned char* ws; int l;
    __device__ __forceinline__ void operator()(const f32x4 (&acc)[2][2][4][2], const Unit& u, int wr, int wc, int fr, int fq) const {
        { const int ln = fresh_lane(); fr = ln & 15; fq = ln >> 4; }
        bf16_t* P = (bf16_t*)(ws + WS_P); const float* SS = (const float*)(ws + WS_SS1); const float* bias = (const float*)(ws + WS_BIAS1) + (size_t)l * 9 * DINP;
        const float* tab32 = (const float*)(ws + WS_TAB); const float* tab64 = (const float*)(ws + WS_TAB64); const float* par = (const float*)(ws + WS_PAR) + l * PAR_STRIDE;
        const float* gq32 = par + PR_GQ32; const float* gk32 = par + PR_GK32; const float* gq64 = par + PR_GQ64; const float* gk64 = par + PR_GK64;
        const int b = u.pm / TPB, j = u.pm % TPB; const bool lat = j != 0; const float* bia = bias + (size_t)(lat ? b : 8) * DINP;
        const int pn = u.pn;
#pragma unroll
        for (int ai = 0; ai < 2; ++ai)
#pragma unroll
            for (int m = 0; m < 4; ++m) {
                const int rloc = ai * 128 + wr * 64 + m * 16 + fr; const size_t g = (size_t)u.pm * 256 + rloc;
                const f32x4 s4 = *(const f32x4*)(SS + g * 4);
                const float rs = 1.0f / sqrtf((s4[0] + s4[1] + s4[2] + s4[3]) * (1.0f / D) + EPS);
                const int t = (j - 1) * 256 + rloc; const int prow = t >> 6, pcol = t & 63;
                bf16_t* prow_p = P + g * DINP;
                if (pn <= 1) {
                    const float* gain = pn == 0 ? gq32 : gk32;
                    const f32x4 g1 = *(const f32x4*)(gain + 4 * fq), g2 = *(const f32x4*)(gain + 16 + 4 * fq);
                    const int pos = fq < 2 ? prow : pcol; const float* tb = tab32 + (pos * 8 + 4 * (fq & 1)) * 2;
#pragma unroll
                    for (int n = 0; n < 2; ++n) {
                        const int col = 256 * pn + 32 * (2 * wc + n) + 4 * fq;
                        f32x4 x1 = acc[ai][0][m][n] * rs + *(const f32x4*)(bia + col), x2 = acc[ai][1][m][n] * rs + *(const f32x4*)(bia + col + 16);
                        float ss = x1[0] * x1[0] + x1[1] * x1[1] + x1[2] * x1[2] + x1[3] * x1[3] + x2[0] * x2[0] + x2[1] * x2[1] + x2[2] * x2[2] + x2[3] * x2[3];
                        ss += __shfl_xor(ss, 16); ss += __shfl_xor(ss, 32);
                        const float ri = 1.0f / sqrtf(ss * (1.0f / 32.f) + EPS);
                        x1 = x1 * ri * g1; x2 = x2 * ri * g2;
                        if (lat) { const f32x4 c01 = *(const f32x4*)(tb), c23 = *(const f32x4*)(tb + 4);
                            const f32x4 cs = (f32x4){c01[0], c01[2], c23[0], c23[2]}, sn = (f32x4){c01[1], c01[3], c23[1], c23[3]};
                            const f32x4 y1 = x1 * cs - x2 * sn, y2 = x1 * sn + x2 * cs; x1 = y1; x2 = y2; }
                        if (pn == 0) { x1 = x1 * QSA; x2 = x2 * QSA; }
                        u32x2 o1, o2; o1.x = pk2(x1[0], x1[1]); o1.y = pk2(x1[2], x1[3]); o2.x = pk2(x2[0], x2[1]); o2.y = pk2(x2[2], x2[3]);
                        *(u32x2*)(prow_p + col) = o1; *(u32x2*)(prow_p + col + 16) = o2;
                    }
                } else if (pn == 3 || pn == 4) {
                    const bool isq = pn == 3 || wc < 2; const float* gain = isq ? gq64 : gk64;
                    const int colb = 256 * pn + 64 * wc;
                    f32x4 xa[2], xb[2]; float ss = 0.f;
#pragma unroll
                    for (int n = 0; n < 2; ++n) { xa[n] = acc[ai][0][m][n] * rs + *(const f32x4*)(bia + colb + 16 * n + 4 * fq); xb[n] = acc[ai][1][m][n] * rs + *(const f32x4*)(bia + colb + 32 + 16 * n + 4 * fq);
                        ss += xa[n][0] * xa[n][0] + xa[n][1] * xa[n][1] + xa[n][2] * xa[n][2] + xa[n][3] * xa[n][3] + xb[n][0] * xb[n][0] + xb[n][1] * xb[n][1] + xb[n][2] * xb[n][2] + xb[n][3] * xb[n][3]; }
                    ss += __shfl_xor(ss, 16); ss += __shfl_xor(ss, 32);
                    const float ri = 1.0f / sqrtf(ss * (1.0f / 64.f) + EPS);
#pragma unroll
                    for (int n = 0; n < 2; ++n) {
                        f32x4 x1 = xa[n] * ri * *(const f32x4*)(gain + 16 * n + 4 * fq), x2 = xb[n] * ri * *(const f32x4*)(gain + 32 + 16 * n + 4 * fq);
                        if (lat) { const float* tb = tab64 + ((n == 0 ? prow : pcol) * 16 + 4 * fq) * 2; const f32x4 c01 = *(const f32x4*)(tb), c23 = *(const f32x4*)(tb + 4);
                            const f32x4 cs = (f32x4){c01[0], c01[2], c23[0], c23[2]}, sn = (f32x4){c01[1], c01[3], c23[1], c23[3]};
                            const f32x4 y1 = x1 * cs - x2 * sn, y2 = x1 * sn + x2 * cs; x1 = y1; x2 = y2; }
                        if (isq) { x1 = x1 * QSB; x2 = x2 * QSB; }
                        u32x2 o1, o2; o1.x = pk2(x1[0], x1[1]); o1.y = pk2(x1[2], x1[3]); o2.x = pk2(x2[0], x2[1]); o2.y = pk2(x2[2], x2[3]);
                        *(u32x2*)(prow_p + colb + 16 * n + 4 * fq) = o1; *(u32x2*)(prow_p + colb + 32 + 16 * n + 4 * fq) = o2;
                    }
                } else {
#pragma unroll
                    for (int bj = 0; bj < 2; ++bj)
#pragma unroll
                        for (int n = 0; n < 2; ++n) { const int col = 256 * pn + 128 * bj + 32 * wc + 16 * n + 4 * fq;
                            if (col < DIN) { const f32x4 x1 = acc[ai][bj][m][n] * rs + *(const f32x4*)(bia + col); u32x2 o; o.x = pk2(x1[0], x1[1]); o.y = pk2(x1[2], x1[3]); *(u32x2*)(prow_p + col) = o; } }
                }
            }
    }
};

__device__ __forceinline__ void phase_p1(Frame& F, int l) {
    pg8::Gemm g{(const bf16_t*)(F.ws + WS_VN), (const bf16_t*)(F.ws + WS_WIN) + (size_t)l * DINP * D, MALL, DINP, D};
    Order S; S.init(NTILE, DINP, F.G, (int)F.bid, 0);
    EpiIn E{F.ws, l};
    pg8::gemm_phase<EpiIn, Order, true, true>(F.lds, g, S, E, F.tid);
}
struct EpiRes {
    static constexpr bool PERM = false, AFTER_DRAIN = false;
    unsigned char* ws; const float* xin; const float* ctxin; float* out; LAS float* red; int l, kind;
    __device__ __forceinline__ void operator()(const f32x4 (&acc)[2][2][4][2], const Unit& u, int wr, int wc, int fr, int fq) const {
        { const int ln = fresh_lane(); fr = ln & 15; fq = ln >> 4; }
        const float* MOD = (const float*)(ws + WS_MOD);
        const int b = u.pm / TPB, j = u.pm % TPB; const bool lat = j != 0; const int v = lat ? b : 8;
        const float* gate = MOD + ((size_t)l * 9 + v) * NMOD * D + (kind == 0 ? 2 : 5) * D;
        const bool do_vn = kind == 0 || l == 0;
        const float* scp = kind == 0 ? MOD + ((size_t)l * 9 + v) * NMOD * D + 4 * D : MOD + ((size_t)(l + 1) * 9 + v) * NMOD * D + 1 * D;
        const float* gainp = (const float*)(ws + WS_GAIN) + (kind == 0 ? (2 + l) : (l + 1)) * D;
        float* SSd = (float*)(ws + (kind == 0 ? WS_SS2 : WS_SS1));
        bf16_t* VN = (bf16_t*)(ws + WS_VN); float* XC = (float*)(ws + WS_XC);
        const bool first = kind == 0 && l == 0;
        const float* srcb = lat ? (first ? xin : out) + (size_t)b * T * D : (first ? ctxin : XC) + (size_t)b * C * D;
        float* dstb = lat ? out + (size_t)b * T * D : XC + (size_t)b * C * D;
        const int rbase = lat ? (j - 1) * 256 : 0;
#pragma unroll
        for (int ai = 0; ai < 2; ++ai)
#pragma unroll
            for (int m = 0; m < 4; ++m) {
                const int rloc = ai * 128 + wr * 64 + m * 16 + fr; const size_t g = (size_t)u.pm * 256 + rloc; const size_t ro = (size_t)(rbase + rloc) * D;
                float ss = 0.f;
#pragma unroll
                for (int bj = 0; bj < 2; ++bj)
#pragma unroll
                    for (int n = 0; n < 2; ++n) { const int c = 256 * u.pn + 128 * bj + 32 * wc + 16 * n + 4 * fq;
                        const f32x4 xo = *(const f32x4*)(srcb + ro + c); const f32x4 gt = *(const f32x4*)(gate + c);
                        const f32x4 x = xo + gt * acc[ai][bj][m][n];
                        *(f32x4*)(dstb + ro + c) = x;
                        if (do_vn) { const f32x4 gn = *(const f32x4*)(gainp + c); const f32x4 sc = *(const f32x4*)(scp + c); const f32x4 vn = x * gn * (sc + 1.0f);
                            u32x2 o; o.x = pk2(vn[0], vn[1]); o.y = pk2(vn[2], vn[3]); *(u32x2*)(VN + g * D + c) = o;
                            ss += x[0] * x[0] + x[1] * x[1] + x[2] * x[2] + x[3] * x[3]; } }
                if (do_vn) { ss += __shfl_xor(ss, 16); ss += __shfl_xor(ss, 32); if (fq == 0) red[wc * 256 + rloc] = ss; }
            }
        if (do_vn) {
            asm volatile("s_waitcnt lgkmcnt(0)" ::: "memory"); __builtin_amdgcn_s_barrier(); asm volatile("" ::: "memory");
            const int tid = 64 * (4 * wr + wc) + 16 * fq + fr;
            if (tid < 256) SSd[((size_t)u.pm * 256 + tid) * 4 + u.pn] = (red[tid] + red[256 + tid]) + (red[512 + tid] + red[768 + tid]);
        }
    }
};

struct EpiUp {
    static constexpr bool PERM = false, AFTER_DRAIN = false;
    unsigned char* ws; LAS float* ex; int l;
    __device__ __forceinline__ void operator()(const f32x4 (&acc)[2][2][4][2], const Unit& u, int wr, int wc, int fr, int fq) const {
        { const int ln = fresh_lane(); fr = ln & 15; fq = ln >> 4; }
        const float* SS = (const float*)(ws + WS_SS2); const float* ffp = (const float*)(ws + WS_FFNP) + (size_t)l * 4 * DFF;
        const int b = u.pm / TPB, j = u.pm % TPB; const int v = j != 0 ? b : 8;
        const float* bia = (const float*)(ws + WS_BIAS2) + ((size_t)l * 9 + v) * 2 * DFF;
        bf16_t* U = (bf16_t*)(ws + WS_U); float* SIDE = (float*)(ws + WS_SIDE) + (size_t)u.pm * 6 * DFF;
        const int lane = fr + 16 * fq;
        float rsv[2][4];
#pragma unroll
        for (int ai = 0; ai < 2; ++ai)
#pragma unroll
            for (int m = 0; m < 4; ++m) { const size_t g = (size_t)u.pm * 256 + ai * 128 + wr * 64 + m * 16 + fr; const f32x4 s4 = *(const f32x4*)(SS + g * 4);
                rsv[ai][m] = 1.0f / sqrtf((s4[0] + s4[1] + s4[2] + s4[3]) * (1.0f / D) + EPS); }
#pragma unroll
        for (int ai = 0; ai < 2; ++ai)
#pragma unroll
            for (int n = 0; n < 2; ++n) { const int q = 2 * ai + wr; const int cc = 32 * wc + 16 * n + 4 * fq; const f32x4 b4 = *(const f32x4*)(bia + 128 * u.pn + cc);
                if (fr == 0) *(LAS f32x4*)(ex + (q * 2 + 0) * 128 + cc) = acc[ai][0][0][n] * rsv[ai][0] + b4;
                if (fr == 15) *(LAS f32x4*)(ex + (q * 2 + 1) * 128 + cc) = acc[ai][0][3][n] * rsv[ai][3] + b4; }
        asm volatile("s_waitcnt lgkmcnt(0)" ::: "memory"); __builtin_amdgcn_s_barrier(); asm volatile("" ::: "memory");
        const int srcp = (lane & 48) | ((fr + 15) & 15), srcn = (lane & 48) | ((fr + 1) & 15);
#pragma unroll
        for (int ai = 0; ai < 2; ++ai) {
            const int q = 2 * ai + wr;
#pragma unroll
            for (int n = 0; n < 2; ++n) {
                const int cc = 32 * wc + 16 * n + 4 * fq; const int ch = 128 * u.pn + cc;
                const f32x4 b4 = *(const f32x4*)(bia + ch), bv4 = *(const f32x4*)(bia + DFF + ch);
                const f32x4 w0 = *(const f32x4*)(ffp + ch), w1 = *(const f32x4*)(ffp + DFF + ch), w2 = *(const f32x4*)(ffp + 2 * DFF + ch), fb = *(const f32x4*)(ffp + 3 * DFF + ch);
                f32x4 pb = (f32x4){0.f, 0.f, 0.f, 0.f}, nb = pb;
                if (q > 0) pb = *(const LAS f32x4*)(ex + ((q - 1) * 2 + 1) * 128 + cc);
                if (q < 3) nb = *(const LAS f32x4*)(ex + ((q + 1) * 2 + 0) * 128 + cc);
                f32x4 Gm[4];
#pragma unroll
                for (int m = 0; m < 4; ++m) Gm[m] = acc[ai][0][m][n] * rsv[ai][m] + b4;
#pragma unroll
                for (int m = 0; m < 4; ++m) {
                    const f32x4 sp = (fr == 15 && m > 0) ? Gm[m > 0 ? m - 1 : 0] : Gm[m], sn = (fr == 0 && m < 3) ? Gm[m < 3 ? m + 1 : 3] : Gm[m];
                    f32x4 prev, next;
#pragma unroll
                    for (int e = 0; e < 4; ++e) { prev[e] = __shfl(sp[e], srcp, 64); next[e] = __shfl(sn[e], srcn, 64); }
                    if (m == 0 && fr == 0) prev = pb;
                    if (m == 3 && fr == 15) next = nb;
                    const f32x4 pre = fb + w0 * prev + w1 * Gm[m] + w2 * next;
                    const f32x4 val = acc[ai][1][m][n] * rsv[ai][m] + bv4;
                    f32x4 uu;
#pragma unroll
                    for (int e = 0; e < 4; ++e) uu[e] = pre[e] / (1.0f + __expf(-pre[e])) * val[e];
                    const int rloc = ai * 128 + wr * 64 + m * 16 + fr; const size_t g = (size_t)u.pm * 256 + rloc;
                    u32x2 o; o.x = pk2(uu[0], uu[1]); o.y = pk2(uu[2], uu[3]); *(u32x2*)(U + g * DFF + ch) = o;
                    if (rloc == 0) { *(f32x4*)(SIDE + 0 * DFF + ch) = pre; *(f32x4*)(SIDE + 1 * DFF + ch) = val; *(f32x4*)(SIDE + 2 * DFF + ch) = Gm[m]; }
                    if (rloc == 255) { *(f32x4*)(SIDE + 3 * DFF + ch) = pre; *(f32x4*)(SIDE + 4 * DFF + ch) = val; *(f32x4*)(SIDE + 5 * DFF + ch) = Gm[m]; }
                }
                asm volatile("" ::: "memory");
            }
        }
        asm volatile("s_waitcnt lgkmcnt(0)" ::: "memory"); __builtin_amdgcn_s_barrier(); asm volatile("" ::: "memory");
    }
};

__device__ __forceinline__ void phase_p3(Frame& F, int l) {
    pg8::Gemm g{(const bf16_t*)(F.ws + WS_Y), (const bf16_t*)(F.ws + WS_WOUT) + (size_t)l * D * DMIX, MALL, D, DMIX};
    Order S; S.init(l == 0 ? NTILE : NB * 16, D, F.G, F.bid, l == 0 ? 0 : 1);
    EpiRes E{F.ws, F.in_(0), F.in_(2), F.out, (LAS float*)(F.lds + 131072 + 4096), l, 0};
    pg8::gemm_phase<EpiRes, Order, true, true>(F.lds, g, S, E, F.tid);
}
__device__ __forceinline__ void phase_p4(Frame& F, int l) {
    pg8::Gemm g{(const bf16_t*)(F.ws + WS_VN), (const bf16_t*)(F.ws + WS_WUP) + (size_t)l * 2 * DFF * D, MALL, 2 * DFF, D};
    Order S; S.init(l == 0 ? NTILE : NB * 16, 2 * DFF, F.G, F.bid, l == 0 ? 0 : 1);
    EpiUp E{F.ws, (LAS float*)(F.lds + 131072), l};
    pg8::gemm_phase<EpiUp, Order, true, true>(F.lds, g, S, E, F.tid);
}
__device__ __forceinline__ void phase_p5(Frame& F, int l) {
    Order S; S.init(l == 0 ? NTILE : NB * 16, D, F.G, F.bid, l == 0 ? 0 : 1);
    { const float* SIDE = (const float*)(F.ws + WS_SIDE); const float* ffp = (const float*)(F.ws + WS_FFNP) + (size_t)l * 4 * DFF; bf16_t* U = (bf16_t*)(F.ws + WS_U);
      Unit u;
      for (int i = 0; S.next(i, u); ++i) { const int pm = u.pm, j = pm % TPB;
          for (int ch = F.tid; ch < DFF; ch += NTHREADS) {
              if (j >= 2) { const float pre = SIDE[((size_t)pm * 6 + 0) * DFF + ch] + ffp[ch] * SIDE[((size_t)(pm - 1) * 6 + 5) * DFF + ch];
                  U[(size_t)pm * 256 * DFF + ch] = (bf16_t)f2bf(pre / (1.0f + __expf(-pre)) * SIDE[((size_t)pm * 6 + 1) * DFF + ch]); }
              if (j >= 1 && j <= 15) { const float pre = SIDE[((size_t)pm * 6 + 3) * DFF + ch] + ffp[2 * DFF + ch] * SIDE[((size_t)(pm + 1) * 6 + 2) * DFF + ch];
                  U[((size_t)pm * 256 + 255) * DFF + ch] = (bf16_t)f2bf(pre / (1.0f + __expf(-pre)) * SIDE[((size_t)pm * 6 + 4) * DFF + ch]); }
          } }
      asm volatile("s_waitcnt vmcnt(0)" ::: "memory"); __syncthreads(); }
    pg8::Gemm g{(const bf16_t*)(F.ws + WS_U), (const bf16_t*)(F.ws + WS_WDN) + (size_t)l * D * DFF, MALL, D, DFF};
    EpiRes E{F.ws, F.in_(0), F.in_(2), F.out, (LAS float*)(F.lds + 131072 + 4096), l, 1};
    pg8::gemm_phase<EpiRes, Order, true, true>(F.lds, g, S, E, F.tid);
}
typedef short bf16x8 __attribute__((ext_vector_type(8)));
typedef short s16x4 __attribute__((ext_vector_type(4)));
typedef float f32x16 __attribute__((ext_vector_type(16)));
typedef float f32x2_t __attribute__((ext_vector_type(2))); typedef __bf16 bf16x2_t __attribute__((ext_vector_type(2)));
__device__ __forceinline__ unsigned cvtpk(float lo, float hi) { f32x2_t v = {lo, hi}; bf16x2_t b = __builtin_convertvector(v, bf16x2_t); return __builtin_bit_cast(unsigned, b); }
__device__ __forceinline__ int crow(int r, int hi) { return (r & 3) + 8 * (r >> 2) + 4 * hi; }
typedef short v4i16_t __attribute__((ext_vector_type(4)));
__device__ __forceinline__ s16x4 vtr(const LAS unsigned char* p) { return __builtin_bit_cast(s16x4, __builtin_amdgcn_ds_read_tr16_b64_v4i16((LAS v4i16_t*)p)); }

constexpr int ATT_KV_BYTES = 8192;
__device__ __forceinline__ void att_stage(const bf16_t* Krow0, const bf16_t* Vrow0, LAS unsigned char* kbuf, LAS unsigned char* vbuf, int wave, int lane) {
    const bf16_t* ks = Krow0 + (size_t)lane * DINP + wave * 8;
    const bf16_t* vs = Vrow0 + (size_t)(16 * (wave & 3) + (lane >> 2)) * DINP + (wave >> 2) * 32 + (lane & 3) * 8;
    __builtin_amdgcn_global_load_lds((const unsigned*)ks, (LAS unsigned*)(kbuf + wave * 1024), 16, 0, 0);
    __builtin_amdgcn_global_load_lds((const unsigned*)vs, (LAS unsigned*)(vbuf + wave * 1024), 16, 0, 0);
}
template <int NK> __device__ __forceinline__ f32x16 att_qk(const LAS unsigned char* kbuf, int d0, int kh, const bf16x8* qr, f32x16 cinit, int r32, int hi) {
    f32x16 s = cinit;
#pragma unroll
    for (int i = 0; i < NK; ++i) { const bf16x8 kf = *(const LAS bf16x8*)(kbuf + (2 * (d0 + i) + hi) * 1024 + (kh * 32 + r32) * 16); s = __builtin_amdgcn_mfma_f32_32x32x16_bf16(kf, qr[i], s, 0, 0, 0); }
    return s;
}
__device__ __forceinline__ bf16x8 att_vfrag(const LAS unsigned char* vbuf, int dh, int ks, int lane, int hi) {
    const LAS unsigned char* p = vbuf + (dh * 4 + ks) * 1024 + ((lane >> 4) & 1) * 32 + (lane & 3) * 8 + (4 * hi + ((lane & 15) >> 2)) * 64;
    const s16x4 lo = vtr(p), hh = vtr(p + 512);
    return (bf16x8){lo[0], lo[1], lo[2], lo[3], hh[0], hh[1], hh[2], hh[3]};
}
__device__ __forceinline__ float half_swap_sum(float v) { return v + __shfl_xor(v, 32); }

__device__ __forceinline__ void da_unit(Frame& F, int l, int b, int h, int q0, int nkeys) {
    const int lane_ = fresh_lane();
    const int lane = lane_, wave = F.wave, r32 = lane & 31, hi = lane >> 5;
    const bf16_t* P = (const bf16_t*)(F.ws + WS_P) + (size_t)b * RB * DINP;
    const float* par = (const float*)(F.ws + WS_PAR) + l * PAR_STRIDE;
    LAS unsigned char* kb0 = F.lds; LAS unsigned char* vb0 = F.lds + 2 * ATT_KV_BYTES;
    LAS float* wsf = (LAS float*)(F.lds + 4 * ATT_KV_BYTES) + wave * 128;
    const bf16_t* Kp = P + O_AK + h * 64; const bf16_t* Vp = P + O_AV + h * 64;
    const int NT = nkeys / 64;
    att_stage(Kp, Vp, kb0, vb0, wave, lane);
    bf16x8 qr[4];
#pragma unroll
    for (int d0 = 0; d0 < 4; ++d0) qr[d0] = *(const bf16x8*)(P + (size_t)(q0 + wave * 32 + r32) * DINP + O_AQ + h * 64 + d0 * 16 + hi * 8);
    const float negM = -par[PR_MA];
    f32x16 cinit;
#pragma unroll
    for (int r = 0; r < 16; ++r) cinit[r] = negM;
    f32x16 o[2][2];
#pragma unroll
    for (int m = 0; m < 2; ++m)
#pragma unroll
        for (int dh = 0; dh < 2; ++dh)
#pragma unroll
            for (int r = 0; r < 16; ++r) o[m][dh][r] = 0.f;
    float lsum[2] = {0.f, 0.f};
    asm volatile("s_waitcnt vmcnt(0)" ::: "memory"); __syncthreads();
    for (int t = 0; t < NT; ++t) {
        const int cur = t & 1;
        if (t + 1 < NT) att_stage(Kp + (size_t)(t + 1) * 64 * DINP, Vp + (size_t)(t + 1) * 64 * DINP, kb0 + (cur ^ 1) * ATT_KV_BYTES, vb0 + (cur ^ 1) * ATT_KV_BYTES, wave, lane);
        const LAS unsigned char* kb = kb0 + cur * ATT_KV_BYTES; const LAS unsigned char* vb = vb0 + cur * ATT_KV_BYTES;
        unsigned pw[2][4][4];
#pragma unroll
        for (int m = 0; m < 2; ++m)
#pragma unroll
            for (int kh = 0; kh < 2; ++kh) {
                f32x16 s = att_qk<2>(kb, 2 * m, kh, qr + 2 * m, cinit, r32, hi);
                float acc = 0.f;
#pragma unroll
                for (int r = 0; r < 16; ++r) { s[r] = __builtin_amdgcn_exp2f(s[r]); acc += s[r]; }
                lsum[m] += acc;
#pragma unroll
                for (int i = 0; i < 4; ++i) { pw[m][2 * kh][i] = cvtpk(s[2 * i], s[2 * i + 1]); pw[m][2 * kh + 1][i] = cvtpk(s[8 + 2 * i], s[8 + 2 * i + 1]); }
                __builtin_amdgcn_sched_barrier(0);
            }
#pragma unroll
        for (int dh = 0; dh < 2; ++dh)
#pragma unroll
            for (int ks = 0; ks < 4; ++ks) {
                const bf16x8 vf = att_vfrag(vb, dh, ks, lane, hi);
#pragma unroll
                for (int m = 0; m < 2; ++m) { const u32x4 pa = (u32x4){pw[m][ks][0], pw[m][ks][1], pw[m][ks][2], pw[m][ks][3]};
                    o[m][dh] = __builtin_amdgcn_mfma_f32_32x32x16_bf16(__builtin_bit_cast(bf16x8, pa), vf, o[m][dh], 0, 0, 0); }
            }
        asm volatile("s_waitcnt vmcnt(0)" ::: "memory"); __syncthreads();
    }
    const float lam = par[PR_LAM], li = par[PR_LI];
    lsum[0] = half_swap_sum(lsum[0]); lsum[1] = half_swap_sum(lsum[1]);
    if (hi == 0) { wsf[r32] = 1.0f / lsum[0]; wsf[32 + r32] = lam / lsum[1]; }
    LDS_WAIT();
    float ss[16];
#pragma unroll
    for (int r = 0; r < 16; ++r) { const int row = crow(r, hi); const float i0 = wsf[row], i1 = wsf[32 + row];
        float sq = 0.f;
#pragma unroll
        for (int dh = 0; dh < 2; ++dh) { const float v = o[0][dh][r] * i0 - o[1][dh][r] * i1; o[0][dh][r] = v; sq += v * v; }
        ss[r] = sq; }
#pragma unroll
    for (int sh = 1; sh < 32; sh <<= 1)
#pragma unroll
        for (int r = 0; r < 16; ++r) ss[r] += __shfl_xor(ss[r], sh);
    bf16_t* Y = (bf16_t*)(F.ws + WS_Y) + ((size_t)b * RB + q0 + wave * 32) * D + h * 64;
#pragma unroll
    for (int dh = 0; dh < 2; ++dh) { const float gsc = par[PR_SUBG + 32 * dh + r32] * (1.0f - li);
#pragma unroll
        for (int r = 0; r < 16; ++r) { const float rs = 1.0f / sqrtf(ss[r] * (1.0f / 64.f) + EPS);
            Y[(size_t)crow(r, hi) * D + 32 * dh + r32] = (bf16_t)f2bf(o[0][dh][r] * rs * gsc); } }
    __syncthreads();
}

__device__ __forceinline__ void sw_unit(Frame& F, int l, int b, int kv, int q0, int g) {
    const int lane_ = fresh_lane();
    const int lane = lane_, wave = F.wave, r32 = lane & 31, hi = lane >> 5;
    const bf16_t* P = (const bf16_t*)(F.ws + WS_P) + (size_t)b * RB * DINP;
    const float* par = (const float*)(F.ws + WS_PAR) + l * PAR_STRIDE;
    LAS unsigned char* kb0 = F.lds; LAS unsigned char* vb0 = F.lds + 2 * ATT_KV_BYTES;
    LAS float* wsf = (LAS float*)(F.lds + 4 * ATT_KV_BYTES) + wave * 128;
    const bf16_t* Kp = P + O_BK + kv * 64; const bf16_t* Vp = P + O_BV + kv * 64;
    const bool lat = q0 != 0;
    const int pos0 = q0 - C;
    const int band_lo = lat ? (pos0 - 128 < 0 ? 0 : pos0 - 128) : 0, band_hi = lat ? (pos0 + 384 > T ? T : pos0 + 384) : 0;
    const int NT = 4 + (band_hi - band_lo) / 64;
    const int qpos = pos0 + wave * 32 + r32;
    att_stage(Kp, Vp, kb0, vb0, wave, lane);
    bf16x8 qr[4];
#pragma unroll
    for (int d0 = 0; d0 < 4; ++d0) qr[d0] = *(const bf16x8*)(P + (size_t)(q0 + wave * 32 + r32) * DINP + O_BQ + (kv * 3 + g) * 64 + d0 * 16 + hi * 8);
    const float negM = -par[PR_MB];
    f32x16 cinit;
#pragma unroll
    for (int r = 0; r < 16; ++r) cinit[r] = negM;
    f32x16 o[2];
    float lsum = hi == 0 ? __builtin_amdgcn_exp2f(par[PR_SINK + kv * 3 + g] * LOG2E + negM) : 0.f;
#pragma unroll
    for (int dh = 0; dh < 2; ++dh)
#pragma unroll
        for (int r = 0; r < 16; ++r) o[dh][r] = 0.f;
    asm volatile("s_waitcnt vmcnt(0)" ::: "memory"); __syncthreads();
    for (int t = 0; t < NT; ++t) {
        const int cur = t & 1;
        if (t + 1 < NT) { const int nr = (t + 1 < 4) ? (t + 1) * 64 : C + band_lo + (t + 1 - 4) * 64;
            att_stage(Kp + (size_t)nr * DINP, Vp + (size_t)nr * DINP, kb0 + (cur ^ 1) * ATT_KV_BYTES, vb0 + (cur ^ 1) * ATT_KV_BYTES, wave, lane); }
        const LAS unsigned char* kb = kb0 + cur * ATT_KV_BYTES; const LAS unsigned char* vb = vb0 + cur * ATT_KV_BYTES;
        const int kpos0 = band_lo + (t - 4) * 64;
        const int wlo = pos0 + wave * 32 - 128, whi = pos0 + wave * 32 + 31 + 128;
        const bool band = t >= 4;
        const bool active = !band || (kpos0 + 63 >= wlo && kpos0 <= whi);
        if (active) {
            const bool need_mask = band && (kpos0 < wlo + 31 || kpos0 + 63 > whi - 31);
            {
                unsigned pw[4][4];
#pragma unroll
                for (int kh = 0; kh < 2; ++kh) {
                    f32x16 s = att_qk<4>(kb, 0, kh, qr, cinit, r32, hi);
                    float acc = 0.f;
#pragma unroll
                    for (int r = 0; r < 16; ++r) { float p = __builtin_amdgcn_exp2f(s[r]);
                        if (need_mask) { const int d = qpos - (kpos0 + kh * 32 + crow(r, hi)); p = (d > 128 || d < -128) ? 0.f : p; }
                        s[r] = p; acc += p; }
                    lsum += acc;
#pragma unroll
                    for (int i = 0; i < 4; ++i) { pw[2 * kh][i] = cvtpk(s[2 * i], s[2 * i + 1]); pw[2 * kh + 1][i] = cvtpk(s[8 + 2 * i], s[8 + 2 * i + 1]); }
                }
#pragma unroll
                for (int dh = 0; dh < 2; ++dh)
#pragma unroll
                    for (int ks = 0; ks < 4; ++ks) { const bf16x8 vf = att_vfrag(vb, dh, ks, lane, hi); const u32x4 pa = (u32x4){pw[ks][0], pw[ks][1], pw[ks][2], pw[ks][3]};
                        o[dh] = __builtin_amdgcn_mfma_f32_32x32x16_bf16(__builtin_bit_cast(bf16x8, pa), vf, o[dh], 0, 0, 0); }
            }
        }
        asm volatile("s_waitcnt vmcnt(0)" ::: "memory"); __syncthreads();
    }
    { const float lt = half_swap_sum(lsum); if (hi == 0) wsf[r32] = 1.0f / lt; }
    LDS_WAIT();
    bf16_t* Y = (bf16_t*)(F.ws + WS_Y) + ((size_t)b * RB + q0 + wave * 32) * D + 256 + kv * 192;
#pragma unroll
    for (int r = 0; r < 16; ++r) { const int row = crow(r, hi); const float il = wsf[row];
#pragma unroll
        for (int dh = 0; dh < 2; ++dh) Y[(size_t)row * D + g * 64 + 32 * dh + r32] = (bf16_t)f2bf(o[dh][r] * il); }
    __syncthreads();
}

constexpr int LRU_XS = 0, LRU_XCB = 67584, LRU_WT = LRU_XCB + 256 * 144, LRU_EXC = LRU_WT + 128 * 144, LRU_HIN = LRU_EXC + 4096;
static_assert(LRU_HIN + 512 <= 131072, "LRU LDS map");
__device__ __forceinline__ float fast_sigmoid(float z) { return __builtin_amdgcn_rcpf(1.0f + __builtin_amdgcn_exp2f(-LOG2E * z)); }
__device__ __forceinline__ void lru_item(Frame& F, int l, int pm, int hb, int stage) {
    const int lane_ = fresh_lane();
    const int lane = lane_, wave = F.wave, tid = wave * 64 + lane, r32 = lane & 31, hi = lane >> 5;
    const int b = pm / TPB, j = pm % TPB; const int L = j == 0 ? C : T, t0 = j == 0 ? 0 : (j - 1) * 256;
    const bf16_t* P = (const bf16_t*)(F.ws + WS_P) + (size_t)pm * 256 * DINP;
    LAS float* XS = (LAS float*)(F.lds + LRU_XS); LAS unsigned char* XCb = F.lds + LRU_XCB; LAS unsigned char* WT = F.lds + LRU_WT;
    LAS float* EXC = (LAS float*)(F.lds + LRU_EXC); LAS float* HIN = (LAS float*)(F.lds + LRU_HIN);
    float* SUM = (float*)(F.ws + WS_LRU);
    for (int e = tid; e < 262 * 8; e += NTHREADS) { const int row = e >> 3, cc = e & 7; const int rl = row - 3, tt = t0 + rl;
        f32x4 lo = (f32x4){0.f, 0.f, 0.f, 0.f}, hh = lo;
        if (tt >= 0 && tt < L) { const u32x4 v = *(const u32x4*)(P + (ptrdiff_t)rl * DINP + O_CX + 64 * hb + 8 * cc);
            lo = (f32x4){__builtin_bit_cast(float, v.x << 16), __builtin_bit_cast(float, v.x & 0xffff0000u), __builtin_bit_cast(float, v.y << 16), __builtin_bit_cast(float, v.y & 0xffff0000u)};
            hh = (f32x4){__builtin_bit_cast(float, v.z << 16), __builtin_bit_cast(float, v.z & 0xffff0000u), __builtin_bit_cast(float, v.w << 16), __builtin_bit_cast(float, v.w & 0xffff0000u)}; }
        *(LAS f32x4*)(XS + row * 64 + 8 * cc) = lo; *(LAS f32x4*)(XS + row * 64 + 8 * cc + 4) = hh; }
    if (stage == 1 && tid < 128) { const int d = tid >> 6, ch = tid & 63; const int pm0 = b * TPB; float h = 0.f;
        typedef float f2 __attribute__((ext_vector_type(2)));
        const f2* S2 = (const f2*)SUM;
        if (d == 0) { f2 sv[16];
#pragma unroll
            for (int jj = 0; jj < 16; ++jj) sv[jj] = jj < j ? S2[((size_t)(pm0 + jj) * 2 + 0) * LW + 64 * hb + ch] : (f2){1.f, 0.f};
#pragma unroll
            for (int jj = 0; jj < 16; ++jj) h = sv[jj][0] * h + sv[jj][1]; }
        else if (j != 0) { f2 sv[16]; const f2 s0 = S2[((size_t)pm0 * 2 + 1) * LW + 64 * hb + ch];
#pragma unroll
            for (int k = 0; k < 15; ++k) { const int jj = 16 - k; sv[k] = jj > j ? S2[((size_t)(pm0 + jj) * 2 + 1) * LW + 64 * hb + ch] : (f2){1.f, 0.f}; }
            h = s0[1];
#pragma unroll
            for (int k = 0; k < 15; ++k) h = sv[k][0] * h + sv[k][1]; }
        HIN[tid] = h; }
    f32x16 Hf[2];
#pragma unroll
    for (int d = 0; d < 2; ++d) {
        __syncthreads();
        const float* cw = F.in_(19) + ((size_t)(l * 2 + d) * 4) * LW + 64 * hb;
        const float* lp = (const float*)(F.ws + WS_LRUP) + (size_t)(l * 2 + d) * 4 * LW + 64 * hb;
        { const u32x4* src = (const u32x4*)((const bf16_t*)(F.ws + WS_LRUW) + (size_t)((l * 2 + d) * 6 + hb) * 8192);
#pragma unroll
          for (int i = 0; i < 2; ++i) { const int e = tid + i * NTHREADS; *(LAS u32x4*)(WT + (e >> 3) * 144 + (e & 7) * 16) = src[e]; } }
        { const int c2 = (tid & 31) * 2; typedef float f2 __attribute__((ext_vector_type(2)));
          const f2 w0 = *(const f2*)(cw + 0 * LW + c2), w1 = *(const f2*)(cw + 1 * LW + c2), w2 = *(const f2*)(cw + 2 * LW + c2), w3 = *(const f2*)(cw + 3 * LW + c2), bb = *(const f2*)(lp + 3 * LW + c2);
#pragma unroll 4
          for (int i = 0; i < 16; ++i) { const int rl = (tid >> 5) + 16 * i; const LAS float* x = XS + (rl + 3) * 64 + c2;
              const f2 x0 = *(const LAS f2*)(x), xa = *(const LAS f2*)(x + (d == 0 ? -3 : 3) * 64), xb = *(const LAS f2*)(x + (d == 0 ? -2 : 2) * 64), xc_ = *(const LAS f2*)(x + (d == 0 ? -1 : 1) * 64);
              const f2 v = bb + w0 * xa + w1 * xb + w2 * xc_ + w3 * x0;
              *(LAS unsigned*)(XCb + rl * 144 + c2 * 2) = cvtpk(v[0], v[1]); } }
        __syncthreads();
        f32x16 acc[4];
#pragma unroll
        for (int nt = 0; nt < 4; ++nt)
#pragma unroll
            for (int r = 0; r < 16; ++r) acc[nt][r] = 0.f;
#pragma unroll
        for (int ks = 0; ks < 4; ++ks) { const bf16x8 af = *(const LAS bf16x8*)(XCb + (wave * 32 + r32) * 144 + (16 * ks + 8 * hi) * 2);
#pragma unroll
            for (int nt = 0; nt < 4; ++nt) { const bf16x8 bf = *(const LAS bf16x8*)(WT + (32 * nt + r32) * 144 + (16 * ks + 8 * hi) * 2);
                acc[nt] = __builtin_amdgcn_mfma_f32_32x32x16_bf16(af, bf, acc[nt], 0, 0, 0); } }
#pragma unroll
        for (int chh = 0; chh < 2; ++chh) { const int ch = 32 * chh + r32;
            const float ba = lp[ch], bx = lp[LW + ch], sp8 = lp[2 * LW + ch];
#pragma unroll
            for (int r = 0; r < 16; ++r) { const int rl = wave * 32 + crow(r, hi);
                const float xc = bf2f(*(const LAS unsigned short*)(XCb + rl * 144 + ch * 2));
                const float rg = fast_sigmoid(acc[chh][r] + ba), ig = fast_sigmoid(acc[2 + chh][r] + bx);
                const float av = __builtin_amdgcn_exp2f(-(rg * sp8));
                acc[chh][r] = av; acc[2 + chh][r] = __builtin_amdgcn_sqrtf(fmaxf(1.0f - av * av, 0.f)) * (ig * xc); } }
        float gA[2][8], gB[2][8];
#pragma unroll
        for (int chh = 0; chh < 2; ++chh) {
#pragma unroll
            for (int q = 0; q < 4; ++q) { float A_ = 1.f, B_ = 0.f;
#pragma unroll
                for (int e = 0; e < 4; ++e) { const int r = 4 * q + (d == 0 ? e : 3 - e); B_ = acc[chh][r] * B_ + acc[2 + chh][r]; A_ *= acc[chh][r]; }
                const float pA_ = __shfl_xor(A_, 32), pB_ = __shfl_xor(B_, 32);
                gA[chh][2 * q] = hi ? pA_ : A_; gA[chh][2 * q + 1] = hi ? A_ : pA_; gB[chh][2 * q] = hi ? pB_ : B_; gB[chh][2 * q + 1] = hi ? B_ : pB_; }
            float blkA = 1.f, blkH = 0.f;
#pragma unroll
            for (int k = 0; k < 8; ++k) { const int s = d == 0 ? k : 7 - k; blkH = gA[chh][s] * blkH + gB[chh][s]; blkA *= gA[chh][s]; }
            if (hi == 0) { typedef float f2 __attribute__((ext_vector_type(2))); *(LAS f2*)(EXC + (wave * 64 + 32 * chh + r32) * 2) = (f2){blkA, blkH}; }
        }
        LDS_WAIT(); __syncthreads();
#pragma unroll
        for (int chh = 0; chh < 2; ++chh) { const int ch = 32 * chh + r32;
            float h = stage == 1 ? HIN[d * 64 + ch] : 0.f;
            float totA = 1.f, totH = 0.f;
#pragma unroll
            for (int k = 0; k < 8; ++k) { const int w = d == 0 ? k : 7 - k; typedef float f2 __attribute__((ext_vector_type(2))); const f2 e2 = *(const LAS f2*)(EXC + (w * 64 + ch) * 2);
                const bool before = d == 0 ? (w < wave) : (w > wave);
                if (before) h = e2[0] * h + e2[1];
                totH = e2[0] * totH + e2[1]; totA *= e2[0]; }
            if (stage == 0) { if (wave == 0 && hi == 0) { float* s = SUM + (((size_t)pm * 2 + d) * LW + 64 * hb + ch) * 2; s[0] = totA; s[1] = totH; } }
            else {
                float hq[4] = {0.f, 0.f, 0.f, 0.f};
#pragma unroll
                for (int k = 0; k < 8; ++k) { const int s = d == 0 ? k : 7 - k; const int q = s >> 1;
                    hq[q] = ((s & 1) == hi) ? h : hq[q];
                    h = gA[chh][s] * h + gB[chh][s]; }
#pragma unroll
                for (int q = 0; q < 4; ++q) { float hh = hq[q];
#pragma unroll
                    for (int e = 0; e < 4; ++e) { const int r = 4 * q + (d == 0 ? e : 3 - e); hh = acc[chh][r] * hh + acc[2 + chh][r]; acc[2 + chh][r] = hh; } }
                if (d == 0) Hf[chh] = acc[2 + chh];
                else {
                    bf16_t* Y = (bf16_t*)(F.ws + WS_Y) + (size_t)pm * 256 * D + 640 + 64 * hb + ch;
#pragma unroll
                    for (int r = 0; r < 16; ++r) { const int rl = wave * 32 + crow(r, hi);
                        const float g = bf2f(P[(size_t)rl * DINP + O_CG + 64 * hb + ch]);
                        const float u2 = (2.0f * 0.7978845608028654f * LOG2E) * (g + 0.044715f * g * g * g);
                        const float ge = g * __builtin_amdgcn_rcpf(1.0f + __builtin_amdgcn_exp2f(-u2));
                        Y[(size_t)rl * D] = (bf16_t)f2bf((Hf[chh][r] + acc[2 + chh][r]) * ge); }
                }
            }
        }
    }
    __syncthreads();
}

__device__ __forceinline__ void unit_map16(const Frame& F, int u, int& gi, int& sub) {
    if (F.G == 256) { const int bid = u & 255, rnd = u >> 8, x = bid & 7, k = bid >> 3; gi = rnd * 16 + 2 * x + (k >> 4); sub = k & 15; }
    else { gi = u >> 4; sub = u & 15; }
}
__device__ __forceinline__ void phase_p2a(Frame& F, int l) {
    if (!(F.flags & 1)) for (int it = F.bid; it < NTILE * 6; it += F.G) lru_item(F, l, it / 6, it % 6, 0);
    if (F.flags & 2) return;
    for (int u = F.bid; u < NB * 2 * 16; u += F.G) { int gi, pb; unit_map16(F, u, gi, pb); for (int g = 0; g < 3; ++g) sw_unit(F, l, gi >> 1, gi & 1, C + pb * 256, g); }
    if (l == 0) for (int u = F.bid; u < NB * 2; u += F.G) for (int g = 0; g < 3; ++g) sw_unit(F, l, u >> 1, u & 1, 0, g);
}
__device__ __forceinline__ void phase_p2b(Frame& F, int l) {
    if (!(F.flags & 1)) for (int it = F.bid; it < NTILE * 6; it += F.G) { const int pm = it / 6; if (l == 1 && pm % TPB == 0) continue; lru_item(F, l, pm, it % 6, 1); }
    if (F.flags & 2) return;
    for (int u = F.bid; u < NB * 4 * 16; u += F.G) { int gi, qb; unit_map16(F, u, gi, qb); da_unit(F, l, gi >> 2, gi & 3, C + qb * 256, RB); }
    if (l == 0) for (int u = F.bid; u < NB * 4; u += F.G) da_unit(F, l, u >> 2, u & 3, 0, C);
}
#define XB_TMO      128
#define XB_XCNT(j)  (256  + 64 * (j))
#define XB_XSUB(j)  (1280 + 64 * (j))
#define XB_XGEN(j)  (2304 + 64 * (j))
#define XB_TOP      3328
#define XB_TOPGEN   3392
#define XCD_BAR_WORDS 3456
#define XB_SPIN_CAP (1u << 18)

__device__ __forceinline__ unsigned xb_ld(unsigned* p)              { return __hip_atomic_load(p, __ATOMIC_RELAXED, __HIP_MEMORY_SCOPE_AGENT); }
__device__ __forceinline__ unsigned xb_add(unsigned* p, unsigned v) { return __hip_atomic_fetch_add(p, v, __ATOMIC_RELAXED, __HIP_MEMORY_SCOPE_AGENT); }
__device__ __forceinline__ unsigned xb_xcc_id() { return (unsigned)__builtin_amdgcn_s_getreg((3 << 11) | 20) & 0xFu; }
#define XB_SPIN(cond, bar) do { unsigned _sp = 0; while (cond) { __builtin_amdgcn_s_sleep(1); \
    if ((++_sp & 255u) == 0u) { if (xb_ld(&(bar)[XB_TMO])) break; if (_sp > XB_SPIN_CAP) { atomicAdd(&(bar)[XB_TMO], 1u); break; } } } } while (0)

struct XcdBarrier {
    unsigned* bar; unsigned x;
    volatile LAS unsigned* st;
};

__device__ __forceinline__ XcdBarrier xcd_barrier_post(unsigned* bar, volatile LAS unsigned* st, int tid) {
    XcdBarrier b; b.bar = bar; b.x = xb_xcc_id(); b.st = st;
    if (tid == 0) (void)xb_add(&bar[XB_XCNT(b.x)], 1u);
    return b;
}
__device__ __forceinline__ void xcd_barrier_complete(unsigned* bar, unsigned x, unsigned& nloc, unsigned& nx) {
    const unsigned G = gridDim.x * gridDim.y * gridDim.z;
    unsigned sum, cnt, mine, sp = 0u;
    for (;;) {
        sum = 0u; cnt = 0u; mine = 0u;
#pragma unroll
        for (unsigned j = 0; j < 16; ++j) { const unsigned c = xb_ld(&bar[XB_XCNT(j)]); sum += c; cnt += (c > 0u) ? 1u : 0u; mine = (j == x) ? c : mine; }
        if (sum == G) break;
        __builtin_amdgcn_s_sleep(1);
        if ((++sp & 255u) == 0u) { if (xb_ld(&bar[XB_TMO])) break; if (sp > XB_SPIN_CAP) { atomicAdd(&bar[XB_TMO], 1u); break; } }
    }
    nloc = mine > 0u ? mine : 1u; nx = cnt > 0u ? cnt : 1u;
}

__device__ __forceinline__ void xcd_barrier(const XcdBarrier& b, int tid) {
    asm volatile("s_waitcnt vmcnt(0)" ::: "memory");
    __syncthreads();
    if (tid == 0) {
        unsigned* bar = b.bar;
        __builtin_amdgcn_s_waitcnt(0);
        unsigned nloc = b.st[0], nx = b.st[1];
        if (nloc == 0u) { xcd_barrier_complete(bar, b.x, nloc, nx); b.st[0] = nloc; b.st[1] = nx; }
        const unsigned old = xb_add(&bar[XB_XSUB(b.x)], 1u);
        const unsigned gen = old / nloc;
        if (old + 1u == (gen + 1u) * nloc) {
            __builtin_amdgcn_fence(__ATOMIC_RELEASE, "agent");
            asm volatile("s_waitcnt vmcnt(0)" ::: "memory");
            const unsigned og = xb_add(&bar[XB_TOP], 1u);
            const unsigned tg = og / nx;
            if (og + 1u == (tg + 1u) * nx) xb_add(&bar[XB_TOPGEN], 1u);
            else XB_SPIN(xb_ld(&bar[XB_TOPGEN]) == tg, bar);
            __builtin_amdgcn_fence(__ATOMIC_ACQUIRE, "agent");
            xb_add(&bar[XB_XGEN(b.x)], 1u);
            asm volatile("s_waitcnt vmcnt(0)" ::: "memory");
        } else {
            XB_SPIN(xb_ld(&bar[XB_XGEN(b.x)]) == gen, bar);
            __builtin_amdgcn_fence(__ATOMIC_ACQUIRE, "agent");
            asm volatile("s_waitcnt vmcnt(0)" ::: "memory");
        }
    }
    __syncthreads();
}

constexpr int CW_BAR = 4096;
constexpr int LDS_MISC = 131072 + 8192;
#ifndef PROBE_DOUBLE
#define PROBE_DOUBLE (-1)
#endif
struct Args { const float* in[31]; float* out; unsigned char* ws; int ph_lo, ph_hi, flags, pad; };
constexpr int N_PHASES = 14;
__global__ void __launch_bounds__(NTHREADS, 2) mk_fwd(Args args) {
    extern __shared__ __attribute__((aligned(16))) unsigned char lds_raw[];
    cg::grid_group grid = cg::this_grid();
    Frame F;
    F.lds = (LAS unsigned char*)lds_raw;
    F.G = gridDim.x;
    F.inp = args.in; F.out = args.out; F.flags = args.flags;
    const int lo = args.ph_lo, hi = args.ph_hi;
    volatile LAS unsigned* bst = (volatile LAS unsigned*)(F.lds + LDS_MISC);
    if (threadIdx.x < 2) bst[threadIdx.x] = 0u;
    __syncthreads();
    XcdBarrier xbar = xcd_barrier_post((unsigned*)args.ws + CW_BAR, bst, (int)threadIdx.x);
    const int wave0 = __builtin_amdgcn_readfirstlane((int)threadIdx.x >> 6);
#define MK_PHASE(k, CALL) do { if (lo <= (k) && (k) < hi) { \
        { const int ln_ = fresh_lane(); int wv_ = wave0; asm volatile("" : "+s"(wv_)); F.lane = ln_; F.wave = wv_; F.tid = wv_ * 64 + ln_; } \
        { int bx = blockIdx.x; asm volatile("" : "+s"(bx)); F.bid = bx; F.vcu = (F.G % 8 == 0) ? (bx % 8) * (F.G / 8) + bx / 8 : bx; } \
        { unsigned char* w_ = args.ws; asm volatile("" : "+s"(w_)); F.ws = w_; int z_ = 0; asm volatile("" : "+s"(z_)); F.zero = z_; } \
        CALL; if ((k) + 1 < hi) { if ((k) == 0) grid.sync(); else xcd_barrier(xbar, wave0 * 64 + fresh_lane()); } } } while (0)
    MK_PHASE(0, phase_p0a(F));
    MK_PHASE(1, phase_p0b(F));
    MK_PHASE(2, phase_p1(F, 0));
    MK_PHASE(3, phase_p2a(F, 0));
    MK_PHASE(4, phase_p2b(F, 0));
    MK_PHASE(5, phase_p3(F, 0));
    MK_PHASE(6, phase_p4(F, 0));
    MK_PHASE(7, phase_p5(F, 0));
    MK_PHASE(8, phase_p1(F, 1));
    MK_PHASE(9, phase_p2a(F, 1));
    MK_PHASE(10, phase_p2b(F, 1));
    MK_PHASE(11, phase_p3(F, 1));
    MK_PHASE(12, phase_p4(F, 1));
    MK_PHASE(13, phase_p5(F, 1));
#undef MK_PHASE
}
}

static int mk_setup() {
    static int grid = 0;
    if (grid == 0) {
        int dev = 0, cus = 0, per_cu = 0;
        hipGetDevice(&dev); hipDeviceGetAttribute(&cus, hipDeviceAttributeMultiprocessorCount, dev);
        hipFuncSetAttribute((const void*)mk::mk_fwd, hipFuncAttributeMaxDynamicSharedMemorySize, mk::LDS_BYTES);
        hipOccupancyMaxActiveBlocksPerMultiprocessor(&per_cu, (const void*)mk::mk_fwd, mk::NTHREADS, mk::LDS_BYTES);
        (void)hipGetLastError();
        if (per_cu < 1) { fprintf(stderr, "mk_setup: occupancy query says %d blocks/CU\n", per_cu); per_cu = 1; }
        grid = cus;
        fprintf(stderr, "mk_setup: cus %d per_cu %d grid %d\n", cus, per_cu, grid);
    }
    return grid;
}
static void mk_run(void* const* d_in, void* d_out, void* d_ws, hipStream_t stream, int lo, int hi, bool coop, int flags = 0) {
    const int grid = mk_setup();
    mk::Args a{};
    for (int i = 0; i < 31; ++i) a.in[i] = (const float*)d_in[i];
    a.out = (float*)d_out; a.ws = (unsigned char*)d_ws; a.ph_lo = lo; a.ph_hi = hi; a.flags = flags;
    if (coop) { void* params[] = {&a}; hipError_t e = hipLaunchCooperativeKernel((const void*)mk::mk_fwd, dim3(grid), dim3(mk::NTHREADS), params, mk::LDS_BYTES, stream);
        if (e != hipSuccess) fprintf(stderr, "coop launch failed: %s\n", hipGetErrorString(e)); }
    else hipLaunchKernelGGL(mk::mk_fwd, dim3(grid), dim3(mk::NTHREADS), mk::LDS_BYTES, stream, a);
}

extern "C" void kernel_launch(void* const* d_in, const int* in_sizes, int n_in, void* d_out, int out_size, void* d_ws, size_t ws_size, hipStream_t stream) {
    if (ws_size < mk::WS_END) { fprintf(stderr, "ws too small\n"); return; }
    hipMemsetAsync(d_ws, 0, mk::MiB, stream);
    mk_run(d_in, d_out, d_ws, stream, 0, mk::N_PHASES, true);
}
```

```cpp
#include <hip/hip_runtime.h>
#include <hip/hip_cooperative_groups.h>
#include <math.h>
#include <stdint.h>
#include <cstdio>
namespace cg = cooperative_groups;
namespace pg8 {
#define PG8_LAS __attribute__((address_space(3)))
typedef unsigned short bf16_t;
typedef short bf16x8 __attribute__((ext_vector_type(8)));
typedef float f32x4 __attribute__((ext_vector_type(4)));
typedef unsigned u32x4 __attribute__((ext_vector_type(4)));
constexpr int BM = 256, BK = 64, HALF = 128, HTB = HALF * BK * 2  , STAGE_BYTES = 8 * HTB, NXCD = 8, WGM = 8;

__host__ __device__ __forceinline__ int lds_byte(int r, int c) { const int st = (r >> 4) * 2 + (c >> 5), rr = r & 15, cc = c & 31, ob = rr * 64 + cc * 2; return st * 1024 + (ob ^ (((ob >> 9) & 1) << 5)); }
__host__ __device__ __forceinline__ void stage_rc(int b, int& R, int& C) { const int st = b / 1024, sb = b % 1024, swz = sb ^ (((sb >> 9) & 1) << 5); R = (st >> 1) * 16 + swz / 64; C = (st & 1) * 32 + (swz % 64) / 2; }
__host__ __device__ __forceinline__ int perm32(int rho) { const int n = rho >> 4, i = rho & 15; return 8 * (i >> 2) + 4 * n + (i & 3); }

struct Unit { int pm, pn; };
struct Gemm { const bf16_t* A; const bf16_t* Bt; int M, N, K; };

struct StaticOrder {
    int nM, nN, nwg, G, c;
    __host__ __device__ void init(int M, int N, int G_, int c_) { nM = M / BM; nN = N / BM; nwg = nM * nN; G = G_; c = c_; }
    __host__ __device__ bool next(int i, Unit& u) const {
        const long L = (long)i * G + c; if (L >= nwg) return false;
        int wgid = (int)L; { const int q = nwg / NXCD, r = nwg % NXCD, xcd = wgid % NXCD, off = wgid / NXCD; wgid = (xcd < r ? xcd * (q + 1) : r * (q + 1) + (xcd - r) * q) + off; }
        const int nig = WGM * nN, gid = wgid / nig, fm = gid * WGM, gsz = (nM - fm) < WGM ? (nM - fm) : WGM;
        u.pm = fm + ((wgid % nig) % gsz); u.pn = (wgid % nig) / gsz; return true;
    }
    __device__ __forceinline__ void a_ready(const Unit&) const {}
    __device__ __forceinline__ void done(const Unit&) const {}
};


template <class Epi, class Sched, bool ALIGN_EPI = false, bool SP2 = false>
__device__ __forceinline__ void gemm_phase(PG8_LAS unsigned char* lds, const Gemm g, const Sched& S, const Epi& E, const int tid) {
    const int wid = __builtin_amdgcn_readfirstlane(tid >> 6), lane = tid & 63, wr = wid >> 2, wc = wid & 3, fr = lane & 15, fq = lane >> 4;
    const int K = g.K, nt = K / BK;
    unsigned voffA[2], voffB[2];
#pragma unroll
    for (int i = 0; i < 2; ++i) { int R, C; stage_rc(tid * 16 + i * 8192, R, C); const int Rb = Epi::PERM ? ((R & ~31) + perm32(R & 31)) : R;
        voffA[i] = (unsigned)(R * K + C) * 2u; voffB[i] = (unsigned)(Rb * K + C) * 2u; }
    const size_t kstep = (size_t)(BK * 2);
    const size_t hstep = (size_t)HALF * K * 2;
    const size_t tstep = 2 * hstep;
    const unsigned ldsw = (unsigned)wid * 1024u;
    const int aoff = lds_byte(wr * 64 + fr, fq * 8), boff = lds_byte(wc * 32 + fr, fq * 8);
#define PG8_SA(b, h) (((b) * 2 + (h)) * HTB)
#define PG8_SB(b, h) ((4 + (b) * 2 + (h)) * HTB)
#define PG8_STAGE(bufoff, gbase, voff) do { _Pragma("unroll") for (int _i = 0; _i < 2; ++_i) \
        __builtin_amdgcn_global_load_lds((const unsigned*)((const char*)(gbase) + (voff)[_i]), (PG8_LAS unsigned*)(lds + (bufoff) + ldsw + _i * 8192), 16, 0, 0); } while (0)
#define PG8_LDA(dst, b, h) do { _Pragma("unroll") for (int m = 0; m < 4; ++m) _Pragma("unroll") for (int k = 0; k < 2; ++k) dst[m][k] = *(const PG8_LAS bf16x8*)(lds + PG8_SA(b, h) + aoff + m * 2048 + k * 1024); } while (0)
#define PG8_LDB(dst, b, h) do { _Pragma("unroll") for (int n = 0; n < 2; ++n) _Pragma("unroll") for (int k = 0; k < 2; ++k) dst[n][k] = *(const PG8_LAS bf16x8*)(lds + PG8_SB(b, h) + boff + n * 2048 + k * 1024); } while (0)
#define PG8_MMA(ai, bj, At, Bt) do { __builtin_amdgcn_s_setprio(1); _Pragma("unroll") for (int m = 0; m < 4; ++m) _Pragma("unroll") for (int n = 0; n < 2; ++n) _Pragma("unroll") for (int k = 0; k < 2; ++k) \
        acc[ai][bj][m][n] = __builtin_amdgcn_mfma_f32_16x16x32_bf16(Bt[n][k], At[m][k], acc[ai][bj][m][n], 0, 0, 0); __builtin_amdgcn_s_setprio(0); } while (0)
#define PG8_WAIT_V(n) asm volatile("s_waitcnt vmcnt(" #n ")" ::: "memory")
#define PG8_WAIT_L(n) asm volatile("s_waitcnt lgkmcnt(" #n ")" ::: "memory")
#define PG8_BAR __builtin_amdgcn_s_barrier()
#define PG8_SCHED __builtin_amdgcn_sched_barrier(0)
    Unit cur, nxt; int ui = 0;
    if (!S.next(0, cur)) return;
    f32x4 acc[2][2][4][2];
#pragma unroll
    for (int a = 0; a < 2; ++a)
#pragma unroll
        for (int b = 0; b < 2; ++b)
#pragma unroll
            for (int m = 0; m < 4; ++m)
#pragma unroll
                for (int n = 0; n < 2; ++n) acc[a][b][m][n] = (f32x4){0.f, 0.f, 0.f, 0.f};
    bf16x8 At[4][2], B0[2][2], B1[2][2];
    const char* cA = (const char*)g.A + (size_t)cur.pm * tstep; const char* cB = (const char*)g.Bt + (size_t)cur.pn * tstep;
    S.a_ready(cur);
    if constexpr (SP2) {
        PG8_STAGE(PG8_SB(0, 0), cB, voffB); PG8_STAGE(PG8_SB(0, 1), cB + hstep, voffB); PG8_STAGE(PG8_SA(0, 0), cA, voffA); PG8_STAGE(PG8_SA(0, 1), cA + hstep, voffA);
        if (wr == 1) PG8_BAR;
        PG8_WAIT_V(2); PG8_BAR;
        PG8_STAGE(PG8_SB(1, 0), cB + kstep, voffB); PG8_STAGE(PG8_SA(1, 0), cA + kstep, voffA); PG8_STAGE(PG8_SB(1, 1), cB + hstep + kstep, voffB);
        PG8_WAIT_V(6); PG8_BAR;
    } else {
        PG8_STAGE(PG8_SB(0, 0), cB, voffB); PG8_STAGE(PG8_SA(0, 0), cA, voffA); PG8_STAGE(PG8_SB(0, 1), cB + hstep, voffB); PG8_STAGE(PG8_SA(0, 1), cA + hstep, voffA);
        if (wr == 1) PG8_BAR;
        PG8_WAIT_V(4); PG8_BAR;
        PG8_STAGE(PG8_SB(1, 0), cB + kstep, voffB); PG8_STAGE(PG8_SA(1, 0), cA + kstep, voffA); PG8_STAGE(PG8_SB(1, 1), cB + hstep + kstep, voffB);
        PG8_WAIT_V(6); PG8_BAR;
    }
    for (;;) {
        const bool has_next = S.next(ui + 1, nxt);
        const char* nA = has_next ? (const char*)g.A + (size_t)nxt.pm * tstep : cA; const char* nB = has_next ? (const char*)g.Bt + (size_t)nxt.pn * tstep : cB;
        for (int t = 0; t < nt; t += 2) {
            const bool last = (t == nt - 2);
            const char* a1 = cA + (size_t)(t + 1) * kstep;
            const char* a2 = last ? nA : cA + (size_t)(t + 2) * kstep; const char* b2 = last ? nB : cB + (size_t)(t + 2) * kstep;
            const char* a3 = a2 + kstep; const char* b3 = b2 + kstep;
            if (last && has_next) S.a_ready(nxt);
            if constexpr (SP2) {
            PG8_LDB(B0, 0, 0); PG8_LDB(B1, 0, 1); PG8_SCHED; PG8_LDA(At, 0, 0); PG8_STAGE(PG8_SA(1, 1), a1 + hstep, voffA);
            PG8_WAIT_V(8); PG8_WAIT_L(0); PG8_BAR; PG8_MMA(0, 0, At, B0); PG8_MMA(0, 1, At, B1); PG8_BAR; PG8_SCHED;
            PG8_LDA(At, 0, 1); PG8_STAGE(PG8_SB(0, 0), b2, voffB); PG8_STAGE(PG8_SB(0, 1), b2 + hstep, voffB); PG8_STAGE(PG8_SA(0, 0), a2, voffA);
            PG8_WAIT_V(8); PG8_WAIT_L(0); PG8_BAR; PG8_MMA(1, 0, At, B0); PG8_MMA(1, 1, At, B1); PG8_BAR; PG8_SCHED;
            PG8_LDB(B0, 1, 0); PG8_LDB(B1, 1, 1); PG8_SCHED; PG8_LDA(At, 1, 0); PG8_STAGE(PG8_SA(0, 1), a2 + hstep, voffA);
            PG8_WAIT_V(8); PG8_WAIT_L(0); PG8_BAR; PG8_MMA(0, 0, At, B0); PG8_MMA(0, 1, At, B1); PG8_BAR; PG8_SCHED;
            PG8_LDA(At, 1, 1); PG8_STAGE(PG8_SB(1, 0), b3, voffB); PG8_STAGE(PG8_SB(1, 1), b3 + hstep, voffB); PG8_STAGE(PG8_SA(1, 0), a3, voffA);
            PG8_WAIT_V(8); PG8_WAIT_L(0); PG8_BAR; PG8_MMA(1, 0, At, B0); PG8_MMA(1, 1, At, B1); PG8_BAR; PG8_SCHED;
            } else {
            PG8_LDB(B0, 0, 0); PG8_SCHED; PG8_LDA(At, 0, 0); PG8_STAGE(PG8_SA(1, 1), a1 + hstep, voffA);
            PG8_WAIT_L(8); PG8_BAR; PG8_WAIT_L(0); PG8_MMA(0, 0, At, B0); PG8_BAR; PG8_SCHED;
            PG8_LDB(B1, 0, 1); PG8_STAGE(PG8_SB(0, 0), b2, voffB);
            PG8_BAR; PG8_WAIT_L(0); PG8_MMA(0, 1, At, B1); PG8_BAR;
            PG8_LDA(At, 0, 1); PG8_STAGE(PG8_SA(0, 0), a2, voffA);
            PG8_BAR; PG8_WAIT_L(0); PG8_MMA(1, 0, At, B0); PG8_BAR; PG8_SCHED;
            PG8_STAGE(PG8_SB(0, 1), b2 + hstep, voffB);
            PG8_WAIT_V(6); PG8_BAR; PG8_MMA(1, 1, At, B1); PG8_BAR;
            PG8_LDB(B0, 1, 0); PG8_SCHED; PG8_LDA(At, 1, 0); PG8_STAGE(PG8_SA(0, 1), a2 + hstep, voffA);
            PG8_WAIT_L(8); PG8_BAR; PG8_WAIT_L(0); PG8_MMA(0, 0, At, B0); PG8_BAR; PG8_SCHED;
            PG8_LDB(B1, 1, 1); PG8_STAGE(PG8_SB(1, 0), b3, voffB);
            PG8_BAR; PG8_WAIT_L(0); PG8_MMA(0, 1, At, B1); PG8_BAR;
            PG8_LDA(At, 1, 1); PG8_STAGE(PG8_SA(1, 0), a3, voffA);
            PG8_BAR; PG8_WAIT_L(0); PG8_MMA(1, 0, At, B0); PG8_BAR; PG8_SCHED;
            PG8_STAGE(PG8_SB(1, 1), b3 + hstep, voffB);
            PG8_WAIT_V(6); PG8_BAR; PG8_MMA(1, 1, At, B1); PG8_BAR;
            }
        }
        if constexpr (ALIGN_EPI) { if (wr == 0) PG8_BAR; }
        if constexpr (!Epi::AFTER_DRAIN) { E(acc, cur, wr, wc, fr, fq); S.done(cur); }
        if (!has_next) break;
#pragma unroll
        for (int a = 0; a < 2; ++a)
#pragma unroll
            for (int b = 0; b < 2; ++b)
#pragma unroll
                for (int m = 0; m < 4; ++m)
#pragma unroll
                    for (int n = 0; n < 2; ++n) acc[a][b][m][n] = (f32x4){0.f, 0.f, 0.f, 0.f};
        cur = nxt; cA = nA; cB = nB; ++ui;
        if constexpr (ALIGN_EPI) { if (wr == 1) PG8_BAR; }
    }
    PG8_WAIT_V(0);
    if constexpr (!ALIGN_EPI) { if (wr == 0) PG8_BAR; }
    PG8_BAR;
    if constexpr (Epi::AFTER_DRAIN) { E.fused(acc, cur, wr, wc, fr, fq, lds, wid, lane); S.done(cur); }
#undef PG8_SA
#undef PG8_SB
#undef PG8_STAGE
#undef PG8_LDA
#undef PG8_LDB
#undef PG8_MMA
#undef PG8_WAIT_V
#undef PG8_WAIT_L
#undef PG8_BAR
#undef PG8_SCHED
}
}

#ifndef PG8_SP2
#define PG8_SP2 true
#endif

namespace mk {
using pg8::bf16_t; using pg8::f32x4; using pg8::Unit;
#define LAS __attribute__((address_space(3)))
typedef unsigned u32x2 __attribute__((ext_vector_type(2)));
typedef unsigned u32x4 __attribute__((ext_vector_type(4)));
constexpr int D = 1024, NB = 8, T = 4096, C = 256, RB = C + T, MALL = NB * RB, NTILE = MALL / 256, TPB = RB / 256  ;
constexpr int DIN = 2176, DINP = 2304, DMIX = 1024, DFF = 2816, NMOD = 6, LW = 384;
constexpr float EPS = 1e-6f, LOG2E = 1.4426950408889634f;
constexpr float QSA = 0.17677669529663687f * LOG2E, QSB = 0.125f * LOG2E;
constexpr int O_AQ = 0, O_AK = 256, O_AV = 512, O_BQ = 768, O_BK = 1152, O_BV = 1280, O_CX = 1408, O_CG = 1792;
constexpr int NWAVES = 8, NTHREADS = 512;
constexpr size_t MiB = 1u << 20;
constexpr size_t WS_CTL = 0;
constexpr size_t WS_WIN = 1 * MiB;
constexpr size_t WS_WOUT = 10 * MiB;
constexpr size_t WS_WUP = 14 * MiB;
constexpr size_t WS_WDN = 36 * MiB;
constexpr size_t WS_MOD = 47 * MiB;
constexpr size_t WS_BIAS1 = WS_MOD + 512 * 1024;
constexpr size_t WS_BIAS2 = WS_BIAS1 + 256 * 1024;
constexpr size_t WS_TAB = WS_BIAS2 + 512 * 1024;
constexpr size_t WS_TAB64 = WS_TAB + 4096, WS_PAR = WS_TAB64 + 8192;
constexpr int PAR_STRIDE = 512, PR_GQ32 = 0, PR_GK32 = 32, PR_GQ64 = 64, PR_GK64 = 128, PR_SUBG = 192, PR_SINK = 256, PR_LAM = 272, PR_MA = 273, PR_MB = 274, PR_LI = 275;
constexpr size_t WS_GAIN = WS_PAR + 8192;
constexpr size_t WS_FFNP = WS_GAIN + 16384;
constexpr size_t WS_LRUP = WS_FFNP + 96 * 1024;
constexpr size_t WS_LRUW = WS_LRUP + 32 * 1024;
constexpr size_t WS_VNM = WS_LRUW + 512 * 1024;
constexpr size_t WS_SS1 = 50 * MiB;
constexpr size_t WS_SS2 = WS_SS1 + 1 * MiB;
constexpr size_t WS_LRU = 55 * MiB;
constexpr size_t WS_XC = 56 * MiB;
constexpr size_t WS_SIDE = 64 * MiB;
constexpr size_t WS_VN = 73 * MiB;
constexpr size_t WS_P = 141 * MiB;
constexpr size_t WS_Y = 294 * MiB;
constexpr size_t WS_U = WS_P;
constexpr size_t WS_END = 362 * MiB;
static_assert(WS_FFNP + 2 * 4 * DFF * 4 <= WS_LRUP && WS_LRUW + 2 * 2 * 6 * 128 * 64 * 2 <= WS_VNM && WS_VNM + 3 * 9 * 1024 * 4 <= WS_SS1 && WS_SS2 + (size_t)MALL * 64 <= WS_LRU && WS_SIDE + (size_t)NTILE * 6 * DFF * 4 <= WS_VN && WS_U + (size_t)MALL * DFF * 2 <= WS_END && WS_P + (size_t)MALL * DINP * 2 <= WS_Y && WS_Y + (size_t)MALL * D * 2 <= WS_END && WS_VN + (size_t)MALL * D * 2 <= WS_P, "ws map");
constexpr int LDS_BYTES = 163840;
constexpr int LDS_EX = 131072, LDS_RED = LDS_EX + 4096, LDS_TAB32 = LDS_EX + 12288, LDS_TAB64 = LDS_EX + 16384;

__device__ __forceinline__ unsigned f2bf(float f) { unsigned u = __builtin_bit_cast(unsigned, f); return (u + 0x7fffu + ((u >> 16) & 1u)) >> 16; }
__device__ __forceinline__ unsigned pk2(float lo, float hi) { return f2bf(lo) | (f2bf(hi) << 16); }
__device__ __forceinline__ float bf2f(unsigned short h) { return __builtin_bit_cast(float, (unsigned)h << 16); }
__device__ __forceinline__ float sigmoidf_(float x) { return 1.f / (1.f + __expf(-x)); }
__device__ __forceinline__ float siluf_(float x) { return x * sigmoidf_(x); }
#define LDS_WAIT() asm volatile("s_waitcnt lgkmcnt(0)" ::: "memory")
#define GAS __attribute__((address_space(1)))
typedef float f32x2_t __attribute__((ext_vector_type(2))); typedef __bf16 bf16x2_t __attribute__((ext_vector_type(2)));
__device__ __forceinline__ unsigned cvtpk(float lo, float hi) { f32x2_t v = {lo, hi}; bf16x2_t b = __builtin_convertvector(v, bf16x2_t); return __builtin_bit_cast(unsigned, b); }
__device__ __forceinline__ f32x4 ldg4(const float* p) { return *(const GAS f32x4*)p; }
__device__ __forceinline__ void stg4(float* p, f32x4 v) { *(GAS f32x4*)p = v; }
__device__ __forceinline__ void stg2u(bf16_t* p, f32x4 v) { u32x2 o; o.x = cvtpk(v[0], v[1]); o.y = cvtpk(v[2], v[3]); *(GAS u32x2*)p = o; }
__device__ __forceinline__ int fresh_lane() { unsigned z = 0u; asm volatile("" : "+v"(z)); return (int)__builtin_amdgcn_mbcnt_hi(~0u, __builtin_amdgcn_mbcnt_lo(~0u, z)); }

struct Frame {
    LAS unsigned char* lds;
    int tid, lane, wave, vcu, G, bid, flags;
    const float* const* inp; int zero; float* out; unsigned char* ws;
    __device__ __forceinline__ const float* in_(int k) const { return inp[k + zero]; }
};

__device__ __forceinline__ int map_in(int n) {
    const int tile = n >> 8, lc = n & 255;
    if (tile <= 1) { const int s = lc >> 5, bj = (lc >> 4) & 1, q = lc & 15; return (tile << 8) + 128 * bj + 32 * (s >> 1) + 16 * (s & 1) + q; }
    if (tile == 3 || tile == 4) { const int z = lc >> 6, bj = (lc >> 5) & 1, q = lc & 31; return (tile << 8) + 128 * bj + 32 * z + q; }
    return n;
}
__device__ __forceinline__ int map_up(int n) { if (n < DFF) return 256 * (n >> 7) + (n & 127); const int c = n - DFF; return 256 * (c >> 7) + 128 + (c & 127); }

template <int MAP> __device__ __forceinline__ void transpose_item(const float* __restrict__ W, int K, int N, bf16_t* __restrict__ WT, LAS float* scr, int item, int lane) {
    const int nblk = N / 32, kb = item / nblk, nb = item % nblk, k0 = 64 * kb, n0 = 32 * nb;
#pragma unroll 8
    for (int i = 0; i < 32; ++i) { const int kk = 2 * i + (lane >> 5); scr[kk * 33 + (lane & 31)] = W[(size_t)(k0 + kk) * N + n0 + (lane & 31)]; }
    LDS_WAIT(); asm volatile("" ::: "memory");
    const int c = lane & 7;
#pragma unroll
    for (int j = 0; j < 4; ++j) { const int n = (lane >> 3) + 8 * j; const LAS float* s = scr + (8 * c) * 33 + n;
        u32x4 o; o.x = pk2(s[0 * 33], s[1 * 33]); o.y = pk2(s[2 * 33], s[3 * 33]); o.z = pk2(s[4 * 33], s[5 * 33]); o.w = pk2(s[6 * 33], s[7 * 33]);
        const int nl = n0 + n; const int row = MAP == 1 ? map_in(nl) : (MAP == 2 ? map_up(nl) : nl);
        *(u32x4*)(WT + (size_t)row * K + k0 + 8 * c) = o; }
    LDS_WAIT(); asm volatile("" ::: "memory");
}

__device__ __forceinline__ void gemv9_item(Frame& F, LAS float* vecs, LAS float* red, const float* __restrict__ W, int ldw, int n0, float* __restrict__ out, int ldo, const float* __restrict__ addb) {
    float acc[9];
#pragma unroll
    for (int v = 0; v < 9; ++v) acc[v] = 0.f;
    const int kb = F.wave * 128;
#pragma unroll 2
    for (int k = 0; k < 128; k += 4) {
        float w[4];
#pragma unroll
        for (int i = 0; i < 4; ++i) w[i] = W[(size_t)(kb + k + i) * ldw + n0 + F.lane];
#pragma unroll
        for (int v = 0; v < 9; ++v) { const f32x4 x = *(const LAS f32x4*)(vecs + v * 1024 + kb + k); acc[v] += x[0] * w[0] + x[1] * w[1] + x[2] * w[2] + x[3] * w[3]; }
    }
#pragma unroll
    for (int v = 0; v < 9; ++v) red[(F.wave * 9 + v) * 64 + F.lane] = acc[v];
    __syncthreads();
    for (int e = F.tid; e < 9 * 64; e += NTHREADS) { const int v = e >> 6, ln = e & 63; float s = 0.f;
#pragma unroll
        for (int w8 = 0; w8 < 8; ++w8) s += red[(w8 * 9 + v) * 64 + ln];
        out[(size_t)v * ldo + n0 + ln] = s + (addb ? addb[n0 + ln] : 0.f); }
    __syncthreads();
}

__device__ const float INVF16[16] = {1.000000000e+00f, 5.623413324e-01f, 3.162277639e-01f, 1.778279394e-01f, 1.000000015e-01f, 5.623413250e-02f, 3.162277490e-02f, 1.778279431e-02f,
                                     9.999999776e-03f, 5.623413250e-03f, 3.162277630e-03f, 1.778279431e-03f, 1.000000047e-03f, 5.623413017e-04f, 3.162277571e-04f, 1.778279402e-04f};
__device__ __forceinline__ void phase_p0a(Frame& F) {
    const float* w_in = F.in_(8); const float* w_out = F.in_(26); const float* w_up = F.in_(27); const float* w_down = F.in_(30);
    bf16_t* WIN = (bf16_t*)(F.ws + WS_WIN); bf16_t* WOUT = (bf16_t*)(F.ws + WS_WOUT); bf16_t* WUP = (bf16_t*)(F.ws + WS_WUP); bf16_t* WDN = (bf16_t*)(F.ws + WS_WDN);
    LAS float* scr = (LAS float*)(F.lds + F.wave * 16384);
    const int gw = F.vcu * NWAVES + F.wave, NGW = F.G * NWAVES;
    constexpr int I_IN = 16 * (DIN / 32), I_OUT = 16 * 32, I_UP = 16 * (2 * DFF / 32), I_DN = (DFF / 64) * 32, I_L = I_IN + I_OUT + I_UP + I_DN;
    for (int it = gw; it < 2 * I_L; it += NGW) {
        const int l = it / I_L; int r = it % I_L;
        if (r < I_IN) { transpose_item<1>(w_in + (size_t)l * D * DIN, D, DIN, WIN + (size_t)l * DINP * D, scr, r, F.lane); continue; } r -= I_IN;
        if (r < I_OUT) { transpose_item<0>(w_out + (size_t)l * DMIX * D, DMIX, D, WOUT + (size_t)l * D * DMIX, scr, r, F.lane); continue; } r -= I_OUT;
        if (r < I_UP) { transpose_item<2>(w_up + (size_t)l * D * 2 * DFF, D, 2 * DFF, WUP + (size_t)l * 2 * DFF * D, scr, r, F.lane); continue; } r -= I_UP;
        transpose_item<0>(w_down + (size_t)l * DFF * D, DFF, D, WDN + (size_t)l * D * DFF, scr, r, F.lane);
    }
    { const int gt = F.vcu * NTHREADS + F.tid, NGT = F.G * NTHREADS; bf16_t* LW_ = (bf16_t*)(F.ws + WS_LRUW);
      for (int e = gt; e < 2 * 2 * 6 * 128 * 64; e += NGT) { const int i = e & 63, o = (e >> 6) & 127, blk = e >> 13;
          LW_[e] = (bf16_t)f2bf((o < 64 ? F.in_(21) : F.in_(23))[(size_t)blk * 4096 + i * 64 + (o & 63)]); } }
    { const int gt = F.vcu * NTHREADS + F.tid, NGT = F.G * NTHREADS; constexpr int PER = (DINP - DIN) * D * 2 / 16;
      for (int e = gt; e < 2 * PER; e += NGT) { const int l = e / PER, o = e % PER; *(u32x4*)((unsigned char*)(WIN + ((size_t)l * DINP + DIN) * D) + (size_t)o * 16) = (u32x4){0u, 0u, 0u, 0u}; } }
    __syncthreads();
    LAS float* vecs = (LAS float*)F.lds; LAS float* red = vecs + 9 * 1024;
    const float* cvec = F.in_(1); const float* cctx = F.in_(3); const float* w_mod = F.in_(4); const float* b_mod = F.in_(5);
    float* MOD = (float*)(F.ws + WS_MOD);
    bool staged = false;
    for (int item = F.bid; item < 2 * 96; item += F.G) {
        if (!staged) { for (int e = F.tid; e < 9 * 1024; e += NTHREADS) { const int v = e >> 10, k = e & 1023; vecs[e] = siluf_(v < 8 ? cvec[v * D + k] : cctx[k]); } __syncthreads(); staged = true; }
        const int l = item / 96, n0 = (item % 96) * 64;
        gemv9_item(F, vecs, red, w_mod + (size_t)l * D * NMOD * D, NMOD * D, n0, MOD + (size_t)l * 9 * NMOD * D, NMOD * D, b_mod + (size_t)l * NMOD * D);
    }
    if (F.bid == F.G - 1) {
        float* tab32 = (float*)(F.ws + WS_TAB); float* tab64 = (float*)(F.ws + WS_TAB64);
        for (int idx = F.tid; idx < 64 * 8 + 64 * 16; idx += NTHREADS) {
            int quarter, pos, fi; float* dst;
            if (idx < 64 * 8) { quarter = 8; pos = idx / 8; fi = idx % 8; dst = tab32 + idx * 2; }
            else { const int j = idx - 64 * 8; quarter = 16; pos = j / 16; fi = j % 16; dst = tab64 + j * 2; }
            const float invf = INVF16[fi * (16 / quarter)];
            const float x = (float)pos * invf;
            const float kf = rintf(x * 0.636619772f); const int kq = (int)kf;
            float r = fmaf(-kf, 1.5703125f, x); r = fmaf(-kf, 4.837512969970703125e-4f, r); r = fmaf(-kf, 7.54978995489188216e-8f, r);
            const float r2 = r * r;
            const float sp = r + r * r2 * (-1.6666654611e-1f + r2 * (8.3321608736e-3f + r2 * (-1.9515295891e-4f)));
            const float cp = 1.0f - 0.5f * r2 + r2 * r2 * (4.166664568298827e-2f + r2 * (-1.388731625493765e-3f + r2 * 2.443315711809948e-5f));
            const int qd = kq & 3;
            const float sv = qd == 0 ? sp : (qd == 1 ? cp : (qd == 2 ? -sp : -cp)), cv = qd == 0 ? cp : (qd == 1 ? -sp : (qd == 2 ? -cp : sp));
            dst[0] = cv; dst[1] = sv;
        }
        float* par = (float*)(F.ws + WS_PAR);
        for (int e = F.tid; e < 2 * 262; e += NTHREADS) { const int l = e / 262, i = e % 262; float v;
            if (i < 32) v = F.in_(9)[l * 32 + i]; else if (i < 64) v = F.in_(10)[l * 32 + i - 32]; else if (i < 128) v = F.in_(16)[l * 64 + i - 64]; else if (i < 192) v = F.in_(17)[l * 64 + i - 128];
            else if (i < 256) v = F.in_(15)[l * 64 + i - 192]; else v = F.in_(18)[l * 6 + i - 256];
            par[l * PAR_STRIDE + i] = v; }
        { float* gn = (float*)(F.ws + WS_GAIN); for (int e = F.tid; e < 4 * D; e += NTHREADS) gn[e] = e < 2 * D ? F.in_(6)[e] : F.in_(7)[e - 2 * D];
          float* fp = (float*)(F.ws + WS_FFNP); for (int e = F.tid; e < 2 * 4 * DFF; e += NTHREADS) { const int l = e / (4 * DFF), i = e % (4 * DFF); fp[e] = i < 3 * DFF ? F.in_(28)[(size_t)l * 3 * DFF + i] : F.in_(29)[(size_t)l * DFF + i - 3 * DFF]; } }
        { float* lp = (float*)(F.ws + WS_LRUP);
          for (int e = F.tid; e < 2 * 2 * LW; e += NTHREADS) { const int ld = e / LW, ch = e % LW;
              lp[(ld * 4 + 0) * LW + ch] = F.in_(22)[e]; lp[(ld * 4 + 1) * LW + ch] = F.in_(24)[e];
              const float lam = F.in_(25)[e]; const float sp = lam > 0.f ? log1pf(expf(-lam)) : -lam + log1pf(expf(lam));
              lp[(ld * 4 + 2) * LW + ch] = 8.0f * LOG2E * sp; lp[(ld * 4 + 3) * LW + ch] = F.in_(20)[e]; } }
        if (F.tid < 2) {
            const int l = F.tid; const float li = 0.8f - 0.6f * expf(-0.3f * (float)l);
            const float* lq1 = F.in_(11) + l * 32; const float* lk1 = F.in_(12) + l * 32; const float* lq2 = F.in_(13) + l * 32; const float* lk2 = F.in_(14) + l * 32;
            float s1 = 0.f, s2 = 0.f; for (int i = 0; i < 32; ++i) { s1 += lq1[i] * lk1[i]; s2 += lq2[i] * lk2[i]; }
            float mq = 0.f, mk_ = 0.f; for (int i = 0; i < 32; ++i) { mq = fmaxf(mq, fabsf(F.in_(9)[l * 32 + i])); mk_ = fmaxf(mk_, fabsf(F.in_(10)[l * 32 + i])); }
            float nq = 0.f, nk = 0.f; for (int i = 0; i < 64; ++i) { nq = fmaxf(nq, fabsf(F.in_(16)[l * 64 + i])); nk = fmaxf(nk, fabsf(F.in_(17)[l * 64 + i])); }
            float mb = QSB * 64.f * nq * nk; for (int i = 0; i < 6; ++i) mb = fmaxf(mb, F.in_(18)[l * 6 + i] * LOG2E);
            par[l * PAR_STRIDE + PR_LAM] = expf(s1) - expf(s2) + li; par[l * PAR_STRIDE + PR_MA] = QSA * 32.f * mq * mk_; par[l * PAR_STRIDE + PR_MB] = mb; par[l * PAR_STRIDE + PR_LI] = li;
        }
    }
}

__device__ __forceinline__ void phase_p0b(Frame& F) {
    LAS float* vecs = (LAS float*)F.lds; LAS float* red = vecs + 9 * 1024;
    const float* MOD = (const float*)(F.ws + WS_MOD); float* B1 = (float*)(F.ws + WS_BIAS1); float* B2 = (float*)(F.ws + WS_BIAS2);
    const float* w_in = F.in_(8); const float* w_up = F.in_(27);
    constexpr int I1 = DIN / 64, I2 = 2 * DFF / 64, IL = I1 + I2;
    for (int item = F.bid; item < 2 * IL; item += F.G) {
        const int l = item / IL; int r = item % IL; const bool is1 = r < I1; if (!is1) r -= I1;
        __syncthreads();
        for (int e = F.tid; e < 9 * 1024; e += NTHREADS) { const int v = e >> 10, k = e & 1023; vecs[e] = MOD[((size_t)l * 9 + v) * NMOD * D + (is1 ? 0 : 3) * D + k]; }
        __syncthreads();
        if (is1) gemv9_item(F, vecs, red, w_in + (size_t)l * D * DIN, DIN, r * 64, B1 + (size_t)l * 9 * DINP, DINP, nullptr);
        else gemv9_item(F, vecs, red, w_up + (size_t)l * D * 2 * DFF, 2 * DFF, r * 64, B2 + (size_t)l * 9 * 2 * DFF, 2 * DFF, nullptr);
    }
    { const int gt = F.vcu * NTHREADS + F.tid, NGT = F.G * NTHREADS; float* VNM = (float*)(F.ws + WS_VNM);
      for (int e = gt; e < 3 * 9 * D; e += NGT) { const int n = e % D, v = (e / D) % 9, k = e / (9 * D); const int l = k == 2 ? 1 : k;
          const float gn = k == 2 ? F.in_(6)[D + n] : F.in_(7)[l * D + n]; const float sc = MOD[((size_t)l * 9 + v) * NMOD * D + (k == 2 ? 1 : 4) * D + n];
          VNM[e] = gn * (1.0f + sc); } }
    { const int gt = F.vcu * NTHREADS + F.tid; if (gt < 2 * 9 * (DINP - DIN)) { const int lv = gt / (DINP - DIN), n = gt % (DINP - DIN); B1[(size_t)lv * DINP + DIN + n] = 0.f; } }
    const float* x = F.in_(0); const float* ctx = F.in_(2); const float* g1 = F.in_(6);
    bf16_t* VN = (bf16_t*)(F.ws + WS_VN); float* SS1 = (float*)(F.ws + WS_SS1);
    const int gw = F.vcu * NWAVES + F.wave, NGW = F.G * NWAVES;
    for (int g = gw; g < MALL; g += NGW) {
        const int b = g / RB, r = g % RB; const int v = r < C ? 8 : b;
        const float* src = r < C ? ctx + ((size_t)b * C + r) * D : x + ((size_t)b * T + (r - C)) * D;
        const float* sc = MOD + ((size_t)0 * 9 + v) * NMOD * D + 1 * D;
        float s = 0.f;
#pragma unroll
        for (int j = 0; j < 4; ++j) { const int n = 4 * F.lane + 256 * j; const f32x4 xv = *(const f32x4*)(src + n); const f32x4 gv = *(const f32x4*)(g1 + n); const f32x4 sv = *(const f32x4*)(sc + n);
            s += xv[0] * xv[0] + xv[1] * xv[1] + xv[2] * xv[2] + xv[3] * xv[3];
            u32x2 o; o.x = pk2(xv[0] * gv[0] * (1.f + sv[0]), xv[1] * gv[1] * (1.f + sv[1])); o.y = pk2(xv[2] * gv[2] * (1.f + sv[2]), xv[3] * gv[3] * (1.f + sv[3]));
            *(u32x2*)(VN + (size_t)g * D + n) = o; }
#pragma unroll
        for (int o = 1; o < 64; o <<= 1) s += __shfl_xor(s, o);
        if (F.lane == 0) *(f32x4*)(SS1 + (size_t)g * 4) = (f32x4){s, 0.f, 0.f, 0.f};
    }
}

struct Order {
    pg8::StaticOrder so; int latent_only;
    __device__ __forceinline__ void init(int nMt, int N, int G, int c, int lat) { so.init(nMt * 256, N, G, c); latent_only = lat; }
    __device__ __forceinline__ bool next(int i, Unit& u) const { if (!so.next(i, u)) return false; if (latent_only) u.pm = (u.pm >> 4) * TPB + 1 + (u.pm & 15); return true; }
    __device__ __forceinline__ void a_ready(const Unit&) const {}
    __device__ __forceinline__ void done(const Unit&) const {}
};

struct EpiIn {
    static constexpr bool PERM = false, AFTER_DRAIN = false;
    unsigned char* ws; LAS unsigned char* lds; int l;
    __device__ __forceinline__ void operator()(const f32x4 (&acc)[2][2][4][2], const Unit& u, int wr, int wc, int fr, int fq) const {
        { const int ln = fresh_lane(); fr = ln & 15; fq = ln >> 4; }
        bf16_t* P = (bf16_t*)(ws + WS_P); const float* SS = (const float*)(ws + WS_SS1); const float* bias = (const float*)(ws + WS_BIAS1) + (size_t)l * 9 * DINP;
        const LAS float* tab32 = (const LAS float*)(lds + LDS_TAB32); const LAS float* tab64 = (const LAS float*)(lds + LDS_TAB64); const float* par = (const float*)(ws + WS_PAR) + l * PAR_STRIDE;
        const int b = u.pm / TPB, j = u.pm % TPB; const bool lat = j != 0; const float* bia = bias + (size_t)(lat ? b : 8) * DINP;
        const int pn = u.pn;
        float rsv[2][4];
        { f32x4 s4[2][4];
#pragma unroll
          for (int ai = 0; ai < 2; ++ai)
#pragma unroll
              for (int m = 0; m < 4; ++m) s4[ai][m] = ldg4(SS + ((size_t)u.pm * 256 + ai * 128 + wr * 64 + m * 16 + fr) * 4);
#pragma unroll
          for (int ai = 0; ai < 2; ++ai)
#pragma unroll
              for (int m = 0; m < 4; ++m) rsv[ai][m] = __builtin_amdgcn_rsqf((s4[ai][m][0] + s4[ai][m][1] + s4[ai][m][2] + s4[ai][m][3]) * (1.0f / D) + EPS); }
        const int tb4 = (j - 1) * 4 + wr;
        if (pn <= 1) {
            const float* gain = par + (pn == 0 ? PR_GQ32 : PR_GK32);
            const f32x4 g1 = ldg4(gain + 4 * fq), g2 = ldg4(gain + 16 + 4 * fq);
            f32x4 b1[2], b2[2];
#pragma unroll
            for (int n = 0; n < 2; ++n) { const int col = 256 * pn + 32 * (2 * wc + n) + 4 * fq; b1[n] = ldg4(bia + col); b2[n] = ldg4(bia + col + 16); }
            const float qs = pn == 0 ? QSA : 1.0f;
#pragma unroll
            for (int ai = 0; ai < 2; ++ai)
#pragma unroll
                for (int m = 0; m < 4; ++m) {
                    const int rloc = ai * 128 + wr * 64 + m * 16 + fr; bf16_t* prow_p = P + ((size_t)u.pm * 256 + rloc) * DINP; const float rs = rsv[ai][m];
                    const int pos = fq < 2 ? tb4 + 2 * ai : 16 * m + fr; const LAS float* tb = tab32 + (pos * 8 + 4 * (fq & 1)) * 2;
                    f32x4 cs, sn;
                    if (lat) { const f32x4 c01 = *(const LAS f32x4*)(tb), c23 = *(const LAS f32x4*)(tb + 4); cs = (f32x4){c01[0], c01[2], c23[0], c23[2]}; sn = (f32x4){c01[1], c01[3], c23[1], c23[3]}; }
#pragma unroll
                    for (int n = 0; n < 2; ++n) {
                        const int col = 256 * pn + 32 * (2 * wc + n) + 4 * fq;
                        f32x4 x1 = acc[ai][0][m][n] * rs + b1[n], x2 = acc[ai][1][m][n] * rs + b2[n];
                        float ss = x1[0] * x1[0] + x1[1] * x1[1] + x1[2] * x1[2] + x1[3] * x1[3] + x2[0] * x2[0] + x2[1] * x2[1] + x2[2] * x2[2] + x2[3] * x2[3];
                        ss += __shfl_xor(ss, 16); ss += __shfl_xor(ss, 32);
                        const float ri = __builtin_amdgcn_rsqf(ss * (1.0f / 32.f) + EPS) * qs;
                        x1 = x1 * ri * g1; x2 = x2 * ri * g2;
                        if (lat) { const f32x4 y1 = x1 * cs - x2 * sn, y2 = x1 * sn + x2 * cs; x1 = y1; x2 = y2; }
                        stg2u(prow_p + col, x1); stg2u(prow_p + col + 16, x2);
                    }
                }
        } else if (pn == 3 || pn == 4) {
            const bool isq = pn == 3 || wc < 2; const float* gain = par + (isq ? PR_GQ64 : PR_GK64);
            const int colb = 256 * pn + 64 * wc;
            f32x4 ga[2], gb[2], ba[2], bb[2];
#pragma unroll
            for (int n = 0; n < 2; ++n) { ga[n] = ldg4(gain + 16 * n + 4 * fq); gb[n] = ldg4(gain + 32 + 16 * n + 4 * fq); ba[n] = ldg4(bia + colb + 16 * n + 4 * fq); bb[n] = ldg4(bia + colb + 32 + 16 * n + 4 * fq); }
            const float qs = isq ? QSB : 1.0f;
#pragma unroll
            for (int ai = 0; ai < 2; ++ai)
#pragma unroll
                for (int m = 0; m < 4; ++m) {
                    const int rloc = ai * 128 + wr * 64 + m * 16 + fr; bf16_t* prow_p = P + ((size_t)u.pm * 256 + rloc) * DINP; const float rs = rsv[ai][m];
                    f32x4 xa[2], xb[2]; float ss = 0.f;
#pragma unroll
                    for (int n = 0; n < 2; ++n) { xa[n] = acc[ai][0][m][n] * rs + ba[n]; xb[n] = acc[ai][1][m][n] * rs + bb[n];
                        ss += xa[n][0] * xa[n][0] + xa[n][1] * xa[n][1] + xa[n][2] * xa[n][2] + xa[n][3] * xa[n][3] + xb[n][0] * xb[n][0] + xb[n][1] * xb[n][1] + xb[n][2] * xb[n][2] + xb[n][3] * xb[n][3]; }
                    ss += __shfl_xor(ss, 16); ss += __shfl_xor(ss, 32);
                    const float ri = __builtin_amdgcn_rsqf(ss * (1.0f / 64.f) + EPS) * qs;
#pragma unroll
                    for (int n = 0; n < 2; ++n) {
                        f32x4 x1 = xa[n] * ri * ga[n], x2 = xb[n] * ri * gb[n];
                        if (lat) { const LAS float* tb = tab64 + ((n == 0 ? tb4 + 2 * ai : 16 * m + fr) * 16 + 4 * fq) * 2; const f32x4 c01 = *(const LAS f32x4*)(tb), c23 = *(const LAS f32x4*)(tb + 4);
                            const f32x4 cs = (f32x4){c01[0], c01[2], c23[0], c23[2]}, sn = (f32x4){c01[1], c01[3], c23[1], c23[3]};
                            const f32x4 y1 = x1 * cs - x2 * sn, y2 = x1 * sn + x2 * cs; x1 = y1; x2 = y2; }
                        stg2u(prow_p + colb + 16 * n + 4 * fq, x1); stg2u(prow_p + colb + 32 + 16 * n + 4 * fq, x2);
                    }
                }
        } else {
            f32x4 bv[2][2];
#pragma unroll
            for (int bj = 0; bj < 2; ++bj)
#pragma unroll
                for (int n = 0; n < 2; ++n) { const int col = 256 * pn + 128 * bj + 32 * wc + 16 * n + 4 * fq; bv[bj][n] = col < DIN ? ldg4(bia + col) : (f32x4){0.f, 0.f, 0.f, 0.f}; }
#pragma unroll
            for (int ai = 0; ai < 2; ++ai)
#pragma unroll
                for (int m = 0; m < 4; ++m) {
                    const int rloc = ai * 128 + wr * 64 + m * 16 + fr; bf16_t* prow_p = P + ((size_t)u.pm * 256 + rloc) * DINP; const float rs = rsv[ai][m];
#pragma unroll
                    for (int bj = 0; bj < 2; ++bj)
#pragma unroll
                        for (int n = 0; n < 2; ++n) { const int col = 256 * pn + 128 * bj + 32 * wc + 16 * n + 4 * fq;
                            if (col < DIN) stg2u(prow_p + col, acc[ai][bj][m][n] * rs + bv[bj][n]); }
                }
        }
    }
};

__device__ __forceinline__ void phase_p1(Frame& F, int l) {
    { const float* t32 = (const float*)(F.ws + WS_TAB); LAS float* d32 = (LAS float*)(F.lds + LDS_TAB32);
      for (int e = F.tid; e < (4096 + 8192) / 16; e += NTHREADS) *(LAS f32x4*)(d32 + 4 * e) = ldg4(t32 + 4 * e);
      __syncthreads(); }
    pg8::Gemm g{(const bf16_t*)(F.ws + WS_VN), (const bf16_t*)(F.ws + WS_WIN) + (size_t)l * DINP * D, MALL, DINP, D};
    Order S; S.init(NTILE, DINP, F.G, (int)F.bid, 0);
    EpiIn E{F.ws, F.lds, l};
    pg8::gemm_phase<EpiIn, Order, true, true>(F.lds, g, S, E, F.tid);
}
struct EpiRes {
    static constexpr bool PERM = false, AFTER_DRAIN = false;
    unsigned char* ws; const float* xin; const float* ctxin; float* out; LAS float* red; int l, kind;
    __device__ __forceinline__ void operator()(const f32x4 (&acc)[2][2][4][2], const Unit& u, int wr, int wc, int fr, int fq) const {
        { const int ln = fresh_lane(); fr = ln & 15; fq = ln >> 4; }
        const float* MOD = (const float*)(ws + WS_MOD);
        const int b = u.pm / TPB, j = u.pm % TPB; const bool lat = j != 0; const int v = lat ? b : 8;
        const float* gate = MOD + ((size_t)l * 9 + v) * NMOD * D + (kind == 0 ? 2 : 5) * D;
        const bool do_vn = kind == 0 || l == 0;
        const float* vnm = (const float*)(ws + WS_VNM) + ((size_t)(kind == 0 ? l : 2) * 9 + v) * D;
        float* SSd = (float*)(ws + (kind == 0 ? WS_SS2 : WS_SS1));
        bf16_t* VN = (bf16_t*)(ws + WS_VN); float* XC = (float*)(ws + WS_XC);
        const bool first = kind == 0 && l == 0;
        const float* srcb = lat ? (first ? xin : out) + (size_t)b * T * D : (first ? ctxin : XC) + (size_t)b * C * D;
        float* dstb = lat ? out + (size_t)b * T * D : XC + (size_t)b * C * D;
        const int rbase = lat ? (j - 1) * 256 : 0;
        const int c0 = 256 * u.pn + 32 * wc + 4 * fq;
        f32x4 gt[2][2], vm[2][2];
#pragma unroll
        for (int bj = 0; bj < 2; ++bj)
#pragma unroll
            for (int n = 0; n < 2; ++n) { gt[bj][n] = ldg4(gate + c0 + 128 * bj + 16 * n); vm[bj][n] = do_vn ? ldg4(vnm + c0 + 128 * bj + 16 * n) : (f32x4){0.f, 0.f, 0.f, 0.f}; }
#pragma unroll
        for (int ai = 0; ai < 2; ++ai) {
            f32x4 xo[4][2][2];
#pragma unroll
            for (int m = 0; m < 4; ++m) { const size_t ro = (size_t)(rbase + ai * 128 + wr * 64 + m * 16 + fr) * D;
#pragma unroll
                for (int bj = 0; bj < 2; ++bj)
#pragma unroll
                    for (int n = 0; n < 2; ++n) xo[m][bj][n] = ldg4(srcb + ro + c0 + 128 * bj + 16 * n); }
#pragma unroll
            for (int m = 0; m < 4; ++m) {
                const int rloc = ai * 128 + wr * 64 + m * 16 + fr; const size_t g = (size_t)u.pm * 256 + rloc; const size_t ro = (size_t)(rbase + rloc) * D;
                float ss = 0.f;
#pragma unroll
                for (int bj = 0; bj < 2; ++bj)
#pragma unroll
                    for (int n = 0; n < 2; ++n) { const int c = c0 + 128 * bj + 16 * n;
                        const f32x4 x = xo[m][bj][n] + gt[bj][n] * acc[ai][bj][m][n];
                        stg4(dstb + ro + c, x);
                        if (do_vn) { stg2u(VN + g * D + c, x * vm[bj][n]); ss += x[0] * x[0] + x[1] * x[1] + x[2] * x[2] + x[3] * x[3]; } }
                if (do_vn) { ss += __shfl_xor(ss, 16); ss += __shfl_xor(ss, 32); if (fq == 0) red[wc * 256 + rloc] = ss; }
            }
        }
        if (do_vn) {
            asm volatile("s_waitcnt lgkmcnt(0)" ::: "memory"); __builtin_amdgcn_s_barrier(); asm volatile("" ::: "memory");
            const int tid = 64 * (4 * wr + wc) + 16 * fq + fr;
            if (tid < 256) SSd[((size_t)u.pm * 256 + tid) * 4 + u.pn] = (red[tid] + red[256 + tid]) + (red[512 + tid] + red[768 + tid]);
        }
    }
};

struct EpiUp {
    static constexpr bool PERM = false, AFTER_DRAIN = false;
    unsigned char* ws; LAS float* ex; int l;
    __device__ __forceinline__ void operator()(const f32x4 (&acc)[2][2][4][2], const Unit& u, int wr, int wc, int fr, int fq) const {
        { const int ln = fresh_lane(); fr = ln & 15; fq = ln >> 4; }
        const float* SS = (const float*)(ws + WS_SS2); const float* ffp = (const float*)(ws + WS_FFNP) + (size_t)l * 4 * DFF;
        const int b = u.pm / TPB, j = u.pm % TPB; const int v = j != 0 ? b : 8;
        const float* bia = (const float*)(ws + WS_BIAS2) + ((size_t)l * 9 + v) * 2 * DFF;
        bf16_t* U = (bf16_t*)(ws + WS_U); float* SIDE = (float*)(ws + WS_SIDE) + (size_t)u.pm * 6 * DFF;
        const int ch0 = 128 * u.pn + 32 * wc + 4 * fq;
        float rsv[2][4];
        { f32x4 s4[2][4];
#pragma unroll
          for (int ai = 0; ai < 2; ++ai)
#pragma unroll
              for (int m = 0; m < 4; ++m) s4[ai][m] = ldg4(SS + ((size_t)u.pm * 256 + ai * 128 + wr * 64 + m * 16 + fr) * 4);
#pragma unroll
          for (int ai = 0; ai < 2; ++ai)
#pragma unroll
              for (int m = 0; m < 4; ++m) rsv[ai][m] = __builtin_amdgcn_rsqf((s4[ai][m][0] + s4[ai][m][1] + s4[ai][m][2] + s4[ai][m][3]) * (1.0f / D) + EPS); }
        f32x4 b4[2], bv4[2], w0[2], w1[2], w2[2], fb[2];
#pragma unroll
        for (int n = 0; n < 2; ++n) { const int ch = ch0 + 16 * n; b4[n] = ldg4(bia + ch); bv4[n] = ldg4(bia + DFF + ch);
            w0[n] = ldg4(ffp + ch); w1[n] = ldg4(ffp + DFF + ch); w2[n] = ldg4(ffp + 2 * DFF + ch); fb[n] = ldg4(ffp + 3 * DFF + ch); }
#pragma unroll
        for (int ai = 0; ai < 2; ++ai)
#pragma unroll
            for (int n = 0; n < 2; ++n) { const int q = 2 * ai + wr; const int cc = 32 * wc + 16 * n + 4 * fq;
                if (fr == 0) *(LAS f32x4*)(ex + (q * 2 + 0) * 128 + cc) = acc[ai][0][0][n] * rsv[ai][0] + b4[n];
                if (fr == 15) *(LAS f32x4*)(ex + (q * 2 + 1) * 128 + cc) = acc[ai][0][3][n] * rsv[ai][3] + b4[n]; }
        asm volatile("s_waitcnt lgkmcnt(0)" ::: "memory"); __builtin_amdgcn_s_barrier(); asm volatile("" ::: "memory");
        const int lane = fr + 16 * fq; const int srcp = (lane & 48) | ((fr + 15) & 15), srcn = (lane & 48) | ((fr + 1) & 15);
#pragma unroll
        for (int ai = 0; ai < 2; ++ai) {
            const int q = 2 * ai + wr;
#pragma unroll
            for (int n = 0; n < 2; ++n) {
                const int cc = 32 * wc + 16 * n + 4 * fq; const int ch = ch0 + 16 * n;
                f32x4 pb = (f32x4){0.f, 0.f, 0.f, 0.f}, nb = pb;
                if (q > 0) pb = *(const LAS f32x4*)(ex + ((q - 1) * 2 + 1) * 128 + cc);
                if (q < 3) nb = *(const LAS f32x4*)(ex + ((q + 1) * 2 + 0) * 128 + cc);
                f32x4 Gm[4];
#pragma unroll
                for (int m = 0; m < 4; ++m) Gm[m] = acc[ai][0][m][n] * rsv[ai][m] + b4[n];
#pragma unroll
                for (int m = 0; m < 4; ++m) {
                    const f32x4 sp = (fr == 15 && m > 0) ? Gm[m > 0 ? m - 1 : 0] : Gm[m], sn = (fr == 0 && m < 3) ? Gm[m < 3 ? m + 1 : 3] : Gm[m];
                    f32x4 prev, next;
#pragma unroll
                    for (int e = 0; e < 4; ++e) { prev[e] = __shfl(sp[e], srcp, 64); next[e] = __shfl(sn[e], srcn, 64); }
                    if (m == 0 && fr == 0) prev = pb;
                    if (m == 3 && fr == 15) next = nb;
                    const f32x4 pre = fb[n] + w0[n] * prev + w1[n] * Gm[m] + w2[n] * next;
                    const f32x4 val = acc[ai][1][m][n] * rsv[ai][m] + bv4[n];
                    f32x4 uu;
#pragma unroll
                    for (int e = 0; e < 4; ++e) uu[e] = pre[e] * __builtin_amdgcn_rcpf(1.0f + __builtin_amdgcn_exp2f(-LOG2E * pre[e])) * val[e];
                    const int rloc = ai * 128 + wr * 64 + m * 16 + fr; const size_t g = (size_t)u.pm * 256 + rloc;
                    stg2u(U + g * DFF + ch, uu);
                    if (rloc == 0) { stg4(SIDE + 0 * DFF + ch, pre); stg4(SIDE + 1 * DFF + ch, val); stg4(SIDE + 2 * DFF + ch, Gm[m]); }
                    if (rloc == 255) { stg4(SIDE + 3 * DFF + ch, pre); stg4(SIDE + 4 * DFF + ch, val); stg4(SIDE + 5 * DFF + ch, Gm[m]); }
                }
            }
        }
        asm volatile("s_waitcnt lgkmcnt(0)" ::: "memory"); __builtin_amdgcn_s_barrier(); asm volatile("" ::: "memory");
    }
};

__device__ __forceinline__ void phase_p3(Frame& F, int l) {
    pg8::Gemm g{(const bf16_t*)(F.ws + WS_Y), (const bf16_t*)(F.ws + WS_WOUT) + (size_t)l * D * DMIX, MALL, D, DMIX};
    Order S; S.init(l == 0 ? NTILE : NB * 16, D, F.G, F.bid, l == 0 ? 0 : 1);
    EpiRes E{F.ws, F.in_(0), F.in_(2), F.out, (LAS float*)(F.lds + LDS_RED), l, 0};
    pg8::gemm_phase<EpiRes, Order, true, true>(F.lds, g, S, E, F.tid);
}
__device__ __forceinline__ void phase_p4(Frame& F, int l) {
    pg8::Gemm g{(const bf16_t*)(F.ws + WS_VN), (const bf16_t*)(F.ws + WS_WUP) + (size_t)l * 2 * DFF * D, MALL, 2 * DFF, D};
    Order S; S.init(l == 0 ? NTILE : NB * 16, 2 * DFF, F.G, F.bid, l == 0 ? 0 : 1);
    EpiUp E{F.ws, (LAS float*)(F.lds + LDS_EX), l};
    pg8::gemm_phase<EpiUp, Order, true, true>(F.lds, g, S, E, F.tid);
}
__device__ __forceinline__ void phase_p5(Frame& F, int l) {
    Order S; S.init(l == 0 ? NTILE : NB * 16, D, F.G, F.bid, l == 0 ? 0 : 1);
    { const float* SIDE = (const float*)(F.ws + WS_SIDE); const float* ffp = (const float*)(F.ws + WS_FFNP) + (size_t)l * 4 * DFF; bf16_t* U = (bf16_t*)(F.ws + WS_U);
      Unit u;
      for (int i = 0; S.next(i, u); ++i) { const int pm = u.pm, j = pm % TPB;
          for (int ch = F.tid; ch < DFF; ch += NTHREADS) {
              if (j >= 2) { const float pre = SIDE[((size_t)pm * 6 + 0) * DFF + ch] + ffp[ch] * SIDE[((size_t)(pm - 1) * 6 + 5) * DFF + ch];
                  U[(size_t)pm * 256 * DFF + ch] = (bf16_t)f2bf(pre / (1.0f + __expf(-pre)) * SIDE[((size_t)pm * 6 + 1) * DFF + ch]); }
              if (j >= 1 && j <= 15) { const float pre = SIDE[((size_t)pm * 6 + 3) * DFF + ch] + ffp[2 * DFF + ch] * SIDE[((size_t)(pm + 1) * 6 + 2) * DFF + ch];
                  U[((size_t)pm * 256 + 255) * DFF + ch] = (bf16_t)f2bf(pre / (1.0f + __expf(-pre)) * SIDE[((size_t)pm * 6 + 4) * DFF + ch]); }
          } }
      asm volatile("s_waitcnt vmcnt(0)" ::: "memory"); __syncthreads(); }
    pg8::Gemm g{(const bf16_t*)(F.ws + WS_U), (const bf16_t*)(F.ws + WS_WDN) + (size_t)l * D * DFF, MALL, D, DFF};
    EpiRes E{F.ws, F.in_(0), F.in_(2), F.out, (LAS float*)(F.lds + LDS_RED), l, 1};
    pg8::gemm_phase<EpiRes, Order, true, true>(F.lds, g, S, E, F.tid);
}
typedef short bf16x8 __attribute__((ext_vector_type(8)));
typedef short s16x4 __attribute__((ext_vector_type(4)));
typedef float f32x16 __attribute__((ext_vector_type(16)));
__device__ __forceinline__ int crow(int r, int hi) { return (r & 3) + 8 * (r >> 2) + 4 * hi; }
typedef short v4i16_t __attribute__((ext_vector_type(4)));
__device__ __forceinline__ s16x4 vtr(const LAS unsigned char* p) { return __builtin_bit_cast(s16x4, __builtin_amdgcn_ds_read_tr16_b64_v4i16((LAS v4i16_t*)p)); }

constexpr int ATT_KV_BYTES = 8192;
__device__ __forceinline__ void att_stage(const bf16_t* Krow0, const bf16_t* Vrow0, LAS unsigned char* kbuf, LAS unsigned char* vbuf, int wave, int lane) {
    const bf16_t* ks = Krow0 + (size_t)lane * DINP + wave * 8;
    const bf16_t* vs = Vrow0 + (size_t)(16 * (wave & 3) + (lane >> 2)) * DINP + (wave >> 2) * 32 + (lane & 3) * 8;
    __builtin_amdgcn_global_load_lds((const unsigned*)ks, (LAS unsigned*)(kbuf + wave * 1024), 16, 0, 0);
    __builtin_amdgcn_global_load_lds((const unsigned*)vs, (LAS unsigned*)(vbuf + wave * 1024), 16, 0, 0);
}
template <int NK> __device__ __forceinline__ f32x16 att_qk(const LAS unsigned char* kbuf, int d0, int kh, const bf16x8* qr, f32x16 cinit, int r32, int hi) {
    f32x16 s = cinit;
#pragma unroll
    for (int i = 0; i < NK; ++i) { const bf16x8 kf = *(const LAS bf16x8*)(kbuf + (2 * (d0 + i) + hi) * 1024 + (kh * 32 + r32) * 16); s = __builtin_amdgcn_mfma_f32_32x32x16_bf16(kf, qr[i], s, 0, 0, 0); }
    return s;
}
__device__ __forceinline__ bf16x8 att_vfrag(const LAS unsigned char* vbuf, int dh, int ks, int lane, int hi) {
    const LAS unsigned char* p = vbuf + (dh * 4 + ks) * 1024 + ((lane >> 4) & 1) * 32 + (lane & 3) * 8 + (4 * hi + ((lane & 15) >> 2)) * 64;
    const s16x4 lo = vtr(p), hh = vtr(p + 512);
    return (bf16x8){lo[0], lo[1], lo[2], lo[3], hh[0], hh[1], hh[2], hh[3]};
}
__device__ __forceinline__ float half_swap_sum(float v) { return v + __shfl_xor(v, 32); }

__device__ __forceinline__ void da_unit(Frame& F, int l, int b, int h, int q0, int nkeys) {
    const int lane_ = fresh_lane();
    const int lane = lane_, wave = F.wave, r32 = lane & 31, hi = lane >> 5;
    const bf16_t* P = (const bf16_t*)(F.ws + WS_P) + (size_t)b * RB * DINP;
    const float* par = (const float*)(F.ws + WS_PAR) + l * PAR_STRIDE;
    LAS unsigned char* kb0 = F.lds; LAS unsigned char* vb0 = F.lds + 2 * ATT_KV_BYTES;
    LAS float* wsf = (LAS float*)(F.lds + 4 * ATT_KV_BYTES) + wave * 128;
    const bf16_t* Kp = P + O_AK + h * 64; const bf16_t* Vp = P + O_AV + h * 64;
    const int NT = nkeys / 64;
    att_stage(Kp, Vp, kb0, vb0, wave, lane);
    bf16x8 qr[4];
#pragma unroll
    for (int d0 = 0; d0 < 4; ++d0) qr[d0] = *(const bf16x8*)(P + (size_t)(q0 + wave * 32 + r32) * DINP + O_AQ + h * 64 + d0 * 16 + hi * 8);
    const float negM = -par[PR_MA];
    f32x16 cinit;
#pragma unroll
    for (int r = 0; r < 16; ++r) cinit[r] = negM;
    f32x16 o[2][2];
#pragma unroll
    for (int m = 0; m < 2; ++m)
#pragma unroll
        for (int dh = 0; dh < 2; ++dh)
#pragma unroll
            for (int r = 0; r < 16; ++r) o[m][dh][r] = 0.f;
    float lsum[2] = {0.f, 0.f};
    asm volatile("s_waitcnt vmcnt(0)" ::: "memory"); __syncthreads();
    for (int t = 0; t < NT; ++t) {
        const int cur = t & 1;
        if (t + 1 < NT) att_stage(Kp + (size_t)(t + 1) * 64 * DINP, Vp + (size_t)(t + 1) * 64 * DINP, kb0 + (cur ^ 1) * ATT_KV_BYTES, vb0 + (cur ^ 1) * ATT_KV_BYTES, wave, lane);
        const LAS unsigned char* kb = kb0 + cur * ATT_KV_BYTES; const LAS unsigned char* vb = vb0 + cur * ATT_KV_BYTES;
        unsigned pw[2][4][4];
#pragma unroll
        for (int m = 0; m < 2; ++m)
#pragma unroll
            for (int kh = 0; kh < 2; ++kh) {
                f32x16 s = att_qk<2>(kb, 2 * m, kh, qr + 2 * m, cinit, r32, hi);
                float acc = 0.f;
#pragma unroll
                for (int r = 0; r < 16; ++r) { s[r] = __builtin_amdgcn_exp2f(s[r]); acc += s[r]; }
                lsum[m] += acc;
#pragma unroll
                for (int i = 0; i < 4; ++i) { pw[m][2 * kh][i] = cvtpk(s[2 * i], s[2 * i + 1]); pw[m][2 * kh + 1][i] = cvtpk(s[8 + 2 * i], s[8 + 2 * i + 1]); }
                __builtin_amdgcn_sched_barrier(0);
            }
#pragma unroll
        for (int dh = 0; dh < 2; ++dh)
#pragma unroll
            for (int ks = 0; ks < 4; ++ks) {
                const bf16x8 vf = att_vfrag(vb, dh, ks, lane, hi);
#pragma unroll
                for (int m = 0; m < 2; ++m) { const u32x4 pa = (u32x4){pw[m][ks][0], pw[m][ks][1], pw[m][ks][2], pw[m][ks][3]};
                    o[m][dh] = __builtin_amdgcn_mfma_f32_32x32x16_bf16(__builtin_bit_cast(bf16x8, pa), vf, o[m][dh], 0, 0, 0); }
            }
        asm volatile("s_waitcnt vmcnt(0)" ::: "memory"); __syncthreads();
    }
    const float lam = par[PR_LAM], li = par[PR_LI];
    lsum[0] = half_swap_sum(lsum[0]); lsum[1] = half_swap_sum(lsum[1]);
    if (hi == 0) { wsf[r32] = 1.0f / lsum[0]; wsf[32 + r32] = lam / lsum[1]; }
    LDS_WAIT();
    float ss[16];
#pragma unroll
    for (int r = 0; r < 16; ++r) { const int row = crow(r, hi); const float i0 = wsf[row], i1 = wsf[32 + row];
        float sq = 0.f;
#pragma unroll
        for (int dh = 0; dh < 2; ++dh) { const float v = o[0][dh][r] * i0 - o[1][dh][r] * i1; o[0][dh][r] = v; sq += v * v; }
        ss[r] = sq; }
#pragma unroll
    for (int sh = 1; sh < 32; sh <<= 1)
#pragma unroll
        for (int r = 0; r < 16; ++r) ss[r] += __shfl_xor(ss[r], sh);
    bf16_t* Y = (bf16_t*)(F.ws + WS_Y) + ((size_t)b * RB + q0 + wave * 32) * D + h * 64;
#pragma unroll
    for (int dh = 0; dh < 2; ++dh) { const float gsc = par[PR_SUBG + 32 * dh + r32] * (1.0f - li);
#pragma unroll
        for (int r = 0; r < 16; ++r) { const float rs = 1.0f / sqrtf(ss[r] * (1.0f / 64.f) + EPS);
            Y[(size_t)crow(r, hi) * D + 32 * dh + r32] = (bf16_t)f2bf(o[0][dh][r] * rs * gsc); } }
    __syncthreads();
}

__device__ __forceinline__ void sw_unit(Frame& F, int l, int b, int kv, int q0, int g) {
    const int lane_ = fresh_lane();
    const int lane = lane_, wave = F.wave, r32 = lane & 31, hi = lane >> 5;
    const bf16_t* P = (const bf16_t*)(F.ws + WS_P) + (size_t)b * RB * DINP;
    const float* par = (const float*)(F.ws + WS_PAR) + l * PAR_STRIDE;
    LAS unsigned char* kb0 = F.lds; LAS unsigned char* vb0 = F.lds + 2 * ATT_KV_BYTES;
    LAS float* wsf = (LAS float*)(F.lds + 4 * ATT_KV_BYTES) + wave * 128;
    const bf16_t* Kp = P + O_BK + kv * 64; const bf16_t* Vp = P + O_BV + kv * 64;
    const bool lat = q0 != 0;
    const int pos0 = q0 - C;
    const int band_lo = lat ? (pos0 - 128 < 0 ? 0 : pos0 - 128) : 0, band_hi = lat ? (pos0 + 384 > T ? T : pos0 + 384) : 0;
    const int NT = 4 + (band_hi - band_lo) / 64;
    const int qpos = pos0 + wave * 32 + r32;
    att_stage(Kp, Vp, kb0, vb0, wave, lane);
    bf16x8 qr[4];
#pragma unroll
    for (int d0 = 0; d0 < 4; ++d0) qr[d0] = *(const bf16x8*)(P + (size_t)(q0 + wave * 32 + r32) * DINP + O_BQ + (kv * 3 + g) * 64 + d0 * 16 + hi * 8);
    const float negM = -par[PR_MB];
    f32x16 cinit;
#pragma unroll
    for (int r = 0; r < 16; ++r) cinit[r] = negM;
    f32x16 o[2];
    float lsum = hi == 0 ? __builtin_amdgcn_exp2f(par[PR_SINK + kv * 3 + g] * LOG2E + negM) : 0.f;
#pragma unroll
    for (int dh = 0; dh < 2; ++dh)
#pragma unroll
        for (int r = 0; r < 16; ++r) o[dh][r] = 0.f;
    asm volatile("s_waitcnt vmcnt(0)" ::: "memory"); __syncthreads();
    for (int t = 0; t < NT; ++t) {
        const int cur = t & 1;
        if (t + 1 < NT) { const int nr = (t + 1 < 4) ? (t + 1) * 64 : C + band_lo + (t + 1 - 4) * 64;
            att_stage(Kp + (size_t)nr * DINP, Vp + (size_t)nr * DINP, kb0 + (cur ^ 1) * ATT_KV_BYTES, vb0 + (cur ^ 1) * ATT_KV_BYTES, wave, lane); }
        const LAS unsigned char* kb = kb0 + cur * ATT_KV_BYTES; const LAS unsigned char* vb = vb0 + cur * ATT_KV_BYTES;
        const int kpos0 = band_lo + (t - 4) * 64;
        const int wlo = pos0 + wave * 32 - 128, whi = pos0 + wave * 32 + 31 + 128;
        const bool band = t >= 4;
        const bool active = !band || (kpos0 + 63 >= wlo && kpos0 <= whi);
        if (active) {
            const bool need_mask = band && (kpos0 < wlo + 31 || kpos0 + 63 > whi - 31);
            {
                unsigned pw[4][4];
#pragma unroll
                for (int kh = 0; kh < 2; ++kh) {
                    f32x16 s = att_qk<4>(kb, 0, kh, qr, cinit, r32, hi);
                    float acc = 0.f;
#pragma unroll
                    for (int r = 0; r < 16; ++r) { float p = __builtin_amdgcn_exp2f(s[r]);
                        if (need_mask) { const int d = qpos - (kpos0 + kh * 32 + crow(r, hi)); p = (d > 128 || d < -128) ? 0.f : p; }
                        s[r] = p; acc += p; }
                    lsum += acc;
#pragma unroll
                    for (int i = 0; i < 4; ++i) { pw[2 * kh][i] = cvtpk(s[2 * i], s[2 * i + 1]); pw[2 * kh + 1][i] = cvtpk(s[8 + 2 * i], s[8 + 2 * i + 1]); }
                }
#pragma unroll
                for (int dh = 0; dh < 2; ++dh)
#pragma unroll
                    for (int ks = 0; ks < 4; ++ks) { const bf16x8 vf = att_vfrag(vb, dh, ks, lane, hi); const u32x4 pa = (u32x4){pw[ks][0], pw[ks][1], pw[ks][2], pw[ks][3]};
                        o[dh] = __builtin_amdgcn_mfma_f32_32x32x16_bf16(__builtin_bit_cast(bf16x8, pa), vf, o[dh], 0, 0, 0); }
            }
        }
        asm volatile("s_waitcnt vmcnt(0)" ::: "memory"); __syncthreads();
    }
    { const float lt = half_swap_sum(lsum); if (hi == 0) wsf[r32] = 1.0f / lt; }
    LDS_WAIT();
    bf16_t* Y = (bf16_t*)(F.ws + WS_Y) + ((size_t)b * RB + q0 + wave * 32) * D + 256 + kv * 192;
#pragma unroll
    for (int r = 0; r < 16; ++r) { const int row = crow(r, hi); const float il = wsf[row];
#pragma unroll
        for (int dh = 0; dh < 2; ++dh) Y[(size_t)row * D + g * 64 + 32 * dh + r32] = (bf16_t)f2bf(o[dh][r] * il); }
    __syncthreads();
}

constexpr int LRU_XS = 0, LRU_XCB = 67584, LRU_WT = LRU_XCB + 256 * 144, LRU_EXC = LRU_WT + 128 * 144, LRU_HIN = LRU_EXC + 4096;
static_assert(LRU_HIN + 512 <= 131072, "LRU LDS map");
__device__ __forceinline__ float fast_sigmoid(float z) { return __builtin_amdgcn_rcpf(1.0f + __builtin_amdgcn_exp2f(-LOG2E * z)); }
__device__ __forceinline__ void lru_item(Frame& F, int l, int pm, int hb, int stage) {
    const int lane_ = fresh_lane();
    const int lane = lane_, wave = F.wave, tid = wave * 64 + lane, r32 = lane & 31, hi = lane >> 5;
    const int b = pm / TPB, j = pm % TPB; const int L = j == 0 ? C : T, t0 = j == 0 ? 0 : (j - 1) * 256;
    const bf16_t* P = (const bf16_t*)(F.ws + WS_P) + (size_t)pm * 256 * DINP;
    LAS float* XS = (LAS float*)(F.lds + LRU_XS); LAS unsigned char* XCb = F.lds + LRU_XCB; LAS unsigned char* WT = F.lds + LRU_WT;
    LAS float* EXC = (LAS float*)(F.lds + LRU_EXC); LAS float* HIN = (LAS float*)(F.lds + LRU_HIN);
    float* SUM = (float*)(F.ws + WS_LRU);
    for (int e = tid; e < 262 * 8; e += NTHREADS) { const int row = e >> 3, cc = e & 7; const int rl = row - 3, tt = t0 + rl;
        f32x4 lo = (f32x4){0.f, 0.f, 0.f, 0.f}, hh = lo;
        if (tt >= 0 && tt < L) { const u32x4 v = *(const u32x4*)(P + (ptrdiff_t)rl * DINP + O_CX + 64 * hb + 8 * cc);
            lo = (f32x4){__builtin_bit_cast(float, v.x << 16), __builtin_bit_cast(float, v.x & 0xffff0000u), __builtin_bit_cast(float, v.y << 16), __builtin_bit_cast(float, v.y & 0xffff0000u)};
            hh = (f32x4){__builtin_bit_cast(float, v.z << 16), __builtin_bit_cast(float, v.z & 0xffff0000u), __builtin_bit_cast(float, v.w << 16), __builtin_bit_cast(float, v.w & 0xffff0000u)}; }
        *(LAS f32x4*)(XS + row * 64 + 8 * cc) = lo; *(LAS f32x4*)(XS + row * 64 + 8 * cc + 4) = hh; }
    if (stage == 1 && tid < 128) { const int d = tid >> 6, ch = tid & 63; const int pm0 = b * TPB; float h = 0.f;
        typedef float f2 __attribute__((ext_vector_type(2)));
        const f2* S2 = (const f2*)SUM;
        if (d == 0) { f2 sv[16];
#pragma unroll
            for (int jj = 0; jj < 16; ++jj) sv[jj] = jj < j ? S2[((size_t)(pm0 + jj) * 2 + 0) * LW + 64 * hb + ch] : (f2){1.f, 0.f};
#pragma unroll
            for (int jj = 0; jj < 16; ++jj) h = sv[jj][0] * h + sv[jj][1]; }
        else if (j != 0) { f2 sv[16]; const f2 s0 = S2[((size_t)pm0 * 2 + 1) * LW + 64 * hb + ch];
#pragma unroll
            for (int k = 0; k < 15; ++k) { const int jj = 16 - k; sv[k] = jj > j ? S2[((size_t)(pm0 + jj) * 2 + 1) * LW + 64 * hb + ch] : (f2){1.f, 0.f}; }
            h = s0[1];
#pragma unroll
            for (int k = 0; k < 15; ++k) h = sv[k][0] * h + sv[k][1]; }
        HIN[tid] = h; }
    f32x16 Hf[2];
#pragma unroll
    for (int d = 0; d < 2; ++d) {
        __syncthreads();
        const float* cw = F.in_(19) + ((size_t)(l * 2 + d) * 4) * LW + 64 * hb;
        const float* lp = (const float*)(F.ws + WS_LRUP) + (size_t)(l * 2 + d) * 4 * LW + 64 * hb;
        { const u32x4* src = (const u32x4*)((const bf16_t*)(F.ws + WS_LRUW) + (size_t)((l * 2 + d) * 6 + hb) * 8192);
#pragma unroll
          for (int i = 0; i < 2; ++i) { const int e = tid + i * NTHREADS; *(LAS u32x4*)(WT + (e >> 3) * 144 + (e & 7) * 16) = src[e]; } }
        { const int c2 = (tid & 31) * 2; typedef float f2 __attribute__((ext_vector_type(2)));
          const f2 w0 = *(const f2*)(cw + 0 * LW + c2), w1 = *(const f2*)(cw + 1 * LW + c2), w2 = *(const f2*)(cw + 2 * LW + c2), w3 = *(const f2*)(cw + 3 * LW + c2), bb = *(const f2*)(lp + 3 * LW + c2);
#pragma unroll 4
          for (int i = 0; i < 16; ++i) { const int rl = (tid >> 5) + 16 * i; const LAS float* x = XS + (rl + 3) * 64 + c2;
              const f2 x0 = *(const LAS f2*)(x), xa = *(const LAS f2*)(x + (d == 0 ? -3 : 3) * 64), xb = *(const LAS f2*)(x + (d == 0 ? -2 : 2) * 64), xc_ = *(const LAS f2*)(x + (d == 0 ? -1 : 1) * 64);
              const f2 v = bb + w0 * xa + w1 * xb + w2 * xc_ + w3 * x0;
              *(LAS unsigned*)(XCb + rl * 144 + c2 * 2) = cvtpk(v[0], v[1]); } }
        __syncthreads();
        f32x16 acc[4];
#pragma unroll
        for (int nt = 0; nt < 4; ++nt)
#pragma unroll
            for (int r = 0; r < 16; ++r) acc[nt][r] = 0.f;
#pragma unroll
        for (int ks = 0; ks < 4; ++ks) { const bf16x8 af = *(const LAS bf16x8*)(XCb + (wave * 32 + r32) * 144 + (16 * ks + 8 * hi) * 2);
#pragma unroll
            for (int nt = 0; nt < 4; ++nt) { const bf16x8 bf = *(const LAS bf16x8*)(WT + (32 * nt + r32) * 144 + (16 * ks + 8 * hi) * 2);
                acc[nt] = __builtin_amdgcn_mfma_f32_32x32x16_bf16(af, bf, acc[nt], 0, 0, 0); } }
#pragma unroll
        for (int chh = 0; chh < 2; ++chh) { const int ch = 32 * chh + r32;
            const float ba = lp[ch], bx = lp[LW + ch], sp8 = lp[2 * LW + ch];
#pragma unroll
            for (int r = 0; r < 16; ++r) { const int rl = wave * 32 + crow(r, hi);
                const float xc = bf2f(*(const LAS unsigned short*)(XCb + rl * 144 + ch * 2));
                const float rg = fast_sigmoid(acc[chh][r] + ba), ig = fast_sigmoid(acc[2 + chh][r] + bx);
                const float av = __builtin_amdgcn_exp2f(-(rg * sp8));
                acc[chh][r] = av; acc[2 + chh][r] = __builtin_amdgcn_sqrtf(fmaxf(1.0f - av * av, 0.f)) * (ig * xc); } }
        float gA[2][8], gB[2][8];
#pragma unroll
        for (int chh = 0; chh < 2; ++chh) {
#pragma unroll
            for (int q = 0; q < 4; ++q) { float A_ = 1.f, B_ = 0.f;
#pragma unroll
                for (int e = 0; e < 4; ++e) { const int r = 4 * q + (d == 0 ? e : 3 - e); B_ = acc[chh][r] * B_ + acc[2 + chh][r]; A_ *= acc[chh][r]; }
                const float pA_ = __shfl_xor(A_, 32), pB_ = __shfl_xor(B_, 32);
                gA[chh][2 * q] = hi ? pA_ : A_; gA[chh][2 * q + 1] = hi ? A_ : pA_; gB[chh][2 * q] = hi ? pB_ : B_; gB[chh][2 * q + 1] = hi ? B_ : pB_; }
            float blkA = 1.f, blkH = 0.f;
#pragma unroll
            for (int k = 0; k < 8; ++k) { const int s = d == 0 ? k : 7 - k; blkH = gA[chh][s] * blkH + gB[chh][s]; blkA *= gA[chh][s]; }
            if (hi == 0) { typedef float f2 __attribute__((ext_vector_type(2))); *(LAS f2*)(EXC + (wave * 64 + 32 * chh + r32) * 2) = (f2){blkA, blkH}; }
        }
        LDS_WAIT(); __syncthreads();
#pragma unroll
        for (int chh = 0; chh < 2; ++chh) { const int ch = 32 * chh + r32;
            float h = stage == 1 ? HIN[d * 64 + ch] : 0.f;
            float totA = 1.f, totH = 0.f;
#pragma unroll
            for (int k = 0; k < 8; ++k) { const int w = d == 0 ? k : 7 - k; typedef float f2 __attribute__((ext_vector_type(2))); const f2 e2 = *(const LAS f2*)(EXC + (w * 64 + ch) * 2);
                const bool before = d == 0 ? (w < wave) : (w > wave);
                if (before) h = e2[0] * h + e2[1];
                totH = e2[0] * totH + e2[1]; totA *= e2[0]; }
            if (stage == 0) { if (wave == 0 && hi == 0) { float* s = SUM + (((size_t)pm * 2 + d) * LW + 64 * hb + ch) * 2; s[0] = totA; s[1] = totH; } }
            else {
                float hq[4] = {0.f, 0.f, 0.f, 0.f};
#pragma unroll
                for (int k = 0; k < 8; ++k) { const int s = d == 0 ? k : 7 - k; const int q = s >> 1;
                    hq[q] = ((s & 1) == hi) ? h : hq[q];
                    h = gA[chh][s] * h + gB[chh][s]; }
#pragma unroll
                for (int q = 0; q < 4; ++q) { float hh = hq[q];
#pragma unroll
                    for (int e = 0; e < 4; ++e) { const int r = 4 * q + (d == 0 ? e : 3 - e); hh = acc[chh][r] * hh + acc[2 + chh][r]; acc[2 + chh][r] = hh; } }
                if (d == 0) Hf[chh] = acc[2 + chh];
                else {
                    bf16_t* Y = (bf16_t*)(F.ws + WS_Y) + (size_t)pm * 256 * D + 640 + 64 * hb + ch;
#pragma unroll
                    for (int r = 0; r < 16; ++r) { const int rl = wave * 32 + crow(r, hi);
                        const float g = bf2f(P[(size_t)rl * DINP + O_CG + 64 * hb + ch]);
                        const float u2 = (2.0f * 0.7978845608028654f * LOG2E) * (g + 0.044715f * g * g * g);
                        const float ge = g * __builtin_amdgcn_rcpf(1.0f + __builtin_amdgcn_exp2f(-u2));
                        Y[(size_t)rl * D] = (bf16_t)f2bf((Hf[chh][r] + acc[2 + chh][r]) * ge); }
                }
            }
        }
    }
    __syncthreads();
}

__device__ __forceinline__ void unit_map16(const Frame& F, int u, int& gi, int& sub) {
    if (F.G == 256) { const int bid = u & 255, rnd = u >> 8, x = bid & 7, k = bid >> 3; gi = rnd * 16 + 2 * x + (k >> 4); sub = k & 15; }
    else { gi = u >> 4; sub = u & 15; }
}
__device__ __forceinline__ void phase_p2a(Frame& F, int l) {
    if (!(F.flags & 1)) for (int it = F.bid; it < NTILE * 6; it += F.G) lru_item(F, l, it / 6, it % 6, 0);
    if (F.flags & 2) return;
    for (int u = F.bid; u < NB * 2 * 16; u += F.G) { int gi, pb; unit_map16(F, u, gi, pb); for (int g = 0; g < 3; ++g) sw_unit(F, l, gi >> 1, gi & 1, C + pb * 256, g); }
    if (l == 0) for (int u = F.bid; u < NB * 2; u += F.G) for (int g = 0; g < 3; ++g) sw_unit(F, l, u >> 1, u & 1, 0, g);
}
__device__ __forceinline__ void phase_p2b(Frame& F, int l) {
    if (!(F.flags & 1)) for (int it = F.bid; it < NTILE * 6; it += F.G) { const int pm = it / 6; if (l == 1 && pm % TPB == 0) continue; lru_item(F, l, pm, it % 6, 1); }
    if (F.flags & 2) return;
    for (int u = F.bid; u < NB * 4 * 16; u += F.G) { int gi, qb; unit_map16(F, u, gi, qb); da_unit(F, l, gi >> 2, gi & 3, C + qb * 256, RB); }
    if (l == 0) for (int u = F.bid; u < NB * 4; u += F.G) da_unit(F, l, u >> 2, u & 3, 0, C);
}
#define XB_TMO      128
#define XB_XCNT(j)  (256  + 64 * (j))
#define XB_XSUB(j)  (1280 + 64 * (j))
#define XB_XGEN(j)  (2304 + 64 * (j))
#define XB_TOP      3328
#define XB_TOPGEN   3392
#define XCD_BAR_WORDS 3456
#define XB_SPIN_CAP (1u << 18)

__device__ __forceinline__ unsigned xb_ld(unsigned* p)              { return __hip_atomic_load(p, __ATOMIC_RELAXED, __HIP_MEMORY_SCOPE_AGENT); }
__device__ __forceinline__ unsigned xb_add(unsigned* p, unsigned v) { return __hip_atomic_fetch_add(p, v, __ATOMIC_RELAXED, __HIP_MEMORY_SCOPE_AGENT); }
__device__ __forceinline__ unsigned xb_xcc_id() { return (unsigned)__builtin_amdgcn_s_getreg((3 << 11) | 20) & 0xFu; }
#define XB_SPIN(cond, bar) do { unsigned _sp = 0; while (cond) { __builtin_amdgcn_s_sleep(1); \
    if ((++_sp & 255u) == 0u) { if (xb_ld(&(bar)[XB_TMO])) break; if (_sp > XB_SPIN_CAP) { atomicAdd(&(bar)[XB_TMO], 1u); break; } } } } while (0)

struct XcdBarrier {
    unsigned* bar; unsigned x;
    volatile LAS unsigned* st;
};

__device__ __forceinline__ XcdBarrier xcd_barrier_post(unsigned* bar, volatile LAS unsigned* st, int tid) {
    XcdBarrier b; b.bar = bar; b.x = xb_xcc_id(); b.st = st;
    if (tid == 0) (void)xb_add(&bar[XB_XCNT(b.x)], 1u);
    return b;
}
__device__ __forceinline__ void xcd_barrier_complete(unsigned* bar, unsigned x, unsigned& nloc, unsigned& nx) {
    const unsigned G = gridDim.x * gridDim.y * gridDim.z;
    unsigned sum, cnt, mine, sp = 0u;
    for (;;) {
        sum = 0u; cnt = 0u; mine = 0u;
#pragma unroll
        for (unsigned j = 0; j < 16; ++j) { const unsigned c = xb_ld(&bar[XB_XCNT(j)]); sum += c; cnt += (c > 0u) ? 1u : 0u; mine = (j == x) ? c : mine; }
        if (sum == G) break;
        __builtin_amdgcn_s_sleep(1);
        if ((++sp & 255u) == 0u) { if (xb_ld(&bar[XB_TMO])) break; if (sp > XB_SPIN_CAP) { atomicAdd(&bar[XB_TMO], 1u); break; } }
    }
    nloc = mine > 0u ? mine : 1u; nx = cnt > 0u ? cnt : 1u;
}

__device__ __forceinline__ void xcd_barrier(const XcdBarrier& b, int tid) {
    asm volatile("s_waitcnt vmcnt(0)" ::: "memory");
    __syncthreads();
    if (tid == 0) {
        unsigned* bar = b.bar;
        __builtin_amdgcn_s_waitcnt(0);
        unsigned nloc = b.st[0], nx = b.st[1];
        if (nloc == 0u) { xcd_barrier_complete(bar, b.x, nloc, nx); b.st[0] = nloc; b.st[1] = nx; }
        const unsigned old = xb_add(&bar[XB_XSUB(b.x)], 1u);
        const unsigned gen = old / nloc;
        if (old + 1u == (gen + 1u) * nloc) {
            __builtin_amdgcn_fence(__ATOMIC_RELEASE, "agent");
            asm volatile("s_waitcnt vmcnt(0)" ::: "memory");
            const unsigned og = xb_add(&bar[XB_TOP], 1u);
            const unsigned tg = og / nx;
            if (og + 1u == (tg + 1u) * nx) xb_add(&bar[XB_TOPGEN], 1u);
            else XB_SPIN(xb_ld(&bar[XB_TOPGEN]) == tg, bar);
            __builtin_amdgcn_fence(__ATOMIC_ACQUIRE, "agent");
            xb_add(&bar[XB_XGEN(b.x)], 1u);
            asm volatile("s_waitcnt vmcnt(0)" ::: "memory");
        } else {
            XB_SPIN(xb_ld(&bar[XB_XGEN(b.x)]) == gen, bar);
            __builtin_amdgcn_fence(__ATOMIC_ACQUIRE, "agent");
            asm volatile("s_waitcnt vmcnt(0)" ::: "memory");
        }
    }
    __syncthreads();
}

constexpr int CW_BAR = 4096;
constexpr int LDS_MISC = LDS_EX + 8192;
#ifndef PROBE_DOUBLE
#define PROBE_DOUBLE (-1)
#endif
struct Args { const float* in[31]; float* out; unsigned char* ws; int ph_lo, ph_hi, flags, pad; };
constexpr int N_PHASES = 14;
__global__ void __launch_bounds__(NTHREADS, 2) mk_fwd(Args args) {
    extern __shared__ __attribute__((aligned(16))) unsigned char lds_raw[];
    cg::grid_group grid = cg::this_grid();
    Frame F;
    F.lds = (LAS unsigned char*)lds_raw;
    F.G = gridDim.x;
    F.inp = args.in; F.out = args.out; F.flags = args.flags;
    const int lo = args.ph_lo, hi = args.ph_hi;
    volatile LAS unsigned* bst = (volatile LAS unsigned*)(F.lds + LDS_MISC);
    if (threadIdx.x < 2) bst[threadIdx.x] = 0u;
    __syncthreads();
    XcdBarrier xbar = xcd_barrier_post((unsigned*)args.ws + CW_BAR, bst, (int)threadIdx.x);
    const int wave0 = __builtin_amdgcn_readfirstlane((int)threadIdx.x >> 6);
#define MK_PHASE(k, CALL) do { if (lo <= (k) && (k) < hi) { \
        { const int ln_ = fresh_lane(); int wv_ = wave0; asm volatile("" : "+s"(wv_)); F.lane = ln_; F.wave = wv_; F.tid = wv_ * 64 + ln_; } \
        { int bx = blockIdx.x; asm volatile("" : "+s"(bx)); F.bid = bx; F.vcu = (F.G % 8 == 0) ? (bx % 8) * (F.G / 8) + bx / 8 : bx; } \
        { unsigned char* w_ = args.ws; asm volatile("" : "+s"(w_)); F.ws = w_; int z_ = 0; asm volatile("" : "+s"(z_)); F.zero = z_; } \
        CALL; if ((k) + 1 < hi) { if ((k) == 0) grid.sync(); else xcd_barrier(xbar, wave0 * 64 + fresh_lane()); } } } while (0)
    MK_PHASE(0, phase_p0a(F));
    MK_PHASE(1, phase_p0b(F));
    MK_PHASE(2, phase_p1(F, 0));
    MK_PHASE(3, phase_p2a(F, 0));
    MK_PHASE(4, phase_p2b(F, 0));
    MK_PHASE(5, phase_p3(F, 0));
    MK_PHASE(6, phase_p4(F, 0));
    MK_PHASE(7, phase_p5(F, 0));
    MK_PHASE(8, phase_p1(F, 1));
    MK_PHASE(9, phase_p2a(F, 1));
    MK_PHASE(10, phase_p2b(F, 1));
    MK_PHASE(11, phase_p3(F, 1));
    MK_PHASE(12, phase_p4(F, 1));
    MK_PHASE(13, phase_p5(F, 1));
#undef MK_PHASE
}
}

static int mk_setup() {
    static int grid = 0;
    if (grid == 0) {
        int dev = 0, cus = 0, per_cu = 0;
        hipGetDevice(&dev); hipDeviceGetAttribute(&cus, hipDeviceAttributeMultiprocessorCount, dev);
        hipFuncSetAttribute((const void*)mk::mk_fwd, hipFuncAttributeMaxDynamicSharedMemorySize, mk::LDS_BYTES);
        hipOccupancyMaxActiveBlocksPerMultiprocessor(&per_cu, (const void*)mk::mk_fwd, mk::NTHREADS, mk::LDS_BYTES);
        (void)hipGetLastError();
        if (per_cu < 1) { fprintf(stderr, "mk_setup: occupancy query says %d blocks/CU\n", per_cu); per_cu = 1; }
        grid = cus;
        fprintf(stderr, "mk_setup: cus %d per_cu %d grid %d\n", cus, per_cu, grid);
    }
    return grid;
}
static void mk_run(void* const* d_in, void* d_out, void* d_ws, hipStream_t stream, int lo, int hi, bool coop, int flags = 0) {
    const int grid = mk_setup();
    mk::Args a{};
    for (int i = 0; i < 31; ++i) a.in[i] = (const float*)d_in[i];
    a.out = (float*)d_out; a.ws = (unsigned char*)d_ws; a.ph_lo = lo; a.ph_hi = hi; a.flags = flags;
    if (coop) { void* params[] = {&a}; hipError_t e = hipLaunchCooperativeKernel((const void*)mk::mk_fwd, dim3(grid), dim3(mk::NTHREADS), params, mk::LDS_BYTES, stream);
        if (e != hipSuccess) fprintf(stderr, "coop launch failed: %s\n", hipGetErrorString(e)); }
    else hipLaunchKernelGGL(mk::mk_fwd, dim3(grid), dim3(mk::NTHREADS), mk::LDS_BYTES, stream, a);
}

extern "C" void kernel_launch(void* const* d_in, const int* in_sizes, int n_in, void* d_out, int out_size, void* d_ws, size_t ws_size, hipStream_t stream) {
    if (ws_size < mk::WS_END) { fprintf(stderr, "ws too small\n"); return; }
    hipMemsetAsync(d_ws, 0, mk::MiB, stream);
    mk_run(d_in, d_out, d_ws, stream, 0, mk::N_PHASES, true);
}
```

```cpp
#include <hip/hip_runtime.h>
#include <hip/hip_cooperative_groups.h>
#include <math.h>
#include <stdint.h>
#include <cstdio>
namespace cg = cooperative_groups;
namespace pg8 {
#define PG8_LAS __attribute__((address_space(3)))
typedef unsigned short bf16_t;
typedef short bf16x8 __attribute__((ext_vector_type(8)));
typedef float f32x4 __attribute__((ext_vector_type(4)));
typedef unsigned u32x4 __attribute__((ext_vector_type(4)));
constexpr int BM = 256, BK = 64, HALF = 128, HTB = HALF * BK * 2  , STAGE_BYTES = 8 * HTB, NXCD = 8, WGM = 8;

__host__ __device__ __forceinline__ int lds_byte(int r, int c) { const int st = (r >> 4) * 2 + (c >> 5), rr = r & 15, cc = c & 31, ob = rr * 64 + cc * 2; return st * 1024 + (ob ^ (((ob >> 9) & 1) << 5)); }
__host__ __device__ __forceinline__ void stage_rc(int b, int& R, int& C) { const int st = b / 1024, sb = b % 1024, swz = sb ^ (((sb >> 9) & 1) << 5); R = (st >> 1) * 16 + swz / 64; C = (st & 1) * 32 + (swz % 64) / 2; }
__host__ __device__ __forceinline__ int perm32(int rho) { const int n = rho >> 4, i = rho & 15; return 8 * (i >> 2) + 4 * n + (i & 3); }

struct Unit { int pm, pn; };
struct Gemm { const bf16_t* A; const bf16_t* Bt; int M, N, K; };

struct StaticOrder {
    int nM, nN, nwg, G, c;
    __host__ __device__ void init(int M, int N, int G_, int c_) { nM = M / BM; nN = N / BM; nwg = nM * nN; G = G_; c = c_; }
    __host__ __device__ bool next(int i, Unit& u) const {
        const long L = (long)i * G + c; if (L >= nwg) return false;
        int wgid = (int)L; { const int q = nwg / NXCD, r = nwg % NXCD, xcd = wgid % NXCD, off = wgid / NXCD; wgid = (xcd < r ? xcd * (q + 1) : r * (q + 1) + (xcd - r) * q) + off; }
        const int nig = WGM * nN, gid = wgid / nig, fm = gid * WGM, gsz = (nM - fm) < WGM ? (nM - fm) : WGM;
        u.pm = fm + ((wgid % nig) % gsz); u.pn = (wgid % nig) / gsz; return true;
    }
    __device__ __forceinline__ void a_ready(const Unit&) const {}
    __device__ __forceinline__ void done(const Unit&) const {}
};


template <class Epi, class Sched, bool ALIGN_EPI = false, bool SP2 = false>
__device__ __forceinline__ void gemm_phase(PG8_LAS unsigned char* lds, const Gemm g, const Sched& S, const Epi& E, const int tid) {
    const int wid = __builtin_amdgcn_readfirstlane(tid >> 6), lane = tid & 63, wr = wid >> 2, wc = wid & 3, fr = lane & 15, fq = lane >> 4;
    const int K = g.K, nt = K / BK;
    unsigned voffA[2], voffB[2];
#pragma unroll
    for (int i = 0; i < 2; ++i) { int R, C; stage_rc(tid * 16 + i * 8192, R, C); const int Rb = Epi::PERM ? ((R & ~31) + perm32(R & 31)) : R;
        voffA[i] = (unsigned)(R * K + C) * 2u; voffB[i] = (unsigned)(Rb * K + C) * 2u; }
    const size_t kstep = (size_t)(BK * 2);
    const size_t hstep = (size_t)HALF * K * 2;
    const size_t tstep = 2 * hstep;
    const unsigned ldsw = (unsigned)wid * 1024u;
    const int aoff = lds_byte(wr * 64 + fr, fq * 8), boff = lds_byte(wc * 32 + fr, fq * 8);
#define PG8_SA(b, h) (((b) * 2 + (h)) * HTB)
#define PG8_SB(b, h) ((4 + (b) * 2 + (h)) * HTB)
#define PG8_STAGE(bufoff, gbase, voff) do { _Pragma("unroll") for (int _i = 0; _i < 2; ++_i) \
        __builtin_amdgcn_global_load_lds((const unsigned*)((const char*)(gbase) + (voff)[_i]), (PG8_LAS unsigned*)(lds + (bufoff) + ldsw + _i * 8192), 16, 0, 0); } while (0)
#define PG8_LDA(dst, b, h) do { _Pragma("unroll") for (int m = 0; m < 4; ++m) _Pragma("unroll") for (int k = 0; k < 2; ++k) dst[m][k] = *(const PG8_LAS bf16x8*)(lds + PG8_SA(b, h) + aoff + m * 2048 + k * 1024); } while (0)
#define PG8_LDB(dst, b, h) do { _Pragma("unroll") for (int n = 0; n < 2; ++n) _Pragma("unroll") for (int k = 0; k < 2; ++k) dst[n][k] = *(const PG8_LAS bf16x8*)(lds + PG8_SB(b, h) + boff + n * 2048 + k * 1024); } while (0)
#define PG8_MMA(ai, bj, At, Bt) do { __builtin_amdgcn_s_setprio(1); _Pragma("unroll") for (int m = 0; m < 4; ++m) _Pragma("unroll") for (int n = 0; n < 2; ++n) _Pragma("unroll") for (int k = 0; k < 2; ++k) \
        acc[ai][bj][m][n] = __builtin_amdgcn_mfma_f32_16x16x32_bf16(Bt[n][k], At[m][k], acc[ai][bj][m][n], 0, 0, 0); __builtin_amdgcn_s_setprio(0); } while (0)
#define PG8_WAIT_V(n) asm volatile("s_waitcnt vmcnt(" #n ")" ::: "memory")
#define PG8_WAIT_L(n) asm volatile("s_waitcnt lgkmcnt(" #n ")" ::: "memory")
#define PG8_BAR __builtin_amdgcn_s_barrier()
#define PG8_SCHED __builtin_amdgcn_sched_barrier(0)
    Unit cur, nxt; int ui = 0;
    if (!S.next(0, cur)) return;
    f32x4 acc[2][2][4][2];
#pragma unroll
    for (int a = 0; a < 2; ++a)
#pragma unroll
        for (int b = 0; b < 2; ++b)
#pragma unroll
            for (int m = 0; m < 4; ++m)
#pragma unroll
                for (int n = 0; n < 2; ++n) acc[a][b][m][n] = (f32x4){0.f, 0.f, 0.f, 0.f};
    bf16x8 At[4][2], B0[2][2], B1[2][2];
    const char* cA = (const char*)g.A + (size_t)cur.pm * tstep; const char* cB = (const char*)g.Bt + (size_t)cur.pn * tstep;
    S.a_ready(cur);
    if constexpr (SP2) {
        PG8_STAGE(PG8_SB(0, 0), cB, voffB); PG8_STAGE(PG8_SB(0, 1), cB + hstep, voffB); PG8_STAGE(PG8_SA(0, 0), cA, voffA); PG8_STAGE(PG8_SA(0, 1), cA + hstep, voffA);
        if (wr == 1) PG8_BAR;
        PG8_WAIT_V(2); PG8_BAR;
        PG8_STAGE(PG8_SB(1, 0), cB + kstep, voffB); PG8_STAGE(PG8_SA(1, 0), cA + kstep, voffA); PG8_STAGE(PG8_SB(1, 1), cB + hstep + kstep, voffB);
        PG8_WAIT_V(6); PG8_BAR;
    } else {
        PG8_STAGE(PG8_SB(0, 0), cB, voffB); PG8_STAGE(PG8_SA(0, 0), cA, voffA); PG8_STAGE(PG8_SB(0, 1), cB + hstep, voffB); PG8_STAGE(PG8_SA(0, 1), cA + hstep, voffA);
        if (wr == 1) PG8_BAR;
        PG8_WAIT_V(4); PG8_BAR;
        PG8_STAGE(PG8_SB(1, 0), cB + kstep, voffB); PG8_STAGE(PG8_SA(1, 0), cA + kstep, voffA); PG8_STAGE(PG8_SB(1, 1), cB + hstep + kstep, voffB);
        PG8_WAIT_V(6); PG8_BAR;
    }
    for (;;) {
        const bool has_next = S.next(ui + 1, nxt);
        const char* nA = has_next ? (const char*)g.A + (size_t)nxt.pm * tstep : cA; const char* nB = has_next ? (const char*)g.Bt + (size_t)nxt.pn * tstep : cB;
        for (int t = 0; t < nt; t += 2) {
            const bool last = (t == nt - 2);
            const char* a1 = cA + (size_t)(t + 1) * kstep;
            const char* a2 = last ? nA : cA + (size_t)(t + 2) * kstep; const char* b2 = last ? nB : cB + (size_t)(t + 2) * kstep;
            const char* a3 = a2 + kstep; const char* b3 = b2 + kstep;
            if (last && has_next) S.a_ready(nxt);
            if constexpr (SP2) {
            PG8_LDB(B0, 0, 0); PG8_LDB(B1, 0, 1); PG8_SCHED; PG8_LDA(At, 0, 0); PG8_STAGE(PG8_SA(1, 1), a1 + hstep, voffA);
            PG8_WAIT_V(8); PG8_WAIT_L(0); PG8_BAR; PG8_MMA(0, 0, At, B0); PG8_MMA(0, 1, At, B1); PG8_BAR; PG8_SCHED;
            PG8_LDA(At, 0, 1); PG8_STAGE(PG8_SB(0, 0), b2, voffB); PG8_STAGE(PG8_SB(0, 1), b2 + hstep, voffB); PG8_STAGE(PG8_SA(0, 0), a2, voffA);
            PG8_WAIT_V(8); PG8_WAIT_L(0); PG8_BAR; PG8_MMA(1, 0, At, B0); PG8_MMA(1, 1, At, B1); PG8_BAR; PG8_SCHED;
            PG8_LDB(B0, 1, 0); PG8_LDB(B1, 1, 1); PG8_SCHED; PG8_LDA(At, 1, 0); PG8_STAGE(PG8_SA(0, 1), a2 + hstep, voffA);
            PG8_WAIT_V(8); PG8_WAIT_L(0); PG8_BAR; PG8_MMA(0, 0, At, B0); PG8_MMA(0, 1, At, B1); PG8_BAR; PG8_SCHED;
            PG8_LDA(At, 1, 1); PG8_STAGE(PG8_SB(1, 0), b3, voffB); PG8_STAGE(PG8_SB(1, 1), b3 + hstep, voffB); PG8_STAGE(PG8_SA(1, 0), a3, voffA);
            PG8_WAIT_V(8); PG8_WAIT_L(0); PG8_BAR; PG8_MMA(1, 0, At, B0); PG8_MMA(1, 1, At, B1); PG8_BAR; PG8_SCHED;
            } else {
            PG8_LDB(B0, 0, 0); PG8_SCHED; PG8_LDA(At, 0, 0); PG8_STAGE(PG8_SA(1, 1), a1 + hstep, voffA);
            PG8_WAIT_L(8); PG8_BAR; PG8_WAIT_L(0); PG8_MMA(0, 0, At, B0); PG8_BAR; PG8_SCHED;
            PG8_LDB(B1, 0, 1); PG8_STAGE(PG8_SB(0, 0), b2, voffB);
            PG8_BAR; PG8_WAIT_L(0); PG8_MMA(0, 1, At, B1); PG8_BAR;
            PG8_LDA(At, 0, 1); PG8_STAGE(PG8_SA(0, 0), a2, voffA);
            PG8_BAR; PG8_WAIT_L(0); PG8_MMA(1, 0, At, B0); PG8_BAR; PG8_SCHED;
            PG8_STAGE(PG8_SB(0, 1), b2 + hstep, voffB);
            PG8_WAIT_V(6); PG8_BAR; PG8_MMA(1, 1, At, B1); PG8_BAR;
            PG8_LDB(B0, 1, 0); PG8_SCHED; PG8_LDA(At, 1, 0); PG8_STAGE(PG8_SA(0, 1), a2 + hstep, voffA);
            PG8_WAIT_L(8); PG8_BAR; PG8_WAIT_L(0); PG8_MMA(0, 0, At, B0); PG8_BAR; PG8_SCHED;
            PG8_LDB(B1, 1, 1); PG8_STAGE(PG8_SB(1, 0), b3, voffB);
            PG8_BAR; PG8_WAIT_L(0); PG8_MMA(0, 1, At, B1); PG8_BAR;
            PG8_LDA(At, 1, 1); PG8_STAGE(PG8_SA(1, 0), a3, voffA);
            PG8_BAR; PG8_WAIT_L(0); PG8_MMA(1, 0, At, B0); PG8_BAR; PG8_SCHED;
            PG8_STAGE(PG8_SB(1, 1), b3 + hstep, voffB);
            PG8_WAIT_V(6); PG8_BAR; PG8_MMA(1, 1, At, B1); PG8_BAR;
            }
        }
        if constexpr (ALIGN_EPI) { if (wr == 0) PG8_BAR; }
        if constexpr (!Epi::AFTER_DRAIN) { E(acc, cur, wr, wc, fr, fq); S.done(cur); }
        if (!has_next) break;
#pragma unroll
        for (int a = 0; a < 2; ++a)
#pragma unroll
            for (int b = 0; b < 2; ++b)
#pragma unroll
                for (int m = 0; m < 4; ++m)
#pragma unroll
                    for (int n = 0; n < 2; ++n) acc[a][b][m][n] = (f32x4){0.f, 0.f, 0.f, 0.f};
        cur = nxt; cA = nA; cB = nB; ++ui;
        if constexpr (ALIGN_EPI) { if (wr == 1) PG8_BAR; }
    }
    PG8_WAIT_V(0);
    if constexpr (!ALIGN_EPI) { if (wr == 0) PG8_BAR; }
    PG8_BAR;
    if constexpr (Epi::AFTER_DRAIN) { E.fused(acc, cur, wr, wc, fr, fq, lds, wid, lane); S.done(cur); }
#undef PG8_SA
#undef PG8_SB
#undef PG8_STAGE
#undef PG8_LDA
#undef PG8_LDB
#undef PG8_MMA
#undef PG8_WAIT_V
#undef PG8_WAIT_L
#undef PG8_BAR
#undef PG8_SCHED
}
}

#ifndef PG8_SP2
#define PG8_SP2 true
#endif

namespace mk {
using pg8::bf16_t; using pg8::f32x4; using pg8::Unit;
#define LAS __attribute__((address_space(3)))
typedef unsigned u32x2 __attribute__((ext_vector_type(2)));
typedef unsigned u32x4 __attribute__((ext_vector_type(4)));
constexpr int D = 1024, NB = 8, T = 4096, C = 256, RB = C + T, MALL = NB * RB, NTILE = MALL / 256, TPB = RB / 256  ;
constexpr int DIN = 2176, DINP = 2304, DMIX = 1024, DFF = 2816, NMOD = 6, LW = 384;
constexpr float EPS = 1e-6f, LOG2E = 1.4426950408889634f;
constexpr float QSA = 0.17677669529663687f * LOG2E, QSB = 0.125f * LOG2E;
constexpr int O_AQ = 0, O_AK = 256, O_AV = 512, O_BQ = 768, O_BK = 1152, O_BV = 1280, O_CX = 1408, O_CG = 1792;
constexpr int NWAVES = 8, NTHREADS = 512;
constexpr size_t MiB = 1u << 20;
constexpr size_t WS_CTL = 0;
constexpr size_t WS_WIN = 1 * MiB;
constexpr size_t WS_WOUT = 10 * MiB;
constexpr size_t WS_WUP = 14 * MiB;
constexpr size_t WS_WDN = 36 * MiB;
constexpr size_t WS_MOD = 47 * MiB;
constexpr size_t WS_BIAS1 = WS_MOD + 512 * 1024;
constexpr size_t WS_BIAS2 = WS_BIAS1 + 256 * 1024;
constexpr size_t WS_TAB = WS_BIAS2 + 512 * 1024;
constexpr size_t WS_TAB64 = WS_TAB + 4096, WS_PAR = WS_TAB64 + 8192;
constexpr int PAR_STRIDE = 512, PR_GQ32 = 0, PR_GK32 = 32, PR_GQ64 = 64, PR_GK64 = 128, PR_SUBG = 192, PR_SINK = 256, PR_LAM = 272, PR_MA = 273, PR_MB = 274, PR_LI = 275;
constexpr size_t WS_GAIN = WS_PAR + 8192;
constexpr size_t WS_FFNP = WS_GAIN + 16384;
constexpr size_t WS_LRUP = WS_FFNP + 96 * 1024;
constexpr size_t WS_LRUW = WS_LRUP + 32 * 1024;
constexpr size_t WS_VNM = WS_LRUW + 512 * 1024;
constexpr size_t WS_SS1 = 50 * MiB;
constexpr size_t WS_SS2 = WS_SS1 + 1 * MiB;
constexpr size_t WS_LRU = 55 * MiB;
constexpr size_t WS_XC = 56 * MiB;
constexpr size_t WS_SIDE = 64 * MiB;
constexpr size_t WS_VN = 73 * MiB;
constexpr size_t WS_P = 141 * MiB;
constexpr size_t WS_Y = 294 * MiB;
constexpr size_t WS_U = WS_P;
constexpr size_t WS_XB = 362 * MiB;
constexpr size_t WS_LG0 = 430 * MiB;
constexpr size_t WS_LG1 = WS_VN;
constexpr size_t WS_END = 478 * MiB;
static_assert(WS_FFNP + 2 * 4 * DFF * 4 <= WS_LRUP && WS_LRUW + 2 * 2 * 6 * 128 * 64 * 2 <= WS_VNM && WS_VNM + 3 * 9 * 1024 * 4 <= WS_SS1 && WS_SS2 + (size_t)MALL * 64 <= WS_LRU && WS_SIDE + (size_t)NTILE * 6 * DFF * 4 <= WS_VN && WS_U + (size_t)MALL * DFF * 2 <= WS_LG0 && WS_P + (size_t)MALL * DINP * 2 <= WS_Y && WS_XB + (size_t)MALL * D * 2 <= WS_LG0 && WS_VN + (size_t)MALL * D * 2 <= WS_P, "ws map");
constexpr int LDS_BYTES = 163840;
constexpr int LDS_EX = 131072, LDS_RED = LDS_EX + 4096, LDS_TAB32 = LDS_EX + 12288, LDS_TAB64 = LDS_EX + 16384;

__device__ __forceinline__ unsigned f2bf(float f) { unsigned u = __builtin_bit_cast(unsigned, f); return (u + 0x7fffu + ((u >> 16) & 1u)) >> 16; }
__device__ __forceinline__ unsigned pk2(float lo, float hi) { return f2bf(lo) | (f2bf(hi) << 16); }
__device__ __forceinline__ float bf2f(unsigned short h) { return __builtin_bit_cast(float, (unsigned)h << 16); }
__device__ __forceinline__ float sigmoidf_(float x) { return 1.f / (1.f + __expf(-x)); }
__device__ __forceinline__ float siluf_(float x) { return x * sigmoidf_(x); }
#define LDS_WAIT() asm volatile("s_waitcnt lgkmcnt(0)" ::: "memory")
#define GAS __attribute__((address_space(1)))
typedef float f32x2_t __attribute__((ext_vector_type(2))); typedef __bf16 bf16x2_t __attribute__((ext_vector_type(2)));
__device__ __forceinline__ unsigned cvtpk(float lo, float hi) { f32x2_t v = {lo, hi}; bf16x2_t b = __builtin_convertvector(v, bf16x2_t); return __builtin_bit_cast(unsigned, b); }
__device__ __forceinline__ f32x4 ldg4(const float* p) { return *(const GAS f32x4*)p; }
__device__ __forceinline__ void stg4(float* p, f32x4 v) { *(GAS f32x4*)p = v; }
__device__ __forceinline__ void stg2u(bf16_t* p, f32x4 v) { u32x2 o; o.x = cvtpk(v[0], v[1]); o.y = cvtpk(v[2], v[3]); *(GAS u32x2*)p = o; }
__device__ __forceinline__ int fresh_lane() { unsigned z = 0u; asm volatile("" : "+v"(z)); return (int)__builtin_amdgcn_mbcnt_hi(~0u, __builtin_amdgcn_mbcnt_lo(~0u, z)); }

struct Frame {
    LAS unsigned char* lds;
    int tid, lane, wave, vcu, G, bid, flags;
    const float* const* inp; int zero; float* out; unsigned char* ws;
    __device__ __forceinline__ const float* in_(int k) const { return inp[k + zero]; }
};

__device__ __forceinline__ int map_in(int n) {
    const int tile = n >> 8, lc = n & 255;
    if (tile <= 1) { const int s = lc >> 5, bj = (lc >> 4) & 1, q = lc & 15; return (tile << 8) + 128 * bj + 16 * s + q; }
    if (tile == 3 || tile == 4) { const int z = lc >> 6, bj = (lc >> 5) & 1, q = lc & 31; return (tile << 8) + 128 * bj + 32 * z + q; }
    return n;
}
__device__ __forceinline__ int map_up(int n) { if (n < DFF) return 256 * (n >> 7) + (n & 127); const int c = n - DFF; return 256 * (c >> 7) + 128 + (c & 127); }

template <int MAP> __device__ __forceinline__ void transpose_item(const float* __restrict__ W, int K, int N, bf16_t* __restrict__ WT, LAS float* scr, int item, int lane) {
    const int nblk = N / 32, kb = item / nblk, nb = item % nblk, k0 = 64 * kb, n0 = 32 * nb;
    { const int r8 = lane >> 3, c4 = (lane & 7) * 4;
#pragma unroll
      for (int i = 0; i < 8; ++i) { const int kk = 8 * i + r8; const f32x4 v = *(const f32x4*)(W + (size_t)(k0 + kk) * N + n0 + c4);
          LAS float* d = scr + kk * 33 + c4; d[0] = v[0]; d[1] = v[1]; d[2] = v[2]; d[3] = v[3]; } }
    LDS_WAIT(); asm volatile("" ::: "memory");
    const int c = lane & 7;
#pragma unroll
    for (int j = 0; j < 4; ++j) { const int n = (lane >> 3) + 8 * j; const LAS float* s = scr + (8 * c) * 33 + n;
        u32x4 o; o.x = pk2(s[0 * 33], s[1 * 33]); o.y = pk2(s[2 * 33], s[3 * 33]); o.z = pk2(s[4 * 33], s[5 * 33]); o.w = pk2(s[6 * 33], s[7 * 33]);
        const int nl = n0 + n; const int row = MAP == 1 ? map_in(nl) : (MAP == 2 ? map_up(nl) : nl);
        *(u32x4*)(WT + (size_t)row * K + k0 + 8 * c) = o; }
    LDS_WAIT(); asm volatile("" ::: "memory");
}

__device__ __forceinline__ void gemv9_item(Frame& F, LAS float* vecs, LAS float* red, const float* __restrict__ W, int ldw, int n0, float* __restrict__ out, int ldo, const float* __restrict__ addb) {
    float acc[9];
#pragma unroll
    for (int v = 0; v < 9; ++v) acc[v] = 0.f;
    const int kb = F.wave * 128;
#pragma unroll 2
    for (int k = 0; k < 128; k += 16) {
        float w[16];
#pragma unroll
        for (int i = 0; i < 16; ++i) w[i] = W[(size_t)(kb + k + i) * ldw + n0 + F.lane];
#pragma unroll
        for (int q = 0; q < 4; ++q) {
#pragma unroll
            for (int v = 0; v < 9; ++v) { const f32x4 x = *(const LAS f32x4*)(vecs + v * 1024 + kb + k + 4 * q); acc[v] += x[0] * w[4 * q] + x[1] * w[4 * q + 1] + x[2] * w[4 * q + 2] + x[3] * w[4 * q + 3]; }
        }
    }
#pragma unroll
    for (int v = 0; v < 9; ++v) red[(F.wave * 9 + v) * 64 + F.lane] = acc[v];
    __syncthreads();
    for (int e = F.tid; e < 9 * 64; e += NTHREADS) { const int v = e >> 6, ln = e & 63; float s = 0.f;
#pragma unroll
        for (int w8 = 0; w8 < 8; ++w8) s += red[(w8 * 9 + v) * 64 + ln];
        out[(size_t)v * ldo + n0 + ln] = s + (addb ? addb[n0 + ln] : 0.f); }
    __syncthreads();
}

__device__ const float INVF16[16] = {1.000000000e+00f, 5.623413324e-01f, 3.162277639e-01f, 1.778279394e-01f, 1.000000015e-01f, 5.623413250e-02f, 3.162277490e-02f, 1.778279431e-02f,
                                     9.999999776e-03f, 5.623413250e-03f, 3.162277630e-03f, 1.778279431e-03f, 1.000000047e-03f, 5.623413017e-04f, 3.162277571e-04f, 1.778279402e-04f};
__device__ __forceinline__ void phase_p0a(Frame& F) {
    const float* w_in = F.in_(8); const float* w_out = F.in_(26); const float* w_up = F.in_(27); const float* w_down = F.in_(30);
    bf16_t* WIN = (bf16_t*)(F.ws + WS_WIN); bf16_t* WOUT = (bf16_t*)(F.ws + WS_WOUT); bf16_t* WUP = (bf16_t*)(F.ws + WS_WUP); bf16_t* WDN = (bf16_t*)(F.ws + WS_WDN);
    LAS float* scr = (LAS float*)(F.lds + F.wave * 16384);
    const int gw = F.vcu * NWAVES + F.wave, NGW = F.G * NWAVES;
    constexpr int I_IN = 16 * (DIN / 32), I_OUT = 16 * 32, I_UP = 16 * (2 * DFF / 32), I_DN = (DFF / 64) * 32, I_L = I_IN + I_OUT + I_UP + I_DN;
    for (int it = gw; it < 2 * I_L; it += NGW) {
        const int l = it / I_L; int r = it % I_L;
        if (r < I_IN) { transpose_item<1>(w_in + (size_t)l * D * DIN, D, DIN, WIN + (size_t)l * DINP * D, scr, r, F.lane); continue; } r -= I_IN;
        if (r < I_OUT) { transpose_item<0>(w_out + (size_t)l * DMIX * D, DMIX, D, WOUT + (size_t)l * D * DMIX, scr, r, F.lane); continue; } r -= I_OUT;
        if (r < I_UP) { transpose_item<2>(w_up + (size_t)l * D * 2 * DFF, D, 2 * DFF, WUP + (size_t)l * 2 * DFF * D, scr, r, F.lane); continue; } r -= I_UP;
        transpose_item<0>(w_down + (size_t)l * DFF * D, DFF, D, WDN + (size_t)l * D * DFF, scr, r, F.lane);
    }
    { const int gt = F.vcu * NTHREADS + F.tid, NGT = F.G * NTHREADS; bf16_t* LW_ = (bf16_t*)(F.ws + WS_LRUW);
      for (int e = gt; e < 2 * 2 * 6 * 128 * 64; e += NGT) { const int i = e & 63, o = (e >> 6) & 127, blk = e >> 13;
          LW_[e] = (bf16_t)f2bf((o < 64 ? F.in_(21) : F.in_(23))[(size_t)blk * 4096 + i * 64 + (o & 63)]); } }
    { const int gt = F.vcu * NTHREADS + F.tid, NGT = F.G * NTHREADS; constexpr int PER = (DINP - DIN) * D * 2 / 16;
      for (int e = gt; e < 2 * PER; e += NGT) { const int l = e / PER, o = e % PER; *(u32x4*)((unsigned char*)(WIN + ((size_t)l * DINP + DIN) * D) + (size_t)o * 16) = (u32x4){0u, 0u, 0u, 0u}; } }
    __syncthreads();
    LAS float* vecs = (LAS float*)F.lds; LAS float* red = vecs + 9 * 1024;
    const float* cvec = F.in_(1); const float* cctx = F.in_(3); const float* w_mod = F.in_(4); const float* b_mod = F.in_(5);
    float* MOD = (float*)(F.ws + WS_MOD);
    bool staged = false;
    for (int item = F.bid; item < 2 * 96; item += F.G) {
        if (!staged) { for (int e = F.tid; e < 9 * 1024; e += NTHREADS) { const int v = e >> 10, k = e & 1023; vecs[e] = siluf_(v < 8 ? cvec[v * D + k] : cctx[k]); } __syncthreads(); staged = true; }
        const int l = item / 96, n0 = (item % 96) * 64;
        gemv9_item(F, vecs, red, w_mod + (size_t)l * D * NMOD * D, NMOD * D, n0, MOD + (size_t)l * 9 * NMOD * D, NMOD * D, b_mod + (size_t)l * NMOD * D);
    }
    if (F.bid == F.G - 1) {
        float* tab32 = (float*)(F.ws + WS_TAB); float* tab64 = (float*)(F.ws + WS_TAB64);
        for (int idx = F.tid; idx < 64 * 8 + 64 * 16; idx += NTHREADS) {
            int quarter, pos, fi; float* dst;
            if (idx < 64 * 8) { quarter = 8; pos = idx / 8; fi = idx % 8; dst = tab32 + idx * 2; }
            else { const int j = idx - 64 * 8; quarter = 16; pos = j / 16; fi = j % 16; dst = tab64 + j * 2; }
            const float invf = INVF16[fi * (16 / quarter)];
            const float x = (float)pos * invf;
            const float kf = rintf(x * 0.636619772f); const int kq = (int)kf;
            float r = fmaf(-kf, 1.5703125f, x); r = fmaf(-kf, 4.837512969970703125e-4f, r); r = fmaf(-kf, 7.54978995489188216e-8f, r);
            const float r2 = r * r;
            const float sp = r + r * r2 * (-1.6666654611e-1f + r2 * (8.3321608736e-3f + r2 * (-1.9515295891e-4f)));
            const float cp = 1.0f - 0.5f * r2 + r2 * r2 * (4.166664568298827e-2f + r2 * (-1.388731625493765e-3f + r2 * 2.443315711809948e-5f));
            const int qd = kq & 3;
            const float sv = qd == 0 ? sp : (qd == 1 ? cp : (qd == 2 ? -sp : -cp)), cv = qd == 0 ? cp : (qd == 1 ? -sp : (qd == 2 ? -cp : sp));
            dst[0] = cv; dst[1] = sv;
        }
        float* par = (float*)(F.ws + WS_PAR);
        for (int e = F.tid; e < 2 * 262; e += NTHREADS) { const int l = e / 262, i = e % 262; float v;
            if (i < 32) v = F.in_(9)[l * 32 + i]; else if (i < 64) v = F.in_(10)[l * 32 + i - 32]; else if (i < 128) v = F.in_(16)[l * 64 + i - 64]; else if (i < 192) v = F.in_(17)[l * 64 + i - 128];
            else if (i < 256) v = F.in_(15)[l * 64 + i - 192]; else v = F.in_(18)[l * 6 + i - 256];
            par[l * PAR_STRIDE + i] = v; }
        { float* gn = (float*)(F.ws + WS_GAIN); for (int e = F.tid; e < 4 * D; e += NTHREADS) gn[e] = e < 2 * D ? F.in_(6)[e] : F.in_(7)[e - 2 * D];
          float* fp = (float*)(F.ws + WS_FFNP); for (int e = F.tid; e < 2 * 4 * DFF; e += NTHREADS) { const int l = e / (4 * DFF), i = e % (4 * DFF); fp[e] = i < 3 * DFF ? F.in_(28)[(size_t)l * 3 * DFF + i] : F.in_(29)[(size_t)l * DFF + i - 3 * DFF]; } }
        { float* lp = (float*)(F.ws + WS_LRUP);
          for (int e = F.tid; e < 2 * 2 * LW; e += NTHREADS) { const int ld = e / LW, ch = e % LW;
              lp[(ld * 4 + 0) * LW + ch] = F.in_(22)[e]; lp[(ld * 4 + 1) * LW + ch] = F.in_(24)[e];
              const float lam = F.in_(25)[e]; const float sp = lam > 0.f ? log1pf(expf(-lam)) : -lam + log1pf(expf(lam));
              lp[(ld * 4 + 2) * LW + ch] = 8.0f * LOG2E * sp; lp[(ld * 4 + 3) * LW + ch] = F.in_(20)[e]; } }
        if (F.tid < 2) {
            const int l = F.tid; const float li = 0.8f - 0.6f * expf(-0.3f * (float)l);
            const float* lq1 = F.in_(11) + l * 32; const float* lk1 = F.in_(12) + l * 32; const float* lq2 = F.in_(13) + l * 32; const float* lk2 = F.in_(14) + l * 32;
            float s1 = 0.f, s2 = 0.f; for (int i = 0; i < 32; ++i) { s1 += lq1[i] * lk1[i]; s2 += lq2[i] * lk2[i]; }
            float mq = 0.f, mk_ = 0.f; for (int i = 0; i < 32; ++i) { mq = fmaxf(mq, fabsf(F.in_(9)[l * 32 + i])); mk_ = fmaxf(mk_, fabsf(F.in_(10)[l * 32 + i])); }
            float nq = 0.f, nk = 0.f; for (int i = 0; i < 64; ++i) { nq = fmaxf(nq, fabsf(F.in_(16)[l * 64 + i])); nk = fmaxf(nk, fabsf(F.in_(17)[l * 64 + i])); }
            float mb = QSB * 64.f * nq * nk; for (int i = 0; i < 6; ++i) mb = fmaxf(mb, F.in_(18)[l * 6 + i] * LOG2E);
            par[l * PAR_STRIDE + PR_LAM] = expf(s1) - expf(s2) + li; par[l * PAR_STRIDE + PR_MA] = QSA * 32.f * mq * mk_; par[l * PAR_STRIDE + PR_MB] = mb; par[l * PAR_STRIDE + PR_LI] = li;
        }
    }
}

__device__ __forceinline__ void phase_p0b(Frame& F) {
    LAS float* vecs = (LAS float*)F.lds; LAS float* red = vecs + 9 * 1024;
    const float* MOD = (const float*)(F.ws + WS_MOD); float* B1 = (float*)(F.ws + WS_BIAS1); float* B2 = (float*)(F.ws + WS_BIAS2);
    const float* w_in = F.in_(8); const float* w_up = F.in_(27);
    constexpr int I1 = DIN / 64, I2 = 2 * DFF / 64, IL = I1 + I2;
    for (int item = F.bid; item < 2 * IL; item += F.G) {
        const int l = item / IL; int r = item % IL; const bool is1 = r < I1; if (!is1) r -= I1;
        __syncthreads();
        for (int e = F.tid; e < 9 * 1024; e += NTHREADS) { const int v = e >> 10, k = e & 1023; vecs[e] = MOD[((size_t)l * 9 + v) * NMOD * D + (is1 ? 0 : 3) * D + k]; }
        __syncthreads();
        if (is1) gemv9_item(F, vecs, red, w_in + (size_t)l * D * DIN, DIN, r * 64, B1 + (size_t)l * 9 * DINP, DINP, nullptr);
        else gemv9_item(F, vecs, red, w_up + (size_t)l * D * 2 * DFF, 2 * DFF, r * 64, B2 + (size_t)l * 9 * 2 * DFF, 2 * DFF, nullptr);
    }
    { const int gt = F.vcu * NTHREADS + F.tid, NGT = F.G * NTHREADS; float* VNM = (float*)(F.ws + WS_VNM);
      for (int e = gt; e < 3 * 9 * D; e += NGT) { const int n = e % D, v = (e / D) % 9, k = e / (9 * D); const int l = k == 2 ? 1 : k;
          const float gn = k == 2 ? F.in_(6)[D + n] : F.in_(7)[l * D + n]; const float sc = MOD[((size_t)l * 9 + v) * NMOD * D + (k == 2 ? 1 : 4) * D + n];
          VNM[e] = gn * (1.0f + sc); } }
    { const int gt = F.vcu * NTHREADS + F.tid; if (gt < 2 * 9 * (DINP - DIN)) { const int lv = gt / (DINP - DIN), n = gt % (DINP - DIN); B1[(size_t)lv * DINP + DIN + n] = 0.f; } }
    const float* x = F.in_(0); const float* ctx = F.in_(2); const float* g1 = F.in_(6);
    bf16_t* VN = (bf16_t*)(F.ws + WS_VN); float* SS1 = (float*)(F.ws + WS_SS1);
    const int gw = F.vcu * NWAVES + F.wave, NGW = F.G * NWAVES;
    for (int g = gw; g < MALL; g += NGW) {
        const int b = g / RB, r = g % RB; const int v = r < C ? 8 : b;
        const float* src = r < C ? ctx + ((size_t)b * C + r) * D : x + ((size_t)b * T + (r - C)) * D;
        const float* sc = MOD + ((size_t)0 * 9 + v) * NMOD * D + 1 * D;
        float s = 0.f;
#pragma unroll
        for (int j = 0; j < 4; ++j) { const int n = 4 * F.lane + 256 * j; const f32x4 xv = *(const f32x4*)(src + n); const f32x4 gv = *(const f32x4*)(g1 + n); const f32x4 sv = *(const f32x4*)(sc + n);
            s += xv[0] * xv[0] + xv[1] * xv[1] + xv[2] * xv[2] + xv[3] * xv[3];
            u32x2 o; o.x = pk2(xv[0] * gv[0] * (1.f + sv[0]), xv[1] * gv[1] * (1.f + sv[1])); o.y = pk2(xv[2] * gv[2] * (1.f + sv[2]), xv[3] * gv[3] * (1.f + sv[3]));
            *(u32x2*)(VN + (size_t)g * D + n) = o; }
#pragma unroll
        for (int o = 1; o < 64; o <<= 1) s += __shfl_xor(s, o);
        if (F.lane == 0) *(f32x4*)(SS1 + (size_t)g * 4) = (f32x4){s, 0.f, 0.f, 0.f};
    }
}

struct Order {
    int nN, R, latent_only, k, nx, per, x;
    pg8::StaticOrder so; bool generic;
    __device__ __forceinline__ void init(int nMt, int N, int G, int c, int lat) {
        nN = N / 256; latent_only = lat; generic = (G != 256);
        if (generic) { so.init(nMt * 256, N, G, c); return; }
        x = c & 7; k = c >> 3; nx = 32; R = lat ? 16 : TPB; per = R * nN;
    }
    __device__ __forceinline__ bool next(int i, Unit& u) const {
        if (generic) { if (!so.next(i, u)) return false; if (latent_only) u.pm = (u.pm >> 4) * TPB + 1 + (u.pm & 15); return true; }
        const int lu = i * nx + k; if (lu >= per) return false;
        constexpr int RG = 4; const int nig = RG * nN, gid = lu / nig, fm = gid * RG, gsz = (R - fm) < RG ? (R - fm) : RG;
        const int rt = fm + (lu % nig) % gsz; u.pn = (lu % nig) / gsz;
        u.pm = x * TPB + (latent_only ? 1 + rt : rt); return true;
    }
    __device__ __forceinline__ void a_ready(const Unit&) const {}
    __device__ __forceinline__ void done(const Unit&) const {}
};

struct EpiIn {
    static constexpr bool PERM = true, AFTER_DRAIN = false;
    unsigned char* ws; LAS unsigned char* lds; int l; int skip;
    __device__ __forceinline__ void operator()(const f32x4 (&acc)[2][2][4][2], const Unit& u, int wr, int wc, int fr, int fq) const {
        if (skip) return;
        { const int ln = fresh_lane(); fr = ln & 15; fq = ln >> 4; }
        bf16_t* P = (bf16_t*)(ws + WS_P); const float* SS = (const float*)(ws + WS_SS1); const float* bias = (const float*)(ws + WS_BIAS1) + (size_t)l * 9 * DINP;
        const LAS float* tab32 = (const LAS float*)(lds + LDS_TAB32); const LAS float* tab64 = (const LAS float*)(lds + LDS_TAB64); const float* par = (const float*)(ws + WS_PAR) + l * PAR_STRIDE;
        const int b = u.pm / TPB, j = u.pm % TPB; const bool lat = j != 0; const float* bia = bias + (size_t)(lat ? b : 8) * DINP;
        const int pn = u.pn;
        float rsv[2][4];
        { f32x4 s4[2][4];
#pragma unroll
          for (int ai = 0; ai < 2; ++ai)
#pragma unroll
              for (int m = 0; m < 4; ++m) s4[ai][m] = ldg4(SS + ((size_t)u.pm * 256 + ai * 128 + wr * 64 + m * 16 + fr) * 4);
#pragma unroll
          for (int ai = 0; ai < 2; ++ai)
#pragma unroll
              for (int m = 0; m < 4; ++m) rsv[ai][m] = __builtin_amdgcn_rsqf((s4[ai][m][0] + s4[ai][m][1] + s4[ai][m][2] + s4[ai][m][3]) * (1.0f / D) + EPS); }
        const int tb4 = (j - 1) * 4 + wr;
        if (pn <= 1) {
            const float* gain = par + (pn == 0 ? PR_GQ32 : PR_GK32);
            const int dq = 8 * (fq & 1); const int col0 = 256 * pn + 32 * (2 * wc + (fq >> 1)) + dq;
            f32x4 g1[2], g2[2], b1[2], b2[2];
#pragma unroll
            for (int n = 0; n < 2; ++n) { g1[n] = ldg4(gain + dq + 4 * n); g2[n] = ldg4(gain + 16 + dq + 4 * n); b1[n] = ldg4(bia + col0 + 4 * n); b2[n] = ldg4(bia + col0 + 16 + 4 * n); }
            const float qs = pn == 0 ? QSA : 1.0f;
#pragma unroll
            for (int ai = 0; ai < 2; ++ai)
#pragma unroll
                for (int m = 0; m < 4; ++m) {
                    const int rloc = ai * 128 + wr * 64 + m * 16 + fr; bf16_t* prow_p = P + ((size_t)u.pm * 256 + rloc) * DINP; const float rs = rsv[ai][m];
                    f32x4 x1[2], x2[2]; float ss = 0.f;
#pragma unroll
                    for (int n = 0; n < 2; ++n) { x1[n] = acc[ai][0][m][n] * rs + b1[n]; x2[n] = acc[ai][1][m][n] * rs + b2[n];
                        ss += x1[n][0] * x1[n][0] + x1[n][1] * x1[n][1] + x1[n][2] * x1[n][2] + x1[n][3] * x1[n][3] + x2[n][0] * x2[n][0] + x2[n][1] * x2[n][1] + x2[n][2] * x2[n][2] + x2[n][3] * x2[n][3]; }
                    ss += __shfl_xor(ss, 16);
                    const float ri = __builtin_amdgcn_rsqf(ss * (1.0f / 32.f) + EPS) * qs;
                    const int pos = (fq & 1) ? 16 * m + fr : tb4 + 2 * ai;
#pragma unroll
                    for (int n = 0; n < 2; ++n) {
                        f32x4 y1 = x1[n] * ri * g1[n], y2 = x2[n] * ri * g2[n];
                        if (lat) { const LAS float* tb = tab32 + (pos * 8 + 4 * n) * 2; const f32x4 c01 = *(const LAS f32x4*)(tb), c23 = *(const LAS f32x4*)(tb + 4);
                            const f32x4 cs = (f32x4){c01[0], c01[2], c23[0], c23[2]}, sn = (f32x4){c01[1], c01[3], c23[1], c23[3]};
                            const f32x4 z1 = y1 * cs - y2 * sn, z2 = y1 * sn + y2 * cs; y1 = z1; y2 = z2; }
                        x1[n] = y1; x2[n] = y2;
                    }
                    u32x4 o1, o2; o1.x = cvtpk(x1[0][0], x1[0][1]); o1.y = cvtpk(x1[0][2], x1[0][3]); o1.z = cvtpk(x1[1][0], x1[1][1]); o1.w = cvtpk(x1[1][2], x1[1][3]);
                    o2.x = cvtpk(x2[0][0], x2[0][1]); o2.y = cvtpk(x2[0][2], x2[0][3]); o2.z = cvtpk(x2[1][0], x2[1][1]); o2.w = cvtpk(x2[1][2], x2[1][3]);
                    *(GAS u32x4*)(prow_p + col0) = o1; *(GAS u32x4*)(prow_p + col0 + 16) = o2;
                }
        } else if (pn == 3 || pn == 4) {
            const bool isq = pn == 3 || wc < 2; const float* gain = par + (isq ? PR_GQ64 : PR_GK64);
            const int colb = 256 * pn + 64 * wc + 8 * fq;
            f32x4 ga[2], gb[2], ba[2], bb[2];
#pragma unroll
            for (int n = 0; n < 2; ++n) { ga[n] = ldg4(gain + 8 * fq + 4 * n); gb[n] = ldg4(gain + 32 + 8 * fq + 4 * n); ba[n] = ldg4(bia + colb + 4 * n); bb[n] = ldg4(bia + colb + 32 + 4 * n); }
            const float qs = isq ? QSB : 1.0f;
#pragma unroll
            for (int ai = 0; ai < 2; ++ai)
#pragma unroll
                for (int m = 0; m < 4; ++m) {
                    const int rloc = ai * 128 + wr * 64 + m * 16 + fr; bf16_t* prow_p = P + ((size_t)u.pm * 256 + rloc) * DINP; const float rs = rsv[ai][m];
                    f32x4 xa[2], xb[2]; float ss = 0.f;
#pragma unroll
                    for (int n = 0; n < 2; ++n) { xa[n] = acc[ai][0][m][n] * rs + ba[n]; xb[n] = acc[ai][1][m][n] * rs + bb[n];
                        ss += xa[n][0] * xa[n][0] + xa[n][1] * xa[n][1] + xa[n][2] * xa[n][2] + xa[n][3] * xa[n][3] + xb[n][0] * xb[n][0] + xb[n][1] * xb[n][1] + xb[n][2] * xb[n][2] + xb[n][3] * xb[n][3]; }
                    ss += __shfl_xor(ss, 16); ss += __shfl_xor(ss, 32);
                    const float ri = __builtin_amdgcn_rsqf(ss * (1.0f / 64.f) + EPS) * qs;
                    const int pos = fq < 2 ? tb4 + 2 * ai : 16 * m + fr;
#pragma unroll
                    for (int n = 0; n < 2; ++n) {
                        f32x4 y1 = xa[n] * ri * ga[n], y2 = xb[n] * ri * gb[n];
                        if (lat) { const LAS float* tb = tab64 + (pos * 16 + 8 * (fq & 1) + 4 * n) * 2; const f32x4 c01 = *(const LAS f32x4*)(tb), c23 = *(const LAS f32x4*)(tb + 4);
                            const f32x4 cs = (f32x4){c01[0], c01[2], c23[0], c23[2]}, sn = (f32x4){c01[1], c01[3], c23[1], c23[3]};
                            const f32x4 z1 = y1 * cs - y2 * sn, z2 = y1 * sn + y2 * cs; y1 = z1; y2 = z2; }
                        xa[n] = y1; xb[n] = y2;
                    }
                    u32x4 o1, o2; o1.x = cvtpk(xa[0][0], xa[0][1]); o1.y = cvtpk(xa[0][2], xa[0][3]); o1.z = cvtpk(xa[1][0], xa[1][1]); o1.w = cvtpk(xa[1][2], xa[1][3]);
                    o2.x = cvtpk(xb[0][0], xb[0][1]); o2.y = cvtpk(xb[0][2], xb[0][3]); o2.z = cvtpk(xb[1][0], xb[1][1]); o2.w = cvtpk(xb[1][2], xb[1][3]);
                    *(GAS u32x4*)(prow_p + colb) = o1; *(GAS u32x4*)(prow_p + colb + 32) = o2;
                }
        } else {
            f32x4 bv[2][2];
#pragma unroll
            for (int bj = 0; bj < 2; ++bj)
#pragma unroll
                for (int n = 0; n < 2; ++n) { const int col = 256 * pn + 128 * bj + 32 * wc + 8 * fq + 4 * n; bv[bj][n] = col < DIN ? ldg4(bia + col) : (f32x4){0.f, 0.f, 0.f, 0.f}; }
#pragma unroll
            for (int ai = 0; ai < 2; ++ai)
#pragma unroll
                for (int m = 0; m < 4; ++m) {
                    const int rloc = ai * 128 + wr * 64 + m * 16 + fr; bf16_t* prow_p = P + ((size_t)u.pm * 256 + rloc) * DINP; const float rs = rsv[ai][m];
#pragma unroll
                    for (int bj = 0; bj < 2; ++bj) { const int col = 256 * pn + 128 * bj + 32 * wc + 8 * fq;
                        if (col < DIN) { const f32x4 a0 = acc[ai][bj][m][0] * rs + bv[bj][0], a1 = acc[ai][bj][m][1] * rs + bv[bj][1];
                            u32x4 o; o.x = cvtpk(a0[0], a0[1]); o.y = cvtpk(a0[2], a0[3]); o.z = cvtpk(a1[0], a1[1]); o.w = cvtpk(a1[2], a1[3]); *(GAS u32x4*)(prow_p + col) = o; } }
                }
        }
    }
};

__device__ __forceinline__ void phase_p1(Frame& F, int l) {
    { const float* t32 = (const float*)(F.ws + WS_TAB); LAS float* d32 = (LAS float*)(F.lds + LDS_TAB32);
      for (int e = F.tid; e < (4096 + 8192) / 16; e += NTHREADS) *(LAS f32x4*)(d32 + 4 * e) = ldg4(t32 + 4 * e);
      __syncthreads(); }
    pg8::Gemm g{(const bf16_t*)(F.ws + WS_VN), (const bf16_t*)(F.ws + WS_WIN) + (size_t)l * DINP * D, MALL, DINP, D};
    Order S; S.init(NTILE, DINP, F.G, (int)F.bid, 0);
    EpiIn E{F.ws, F.lds, l, F.flags & 4};
    pg8::gemm_phase<EpiIn, Order, true, true>(F.lds, g, S, E, F.tid);
}
struct EpiRes {
    static constexpr bool PERM = true, AFTER_DRAIN = false;
    unsigned char* ws; const float* xin; const float* ctxin; float* out; LAS float* red; int l, kind, skip;
    __device__ __forceinline__ void operator()(const f32x4 (&acc)[2][2][4][2], const Unit& u, int wr, int wc, int fr, int fq) const {
        if (skip) return;
        { const int ln = fresh_lane(); fr = ln & 15; fq = ln >> 4; }
        const float* MOD = (const float*)(ws + WS_MOD);
        const int b = u.pm / TPB, j = u.pm % TPB; const bool lat = j != 0; const int v = lat ? b : 8;
        const float* gate = MOD + ((size_t)l * 9 + v) * NMOD * D + (kind == 0 ? 2 : 5) * D;
        const bool do_vn = kind == 0 || l == 0;
        const float* vnm = (const float*)(ws + WS_VNM) + ((size_t)(kind == 0 ? l : 2) * 9 + v) * D;
        float* SSd = (float*)(ws + (kind == 0 ? WS_SS2 : WS_SS1));
        bf16_t* VN = (bf16_t*)(ws + WS_VN); bf16_t* XB = (bf16_t*)(ws + WS_XB);
        const bool first = kind == 0 && l == 0, last = kind == 1 && l == 1;
        const float* srcf = lat ? xin + (size_t)b * T * D : ctxin + (size_t)b * C * D;
        float* dstf = out + (size_t)b * T * D;
        const int rbase = lat ? (j - 1) * 256 : 0;
        const int c0 = 256 * u.pn + 32 * wc + 8 * fq;
        f32x4 gt[2][2], vm[2][2];
#pragma unroll
        for (int bj = 0; bj < 2; ++bj)
#pragma unroll
            for (int n = 0; n < 2; ++n) { gt[bj][n] = ldg4(gate + c0 + 128 * bj + 4 * n); vm[bj][n] = do_vn ? ldg4(vnm + c0 + 128 * bj + 4 * n) : (f32x4){0.f, 0.f, 0.f, 0.f}; }
#define EPIRES_ROW(ai, m, X0, X1, BJ) do { const int c = c0 + 128 * (BJ); \
            const f32x4 x0 = (X0) + gt[BJ][0] * acc[ai][BJ][m][0], x1 = (X1) + gt[BJ][1] * acc[ai][BJ][m][1]; \
            if (last) { const size_t ro = (size_t)(rbase + rloc) * D; stg4(dstf + ro + c, x0); stg4(dstf + ro + c + 4, x1); } \
            else { u32x4 o; o.x = cvtpk(x0[0], x0[1]); o.y = cvtpk(x0[2], x0[3]); o.z = cvtpk(x1[0], x1[1]); o.w = cvtpk(x1[2], x1[3]); *(GAS u32x4*)(XB + g * D + c) = o; } \
            if (do_vn) { const f32x4 v0 = x0 * vm[BJ][0], v1 = x1 * vm[BJ][1]; \
                u32x4 o; o.x = cvtpk(v0[0], v0[1]); o.y = cvtpk(v0[2], v0[3]); o.z = cvtpk(v1[0], v1[1]); o.w = cvtpk(v1[2], v1[3]); *(GAS u32x4*)(VN + g * D + c) = o; \
                ss += (x0[0] * x0[0] + x0[1] * x0[1] + x0[2] * x0[2] + x0[3] * x0[3]) + (x1[0] * x1[0] + x1[1] * x1[1] + x1[2] * x1[2] + x1[3] * x1[3]); } } while (0)
        if (first) {
#pragma unroll
            for (int hq = 0; hq < 4; ++hq) {
                const int ai = hq >> 1, mb = (hq & 1) * 2;
                f32x4 xo[2][2][2];
#pragma unroll
                for (int mm = 0; mm < 2; ++mm) { const size_t ro = (size_t)(rbase + ai * 128 + wr * 64 + (mb + mm) * 16 + fr) * D;
#pragma unroll
                    for (int bj = 0; bj < 2; ++bj) { xo[mm][bj][0] = ldg4(srcf + ro + c0 + 128 * bj); xo[mm][bj][1] = ldg4(srcf + ro + c0 + 128 * bj + 4); } }
#pragma unroll
                for (int mm = 0; mm < 2; ++mm) { const int m = mb + mm; const int rloc = ai * 128 + wr * 64 + m * 16 + fr; const size_t g = (size_t)u.pm * 256 + rloc; float ss = 0.f;
                    EPIRES_ROW(ai, m, xo[mm][0][0], xo[mm][0][1], 0); EPIRES_ROW(ai, m, xo[mm][1][0], xo[mm][1][1], 1);
                    if (do_vn) { ss += __shfl_xor(ss, 16); ss += __shfl_xor(ss, 32); if (fq == 0) red[wc * 256 + rloc] = ss; } }
            }
        } else {
#pragma unroll
            for (int ai = 0; ai < 2; ++ai) {
                u32x4 raw[4][2];
#pragma unroll
                for (int m = 0; m < 4; ++m) { const size_t g = (size_t)u.pm * 256 + ai * 128 + wr * 64 + m * 16 + fr;
#pragma unroll
                    for (int bj = 0; bj < 2; ++bj) raw[m][bj] = *(const GAS u32x4*)(XB + g * D + c0 + 128 * bj); }
#pragma unroll
                for (int m = 0; m < 4; ++m) { const int rloc = ai * 128 + wr * 64 + m * 16 + fr; const size_t g = (size_t)u.pm * 256 + rloc; float ss = 0.f;
#pragma unroll
                    for (int bj = 0; bj < 2; ++bj) { const u32x4 v = raw[m][bj];
                        const f32x4 a0 = (f32x4){__builtin_bit_cast(float, v.x << 16), __builtin_bit_cast(float, v.x & 0xffff0000u), __builtin_bit_cast(float, v.y << 16), __builtin_bit_cast(float, v.y & 0xffff0000u)};
                        const f32x4 a1 = (f32x4){__builtin_bit_cast(float, v.z << 16), __builtin_bit_cast(float, v.z & 0xffff0000u), __builtin_bit_cast(float, v.w << 16), __builtin_bit_cast(float, v.w & 0xffff0000u)};
                        if (bj == 0) EPIRES_ROW(ai, m, a0, a1, 0); else EPIRES_ROW(ai, m, a0, a1, 1); }
                    if (do_vn) { ss += __shfl_xor(ss, 16); ss += __shfl_xor(ss, 32); if (fq == 0) red[wc * 256 + rloc] = ss; } }
            }
        }
#undef EPIRES_ROW
        if (do_vn) {
            asm volatile("s_waitcnt lgkmcnt(0)" ::: "memory"); __builtin_amdgcn_s_barrier(); asm volatile("" ::: "memory");
            const int tid = 64 * (4 * wr + wc) + 16 * fq + fr;
            if (tid < 256) SSd[((size_t)u.pm * 256 + tid) * 4 + u.pn] = (red[tid] + red[256 + tid]) + (red[512 + tid] + red[768 + tid]);
        }
    }
};

struct EpiUp {
    static constexpr bool PERM = true, AFTER_DRAIN = false;
    unsigned char* ws; LAS float* ex; LAS float* pl; int l, skip;
    __device__ __forceinline__ void operator()(const f32x4 (&acc)[2][2][4][2], const Unit& u, int wr, int wc, int fr, int fq) const {
        if (skip) return;
        { const int ln = fresh_lane(); fr = ln & 15; fq = ln >> 4; }
        const float* SS = (const float*)(ws + WS_SS2); const float* ffp = (const float*)(ws + WS_FFNP) + (size_t)l * 4 * DFF;
        const int b = u.pm / TPB, j = u.pm % TPB; const int v = j != 0 ? b : 8;
        const float* bia = (const float*)(ws + WS_BIAS2) + ((size_t)l * 9 + v) * 2 * DFF;
        bf16_t* U = (bf16_t*)(ws + WS_U); float* SIDE = (float*)(ws + WS_SIDE) + (size_t)u.pm * 6 * DFF;
        const int ch0 = 128 * u.pn + 32 * wc + 8 * fq;
        LAS float* rsl = pl + 6 * 128;
        { const int tid = 64 * (4 * wr + wc) + 16 * fq + fr;
          if (tid < 256) { const f32x4 s4 = ldg4(SS + ((size_t)u.pm * 256 + tid) * 4); rsl[tid] = __builtin_amdgcn_rsqf((s4[0] + s4[1] + s4[2] + s4[3]) * (1.0f / D) + EPS); } }
        { const int tid = 64 * (4 * wr + wc) + 16 * fq + fr;
          if (tid < 192) { const int vsel = tid >> 5, c4 = (tid & 31) * 4; const float* src = vsel == 0 ? bia : (vsel == 1 ? bia + DFF : ffp + (size_t)(vsel - 2) * DFF);
              *(LAS f32x4*)(pl + vsel * 128 + c4) = ldg4(src + 128 * u.pn + c4); } }
        asm volatile("s_waitcnt vmcnt(0) lgkmcnt(0)" ::: "memory"); __builtin_amdgcn_s_barrier(); asm volatile("" ::: "memory");
#pragma unroll
        for (int ai = 0; ai < 2; ++ai)
#pragma unroll
            for (int n = 0; n < 2; ++n) { const int q = 2 * ai + wr; const int cc = 32 * wc + 8 * fq + 4 * n; const f32x4 b4x = ldg4(bia + ch0 + 4 * n);
                if (fr == 0) *(LAS f32x4*)(ex + (q * 2 + 0) * 128 + cc) = acc[ai][0][0][n] * rsl[ai * 128 + wr * 64 + 0 * 16 + fr] + b4x;
                if (fr == 15) *(LAS f32x4*)(ex + (q * 2 + 1) * 128 + cc) = acc[ai][0][3][n] * rsl[ai * 128 + wr * 64 + 3 * 16 + fr] + b4x; }
        asm volatile("s_waitcnt lgkmcnt(0)" ::: "memory"); __builtin_amdgcn_s_barrier(); asm volatile("" ::: "memory");
        const int lane = fr + 16 * fq; const int srcp = (lane & 48) | ((fr + 15) & 15), srcn = (lane & 48) | ((fr + 1) & 15);
#pragma unroll
        for (int ai = 0; ai < 2; ++ai) {
            const int q = 2 * ai + wr;
            u32x2 keep[4];
#pragma unroll
            for (int n = 0; n < 2; ++n) {
                const int cc = 32 * wc + 8 * fq + 4 * n; const int ch = ch0 + 4 * n;
                const f32x4 b4n = *(const LAS f32x4*)(pl + 0 * 128 + cc), bv4n = *(const LAS f32x4*)(pl + 1 * 128 + cc), w0n = *(const LAS f32x4*)(pl + 2 * 128 + cc), w1n = *(const LAS f32x4*)(pl + 3 * 128 + cc), w2n = *(const LAS f32x4*)(pl + 4 * 128 + cc), fbn = *(const LAS f32x4*)(pl + 5 * 128 + cc);
                f32x4 pb = (f32x4){0.f, 0.f, 0.f, 0.f}, nb = pb;
                if (q > 0) pb = *(const LAS f32x4*)(ex + ((q - 1) * 2 + 1) * 128 + cc);
                if (q < 3) nb = *(const LAS f32x4*)(ex + ((q + 1) * 2 + 0) * 128 + cc);
                f32x4 Gm[4];
#pragma unroll
                for (int m = 0; m < 4; ++m) Gm[m] = acc[ai][0][m][n] * rsl[ai * 128 + wr * 64 + m * 16 + fr] + b4n;
#pragma unroll
                for (int m = 0; m < 4; ++m) {
                    const f32x4 sp = (fr == 15 && m > 0) ? Gm[m > 0 ? m - 1 : 0] : Gm[m], sn = (fr == 0 && m < 3) ? Gm[m < 3 ? m + 1 : 3] : Gm[m];
                    f32x4 prev, next;
#pragma unroll
                    for (int e = 0; e < 4; ++e) { prev[e] = __shfl(sp[e], srcp, 64); next[e] = __shfl(sn[e], srcn, 64); }
                    if (m == 0 && fr == 0) prev = pb;
                    if (m == 3 && fr == 15) next = nb;
                    const f32x4 pre = fbn + w0n * prev + w1n * Gm[m] + w2n * next;
                    const f32x4 val = acc[ai][1][m][n] * rsl[ai * 128 + wr * 64 + m * 16 + fr] + bv4n;
                    f32x4 uu;
#pragma unroll
                    for (int e = 0; e < 4; ++e) uu[e] = pre[e] * __builtin_amdgcn_rcpf(1.0f + __builtin_amdgcn_exp2f(-LOG2E * pre[e])) * val[e];
                    const int rloc = ai * 128 + wr * 64 + m * 16 + fr; const size_t g = (size_t)u.pm * 256 + rloc;
                    if (n == 0) { keep[m].x = cvtpk(uu[0], uu[1]); keep[m].y = cvtpk(uu[2], uu[3]); }
                    else { u32x4 o; o.x = keep[m].x; o.y = keep[m].y; o.z = cvtpk(uu[0], uu[1]); o.w = cvtpk(uu[2], uu[3]); *(GAS u32x4*)(U + g * DFF + ch0) = o; }
                    if (rloc == 0 || rloc == 255) { float* sd = SIDE + (size_t)(ch >> 2) * 24 + (rloc == 0 ? 0 : 12); stg4(sd, pre); stg4(sd + 4, val); stg4(sd + 8, Gm[m]); }
                }
                asm volatile("" ::: "memory");
            }
        }
        asm volatile("s_waitcnt lgkmcnt(0)" ::: "memory"); __builtin_amdgcn_s_barrier(); asm volatile("" ::: "memory");
    }
};

__device__ __forceinline__ void phase_p3(Frame& F, int l) {
    pg8::Gemm g{(const bf16_t*)(F.ws + WS_Y), (const bf16_t*)(F.ws + WS_WOUT) + (size_t)l * D * DMIX, MALL, D, DMIX};
    Order S; S.init(l == 0 ? NTILE : NB * 16, D, F.G, F.bid, l == 0 ? 0 : 1);
    EpiRes E{F.ws, F.in_(0), F.in_(2), F.out, (LAS float*)(F.lds + LDS_RED), l, 0, F.flags & 4};
    pg8::gemm_phase<EpiRes, Order, true, true>(F.lds, g, S, E, F.tid);
}
__device__ __forceinline__ void phase_p4(Frame& F, int l) {
    pg8::Gemm g{(const bf16_t*)(F.ws + WS_VN), (const bf16_t*)(F.ws + WS_WUP) + (size_t)l * 2 * DFF * D, MALL, 2 * DFF, D};
    Order S; S.init(l == 0 ? NTILE : NB * 16, 2 * DFF, F.G, F.bid, l == 0 ? 0 : 1);
    EpiUp E{F.ws, (LAS float*)(F.lds + LDS_EX), (LAS float*)(F.lds + LDS_EX + 25600), l, F.flags & 4};
    pg8::gemm_phase<EpiUp, Order, true, true>(F.lds, g, S, E, F.tid);
}
__device__ __forceinline__ void phase_p5(Frame& F, int l) {
    Order S; S.init(l == 0 ? NTILE : NB * 16, D, F.G, F.bid, l == 0 ? 0 : 1);
    { const float* SIDE = (const float*)(F.ws + WS_SIDE); const float* ffp = (const float*)(F.ws + WS_FFNP) + (size_t)l * 4 * DFF; bf16_t* U = (bf16_t*)(F.ws + WS_U);
      Unit u;
      for (int i = 0; S.next(i, u); ++i) { const int pm = u.pm, j = pm % TPB;
          for (int ch = F.tid; ch < DFF; ch += NTHREADS) {
              const size_t so = ((size_t)pm * (DFF / 4) + (ch >> 2)) * 24 + (ch & 3);
              if (j >= 2) { const float pre = SIDE[so + 0] + ffp[ch] * SIDE[so - (size_t)(DFF / 4) * 24 + 20];
                  U[(size_t)pm * 256 * DFF + ch] = (bf16_t)f2bf(pre / (1.0f + __expf(-pre)) * SIDE[so + 4]); }
              if (j >= 1 && j <= 15) { const float pre = SIDE[so + 12] + ffp[2 * DFF + ch] * SIDE[so + (size_t)(DFF / 4) * 24 + 8];
                  U[((size_t)pm * 256 + 255) * DFF + ch] = (bf16_t)f2bf(pre / (1.0f + __expf(-pre)) * SIDE[so + 16]); }
          } }
      asm volatile("s_waitcnt vmcnt(0)" ::: "memory"); __syncthreads(); }
    pg8::Gemm g{(const bf16_t*)(F.ws + WS_U), (const bf16_t*)(F.ws + WS_WDN) + (size_t)l * D * DFF, MALL, D, DFF};
    EpiRes E{F.ws, F.in_(0), F.in_(2), F.out, (LAS float*)(F.lds + LDS_RED), l, 1, F.flags & 4};
    pg8::gemm_phase<EpiRes, Order, true, true>(F.lds, g, S, E, F.tid);
}
typedef short bf16x8 __attribute__((ext_vector_type(8)));
typedef short s16x4 __attribute__((ext_vector_type(4)));
typedef float f32x16 __attribute__((ext_vector_type(16)));
__device__ __forceinline__ int crow(int r, int hi) { return (r & 3) + 8 * (r >> 2) + 4 * hi; }
typedef short v4i16_t __attribute__((ext_vector_type(4)));
__device__ __forceinline__ s16x4 vtr(const LAS unsigned char* p) { return __builtin_bit_cast(s16x4, __builtin_amdgcn_ds_read_tr16_b64_v4i16((LAS v4i16_t*)p)); }

constexpr int ATT_KV_BYTES = 8192;
__device__ __forceinline__ void att_stage(const bf16_t* Krow0, const bf16_t* Vrow0, LAS unsigned char* kbuf, LAS unsigned char* vbuf, int wave, int lane) {
    const int kr = 8 * wave + (lane >> 3);
    const bf16_t* ks = Krow0 + (size_t)kr * DINP + (((lane & 7) ^ ((kr >> 1) & 7)) * 8);
    const bf16_t* vs = Vrow0 + (size_t)(16 * (wave & 3) + (lane >> 2)) * DINP + (wave >> 2) * 32 + (lane & 3) * 8;
    __builtin_amdgcn_global_load_lds((const unsigned*)ks, (LAS unsigned*)(kbuf + wave * 1024), 16, 0, 0);
    __builtin_amdgcn_global_load_lds((const unsigned*)vs, (LAS unsigned*)(vbuf + wave * 1024), 16, 0, 0);
}
template <int NK> __device__ __forceinline__ f32x16 att_qk(const LAS unsigned char* kbuf, int d0, int kh, const bf16x8* qr, f32x16 cinit, int r32, int hi) {
    f32x16 s = cinit;
#pragma unroll
    for (int i = 0; i < NK; ++i) { const int key = kh * 32 + r32; const bf16x8 kf = *(const LAS bf16x8*)(kbuf + key * 128 + (((2 * (d0 + i) + hi) ^ ((key >> 1) & 7)) * 16)); s = __builtin_amdgcn_mfma_f32_32x32x16_bf16(kf, qr[i], s, 0, 0, 0); }
    return s;
}
__device__ __forceinline__ bf16x8 att_vfrag(const LAS unsigned char* vbuf, int dh, int ks, int lane, int hi) {
    const LAS unsigned char* p = vbuf + (dh * 4 + ks) * 1024 + ((lane >> 4) & 1) * 32 + (lane & 3) * 8 + (4 * hi + ((lane & 15) >> 2)) * 64;
    const s16x4 lo = vtr(p), hh = vtr(p + 512);
    return (bf16x8){lo[0], lo[1], lo[2], lo[3], hh[0], hh[1], hh[2], hh[3]};
}
__device__ __forceinline__ float half_swap_sum(float v) { return v + __shfl_xor(v, 32); }

__device__ __forceinline__ void da_unit(Frame& F, int l, int b, int h, int q0, int nkeys) {
    const int lane_ = fresh_lane();
    const int lane = lane_, wave = F.wave, r32 = lane & 31, hi = lane >> 5;
    unsigned char* wsu = F.ws; asm volatile("" : "+s"(wsu));
    const bf16_t* P = (const bf16_t*)(wsu + WS_P) + (size_t)b * RB * DINP;
    const float* par = (const float*)(wsu + WS_PAR) + l * PAR_STRIDE;
    LAS unsigned char* kb0 = F.lds; LAS unsigned char* vb0 = F.lds + 4 * ATT_KV_BYTES;
    LAS float* wsf = (LAS float*)(F.lds + 8 * ATT_KV_BYTES) + wave * 128;
    const bf16_t* Kp = P + O_AK + h * 64; const bf16_t* Vp = P + O_AV + h * 64;
    const int NT = nkeys / 64;
#pragma nounroll
    for (int t0 = 0; t0 < 2; ++t0) att_stage(Kp + (size_t)t0 * 64 * DINP, Vp + (size_t)t0 * 64 * DINP, kb0 + t0 * ATT_KV_BYTES, vb0 + t0 * ATT_KV_BYTES, wave, lane);
    bf16x8 qr[4];
#pragma unroll
    for (int d0 = 0; d0 < 4; ++d0) qr[d0] = *(const bf16x8*)(P + (size_t)(q0 + wave * 32 + r32) * DINP + O_AQ + h * 64 + d0 * 16 + hi * 8);
    const float negM = -par[PR_MA];
    f32x16 cinit;
#pragma unroll
    for (int r = 0; r < 16; ++r) cinit[r] = negM;
    f32x16 o[2][2];
#pragma unroll
    for (int m = 0; m < 2; ++m)
#pragma unroll
        for (int dh = 0; dh < 2; ++dh)
#pragma unroll
            for (int r = 0; r < 16; ++r) o[m][dh][r] = 0.f;
    float lsum[2] = {0.f, 0.f};
    asm volatile("s_waitcnt vmcnt(0)" ::: "memory"); __syncthreads();
    f32x16 sc0 = att_qk<2>(kb0, 0, 0, qr, cinit, r32, hi), sc1 = att_qk<2>(kb0, 0, 1, qr, cinit, r32, hi);
    unsigned pwp[4][4];
#pragma unroll
    for (int ks = 0; ks < 4; ++ks)
#pragma unroll
        for (int i = 0; i < 4; ++i) pwp[ks][i] = 0u;
#ifdef DA_STAMP
    unsigned long long st_[6] = {0, 0, 0, 0, 0, 0}; unsigned long long ta_, tb_;
#define DSTAMP(v) do { __builtin_amdgcn_sched_barrier(0); asm volatile("s_memtime %0\n\ts_waitcnt lgkmcnt(0)" : "=s"(v) :: "memory"); __builtin_amdgcn_sched_barrier(0); } while (0)
#else
#define DSTAMP(v) do {} while (0)
#endif
    int bk = 0, bk1 = 1, bvp = 0;
    for (int t = 0; t < NT; ++t) {
#ifdef DA_STAMP
        DSTAMP(ta_); const unsigned long long titer_ = ta_;
#endif
        if (t + 2 < NT) { const int bl = (t + 2) & 3; att_stage(Kp + (size_t)(t + 2) * 64 * DINP, Vp + (size_t)(t + 2) * 64 * DINP, kb0 + bl * ATT_KV_BYTES, vb0 + bl * ATT_KV_BYTES, wave, lane); }
#pragma unroll
        for (int m = 0; m < 2; ++m) {
#ifdef DA_STAMP
            DSTAMP(ta_);
#endif
            f32x16 sn0 = cinit, sn1 = cinit;
            const bool have_next = m == 0 || t + 1 < NT;
            if (have_next) { const LAS unsigned char* kbn = kb0 + (m == 0 ? bk : bk1) * ATT_KV_BYTES; const int mn = m ^ 1;
                sn0 = att_qk<2>(kbn, 2 * mn, 0, qr + 2 * mn, cinit, r32, hi); sn1 = att_qk<2>(kbn, 2 * mn, 1, qr + 2 * mn, cinit, r32, hi); }
#ifdef DA_STAMP
            DSTAMP(tb_); st_[0] += tb_ - ta_; ta_ = tb_;
#endif
            if (m == 1 || t > 0) { const LAS unsigned char* vb = vb0 + (m == 1 ? bk : bvp) * ATT_KV_BYTES;
#pragma unroll
                for (int dh = 0; dh < 2; ++dh)
#pragma unroll
                    for (int ks = 0; ks < 4; ++ks) { const bf16x8 vf = att_vfrag(vb, dh, ks, lane, hi); const u32x4 pa = (u32x4){pwp[ks][0], pwp[ks][1], pwp[ks][2], pwp[ks][3]};
                        o[m ^ 1][dh] = __builtin_amdgcn_mfma_f32_32x32x16_bf16(__builtin_bit_cast(bf16x8, pa), vf, o[m ^ 1][dh], 0, 0, 0); } }
#ifdef DA_STAMP
            DSTAMP(tb_); st_[1] += tb_ - ta_; ta_ = tb_;
#endif
            float acc = 0.f;
#pragma unroll
            for (int r = 0; r < 16; ++r) { sc0[r] = __builtin_amdgcn_exp2f(sc0[r]); sc1[r] = __builtin_amdgcn_exp2f(sc1[r]); acc += sc0[r] + sc1[r]; }
            lsum[m] += acc;
#pragma unroll
            for (int i = 0; i < 4; ++i) { pwp[0][i] = cvtpk(sc0[2 * i], sc0[2 * i + 1]); pwp[1][i] = cvtpk(sc0[8 + 2 * i], sc0[8 + 2 * i + 1]); pwp[2][i] = cvtpk(sc1[2 * i], sc1[2 * i + 1]); pwp[3][i] = cvtpk(sc1[8 + 2 * i], sc1[8 + 2 * i + 1]); }
            sc0 = sn0; sc1 = sn1;
#ifdef DA_STAMP
            asm volatile("" : "+v"(sc0), "+v"(sc1));
            DSTAMP(tb_); st_[2] += tb_ - ta_; ta_ = tb_;
#endif
        }
        bvp = bk; bk = bk1; bk1 = (bk1 + 1) & 3;
        asm volatile("s_waitcnt vmcnt(0) lgkmcnt(0)" ::: "memory");
#ifdef DA_STAMP
        DSTAMP(tb_); st_[3] += tb_ - ta_; ta_ = tb_;
#endif
        __builtin_amdgcn_s_barrier(); asm volatile("" ::: "memory");
#ifdef DA_STAMP
        DSTAMP(tb_); st_[4] += tb_ - ta_; st_[5] += tb_ - titer_;
#endif
    }
    { const LAS unsigned char* vb = vb0 + bvp * ATT_KV_BYTES;
#pragma unroll
      for (int dh = 0; dh < 2; ++dh)
#pragma unroll
          for (int ks = 0; ks < 4; ++ks) { const bf16x8 vf = att_vfrag(vb, dh, ks, lane, hi); const u32x4 pa = (u32x4){pwp[ks][0], pwp[ks][1], pwp[ks][2], pwp[ks][3]};
              o[1][dh] = __builtin_amdgcn_mfma_f32_32x32x16_bf16(__builtin_bit_cast(bf16x8, pa), vf, o[1][dh], 0, 0, 0); } }
    unsigned char* ws2 = F.ws; asm volatile("" : "+s"(ws2));
    const float* par2 = (const float*)(ws2 + WS_PAR) + l * PAR_STRIDE;
    const float lam = par2[PR_LAM], li = par2[PR_LI];
    lsum[0] = half_swap_sum(lsum[0]); lsum[1] = half_swap_sum(lsum[1]);
    if (hi == 0) { wsf[r32] = __builtin_amdgcn_rcpf(lsum[0]); wsf[32 + r32] = lam * __builtin_amdgcn_rcpf(lsum[1]); }
    LDS_WAIT();
    float ss[16];
#pragma unroll
    for (int r = 0; r < 16; ++r) { const int row = crow(r, hi); const float i0 = wsf[row], i1 = wsf[32 + row];
        float sq = 0.f;
#pragma unroll
        for (int dh = 0; dh < 2; ++dh) { const float v = o[0][dh][r] * i0 - o[1][dh][r] * i1; o[0][dh][r] = v; sq += v * v; }
        ss[r] = sq; }
#pragma unroll
    for (int sh = 1; sh < 32; sh <<= 1)
#pragma unroll
        for (int r = 0; r < 16; ++r) ss[r] += __shfl_xor(ss[r], sh);
    bf16_t* Y = (bf16_t*)(ws2 + WS_Y) + ((size_t)b * RB + q0 + wave * 32) * D + h * 64;
#pragma unroll
    for (int dh = 0; dh < 2; ++dh) { const float gsc = par2[PR_SUBG + 32 * dh + r32] * (1.0f - li);
#pragma unroll
        for (int r = 0; r < 16; ++r) { const float rs = __builtin_amdgcn_rsqf(ss[r] * (1.0f / 64.f) + EPS);
            if (!(F.flags & 8)) Y[(size_t)crow(r, hi) * D + 32 * dh + r32] = (bf16_t)f2bf(o[0][dh][r] * rs * gsc); } }
#ifdef DA_STAMP
    if (F.bid == DA_STAMP_BLOCK && wave == DA_STAMP_WAVE && lane == 0 && q0 == C && nkeys == RB) { unsigned long long* sp_ = (unsigned long long*)(ws2 + WS_CTL + 65536);
        for (int i = 0; i < 6; ++i) sp_[i] = st_[i]; sp_[6] = (unsigned long long)NT; }
#endif
    __syncthreads();
}

__device__ __forceinline__ void sw_unit(Frame& F, int l, int b, int kv, int q0, int g) {
    const int lane_ = fresh_lane();
    const int lane = lane_, wave = F.wave, r32 = lane & 31, hi = lane >> 5;
    const bf16_t* P = (const bf16_t*)(F.ws + WS_P) + (size_t)b * RB * DINP;
    const float* par = (const float*)(F.ws + WS_PAR) + l * PAR_STRIDE;
    LAS unsigned char* kb0 = F.lds; LAS unsigned char* vb0 = F.lds + 2 * ATT_KV_BYTES;
    LAS float* wsf = (LAS float*)(F.lds + 4 * ATT_KV_BYTES) + wave * 128;
    const bf16_t* Kp = P + O_BK + kv * 64; const bf16_t* Vp = P + O_BV + kv * 64;
    const bool lat = q0 != 0;
    const int pos0 = q0 - C;
    const int band_lo = lat ? (pos0 - 128 < 0 ? 0 : pos0 - 128) : 0, band_hi = lat ? (pos0 + 384 > T ? T : pos0 + 384) : 0;
    const int NT = 4 + (band_hi - band_lo) / 64;
    const int qpos = pos0 + wave * 32 + r32;
    att_stage(Kp, Vp, kb0, vb0, wave, lane);
    bf16x8 qr[4];
#pragma unroll
    for (int d0 = 0; d0 < 4; ++d0) qr[d0] = *(const bf16x8*)(P + (size_t)(q0 + wave * 32 + r32) * DINP + O_BQ + (kv * 3 + g) * 64 + d0 * 16 + hi * 8);
    const float negM = -par[PR_MB];
    f32x16 cinit;
#pragma unroll
    for (int r = 0; r < 16; ++r) cinit[r] = negM;
    f32x16 o[2];
    float lsum = hi == 0 ? __builtin_amdgcn_exp2f(par[PR_SINK + kv * 3 + g] * LOG2E + negM) : 0.f;
#pragma unroll
    for (int dh = 0; dh < 2; ++dh)
#pragma unroll
        for (int r = 0; r < 16; ++r) o[dh][r] = 0.f;
    asm volatile("s_waitcnt vmcnt(0)" ::: "memory"); __syncthreads();
    for (int t = 0; t < NT; ++t) {
        const int cur = t & 1;
        if (t + 1 < NT) { const int nr = (t + 1 < 4) ? (t + 1) * 64 : C + band_lo + (t + 1 - 4) * 64;
            att_stage(Kp + (size_t)nr * DINP, Vp + (size_t)nr * DINP, kb0 + (cur ^ 1) * ATT_KV_BYTES, vb0 + (cur ^ 1) * ATT_KV_BYTES, wave, lane); }
        const LAS unsigned char* kb = kb0 + cur * ATT_KV_BYTES; const LAS unsigned char* vb = vb0 + cur * ATT_KV_BYTES;
        const int kpos0 = band_lo + (t - 4) * 64;
        const int wlo = pos0 + wave * 32 - 128, whi = pos0 + wave * 32 + 31 + 128;
        const bool band = t >= 4;
        const bool active = !band || (kpos0 + 63 >= wlo && kpos0 <= whi);
        if (active) {
            const bool need_mask = band && (kpos0 < wlo + 31 || kpos0 + 63 > whi - 31);
            {
                unsigned pw[4][4];
#pragma unroll
                for (int kh = 0; kh < 2; ++kh) {
                    f32x16 s = att_qk<4>(kb, 0, kh, qr, cinit, r32, hi);
                    float acc = 0.f;
#pragma unroll
                    for (int r = 0; r < 16; ++r) { float p = __builtin_amdgcn_exp2f(s[r]);
                        if (need_mask) { const int d = qpos - (kpos0 + kh * 32 + crow(r, hi)); p = (d > 128 || d < -128) ? 0.f : p; }
                        s[r] = p; acc += p; }
                    lsum += acc;
#pragma unroll
                    for (int i = 0; i < 4; ++i) { pw[2 * kh][i] = cvtpk(s[2 * i], s[2 * i + 1]); pw[2 * kh + 1][i] = cvtpk(s[8 + 2 * i], s[8 + 2 * i + 1]); }
                }
#pragma unroll
                for (int dh = 0; dh < 2; ++dh)
#pragma unroll
                    for (int ks = 0; ks < 4; ++ks) { const bf16x8 vf = att_vfrag(vb, dh, ks, lane, hi); const u32x4 pa = (u32x4){pw[ks][0], pw[ks][1], pw[ks][2], pw[ks][3]};
                        o[dh] = __builtin_amdgcn_mfma_f32_32x32x16_bf16(__builtin_bit_cast(bf16x8, pa), vf, o[dh], 0, 0, 0); }
            }
        }
        asm volatile("s_waitcnt vmcnt(0)" ::: "memory"); __syncthreads();
    }
    { const float lt = half_swap_sum(lsum); if (hi == 0) wsf[r32] = 1.0f / lt; }
    LDS_WAIT();
    bf16_t* Y = (bf16_t*)(F.ws + WS_Y) + ((size_t)b * RB + q0 + wave * 32) * D + 256 + kv * 192;
#pragma unroll
    for (int r = 0; r < 16; ++r) { const int row = crow(r, hi); const float il = wsf[row];
#pragma unroll
        for (int dh = 0; dh < 2; ++dh) Y[(size_t)row * D + g * 64 + 32 * dh + r32] = (bf16_t)f2bf(o[dh][r] * il); }
    __syncthreads();
}

constexpr int LRU_XS = 0, LRU_CG = 33792, LRU_XCB = LRU_CG + 32768, LRU_WT = LRU_XCB + 256 * 144, LRU_EXC = LRU_WT + 128 * 144, LRU_HIN = LRU_EXC + 4096, LRU_PRM = LRU_HIN + 512, LRU_HF = LRU_PRM + 4096;
static_assert(LRU_HF + 32768 <= LDS_BYTES - 64, "LRU LDS map");
__device__ __forceinline__ float fast_sigmoid(float z) { return __builtin_amdgcn_rcpf(1.0f + __builtin_amdgcn_exp2f(-LOG2E * z)); }
__device__ __forceinline__ float bflo(unsigned v) { return __builtin_bit_cast(float, v << 16); }
__device__ __forceinline__ float bfhi(unsigned v) { return __builtin_bit_cast(float, v & 0xffff0000u); }
__device__ __forceinline__ void lru_item(Frame& F, int l, int pm, int hb, int stage) {
    const int lane_ = fresh_lane();
    const int lane = lane_, wave = F.wave, tid = wave * 64 + lane, r32 = lane & 31, hi = lane >> 5;
    unsigned char* wsu = F.ws; asm volatile("" : "+s"(wsu));
    const int b = pm / TPB, j = pm % TPB; const int L = j == 0 ? C : T, t0 = j == 0 ? 0 : (j - 1) * 256;
    const bf16_t* P = (const bf16_t*)(wsu + WS_P) + (size_t)pm * 256 * DINP;
    LAS unsigned char* XS = F.lds + LRU_XS; LAS unsigned char* CG = F.lds + LRU_CG; LAS unsigned char* XCb = F.lds + LRU_XCB; LAS unsigned char* WT = F.lds + LRU_WT;
    LAS float* EXC = (LAS float*)(F.lds + LRU_EXC); LAS float* HIN = (LAS float*)(F.lds + LRU_HIN);
    float* SUM = (float*)(wsu + WS_LRU);
    const u32x4* wsrc = (const u32x4*)((const bf16_t*)(wsu + WS_LRUW) + (size_t)(l * 2 * 6 + hb) * 8192);
    for (int e = tid; e < 262 * 8; e += NTHREADS) { const int row = e >> 3, cc = e & 7; const int rl = row - 3, tt = t0 + rl;
        u32x4 v = (u32x4){0u, 0u, 0u, 0u};
        if (tt >= 0 && tt < L) v = *(const GAS u32x4*)(P + (ptrdiff_t)rl * DINP + O_CX + 64 * hb + 8 * cc);
        *(LAS u32x4*)(XS + row * 128 + cc * 16) = v; }
    asm volatile("" ::: "memory");
    if (stage != 0) {
#pragma unroll
        for (int i = 0; i < 4; ++i) { const int e = tid + i * NTHREADS; const int row = e >> 3, cc = e & 7; *(LAS u32x4*)(CG + row * 128 + cc * 16) = *(const GAS u32x4*)(P + (size_t)row * DINP + O_CG + 64 * hb + 8 * cc); } }
    asm volatile("" ::: "memory");
#pragma unroll
    for (int i = 0; i < 2; ++i) { const int e = tid + i * NTHREADS; *(LAS u32x4*)(WT + (e >> 3) * 144 + (e & 7) * 16) = *(const GAS u32x4*)(wsrc + e); }
    asm volatile("" ::: "memory");
    { LAS float* PRM = (LAS float*)(F.lds + LRU_PRM);
      for (int e = tid; e < 2 * 8 * 64; e += NTHREADS) { const int ch = e & 63, kk = (e >> 6) & 7, d = e >> 9;
          PRM[e] = kk < 4 ? F.in_(19)[((size_t)(l * 2 + d) * 4 + kk) * LW + 64 * hb + ch] : ((const float*)(wsu + WS_LRUP))[((size_t)(l * 2 + d) * 4 + (kk - 4)) * LW + 64 * hb + ch]; } }
    asm volatile("" ::: "memory");
    LAS unsigned char* HF = F.lds + LRU_HF;
    const bool cache = stage == 0 && j != 0; const int itemL = (b * 16 + (j - 1)) * 6 + hb;
#pragma unroll
    for (int d = 0; d < 2; ++d) {
        if (d == 1) {
#pragma unroll
            for (int i = 0; i < 2; ++i) { const int e = tid + i * NTHREADS; *(LAS u32x4*)(WT + (e >> 3) * 144 + (e & 7) * 16) = *(const GAS u32x4*)(wsrc + 6 * 1024 + e); } }
        typedef float f2 __attribute__((ext_vector_type(2)));
        const LAS float* prm = (const LAS float*)(F.lds + LRU_PRM) + d * 512;
        const int c2 = (tid & 31) * 2;
        __syncthreads();
        const f2 w0 = *(const LAS f2*)(prm + 0 * 64 + c2), w1 = *(const LAS f2*)(prm + 1 * 64 + c2), w2 = *(const LAS f2*)(prm + 2 * 64 + c2), w3 = *(const LAS f2*)(prm + 3 * 64 + c2), bb = *(const LAS f2*)(prm + 7 * 64 + c2);
#pragma unroll 4
        for (int i = 0; i < 16; ++i) { const int rl = (tid >> 5) + 16 * i; const LAS unsigned char* x = XS + (rl + 3) * 128 + c2 * 2;
            const unsigned u0 = *(const LAS unsigned*)(x), ua = *(const LAS unsigned*)(x + (d == 0 ? -3 : 3) * 128), ub = *(const LAS unsigned*)(x + (d == 0 ? -2 : 2) * 128), uc = *(const LAS unsigned*)(x + (d == 0 ? -1 : 1) * 128);
            const float v0 = bb[0] + w0[0] * bflo(ua) + w1[0] * bflo(ub) + w2[0] * bflo(uc) + w3[0] * bflo(u0);
            const float v1 = bb[1] + w0[1] * bfhi(ua) + w1[1] * bfhi(ub) + w2[1] * bfhi(uc) + w3[1] * bfhi(u0);
            *(LAS unsigned*)(XCb + rl * 144 + c2 * 2) = cvtpk(v0, v1); }
        __syncthreads();
        f32x16 acc[4];
#pragma unroll
        for (int nt = 0; nt < 4; ++nt)
#pragma unroll
            for (int r = 0; r < 16; ++r) acc[nt][r] = 0.f;
#pragma unroll
        for (int ks = 0; ks < 4; ++ks) { const bf16x8 af = *(const LAS bf16x8*)(XCb + (wave * 32 + r32) * 144 + (16 * ks + 8 * hi) * 2);
#pragma unroll
            for (int nt = 0; nt < 4; ++nt) { const bf16x8 bf = *(const LAS bf16x8*)(WT + (32 * nt + r32) * 144 + (16 * ks + 8 * hi) * 2);
                acc[nt] = __builtin_amdgcn_mfma_f32_32x32x16_bf16(af, bf, acc[nt], 0, 0, 0); } }
#pragma unroll
        for (int chh = 0; chh < 2; ++chh) { const int ch = 32 * chh + r32;
            const float ba = prm[4 * 64 + ch], bx = prm[5 * 64 + ch], sp8 = prm[6 * 64 + ch];
            unsigned zp[8], bp[8]; float zprev = 0.f, bprev = 0.f;
#pragma unroll
            for (int r = 0; r < 16; ++r) { const int rl = wave * 32 + crow(r, hi);
                const float xc = bf2f(*(const LAS unsigned short*)(XCb + rl * 144 + ch * 2));
                const float rg = fast_sigmoid(acc[chh][r] + ba), ig = fast_sigmoid(acc[2 + chh][r] + bx);
                const float z = rg * sp8;
                const float av = __builtin_amdgcn_exp2f(-z);
                const float bv = __builtin_amdgcn_sqrtf(fmaxf(1.0f - av * av, 0.f)) * (ig * xc);
                acc[chh][r] = av; acc[2 + chh][r] = bv;
                if (r & 1) { zp[r >> 1] = cvtpk(zprev, z); bp[r >> 1] = cvtpk(bprev, bv); } else { zprev = z; bprev = bv; } }
            if (cache) {
                unsigned char* lg = wsu + (d == 0 ? WS_LG0 : WS_LG1) + (size_t)itemL * 65536 + chh * 16384 + wave * 1024 + lane * 16;
                *(GAS u32x4*)(lg) = (u32x4){zp[0], zp[1], zp[2], zp[3]}; *(GAS u32x4*)(lg + 8192) = (u32x4){zp[4], zp[5], zp[6], zp[7]};
                *(GAS u32x4*)(lg + 32768) = (u32x4){bp[0], bp[1], bp[2], bp[3]}; *(GAS u32x4*)(lg + 32768 + 8192) = (u32x4){bp[4], bp[5], bp[6], bp[7]}; } }
        float gA[2][8], gB[2][8];
#pragma unroll
        for (int chh = 0; chh < 2; ++chh) {
#pragma unroll
            for (int q = 0; q < 4; ++q) { float A_ = 1.f, B_ = 0.f;
#pragma unroll
                for (int e = 0; e < 4; ++e) { const int r = 4 * q + (d == 0 ? e : 3 - e); B_ = acc[chh][r] * B_ + acc[2 + chh][r]; A_ *= acc[chh][r]; }
                const float pA_ = __shfl_xor(A_, 32), pB_ = __shfl_xor(B_, 32);
                gA[chh][2 * q] = hi ? pA_ : A_; gA[chh][2 * q + 1] = hi ? A_ : pA_; gB[chh][2 * q] = hi ? pB_ : B_; gB[chh][2 * q + 1] = hi ? B_ : pB_; }
            float blkA = 1.f, blkH = 0.f;
#pragma unroll
            for (int k = 0; k < 8; ++k) { const int s = d == 0 ? k : 7 - k; blkH = gA[chh][s] * blkH + gB[chh][s]; blkA *= gA[chh][s]; }
            if (hi == 0) *(LAS f2*)(EXC + (wave * 64 + 32 * chh + r32) * 2) = (f2){blkA, blkH};
        }
        LDS_WAIT(); __syncthreads();
#pragma unroll
        for (int chh = 0; chh < 2; ++chh) { const int ch = 32 * chh + r32;
            float h = 0.f;
            float totA = 1.f, totH = 0.f;
#pragma unroll
            for (int k = 0; k < 8; ++k) { const int w = d == 0 ? k : 7 - k; const f2 e2 = *(const LAS f2*)(EXC + (w * 64 + ch) * 2);
                const bool before = d == 0 ? (w < wave) : (w > wave);
                if (before) h = e2[0] * h + e2[1];
                totH = e2[0] * totH + e2[1]; totA *= e2[0]; }
            { if (wave == 0 && hi == 0) *(GAS f2*)(SUM + (((size_t)pm * 2 + d) * LW + 64 * hb + ch) * 2) = (f2){totA, totH}; }
            if (stage != 0) {
                float hq[4] = {0.f, 0.f, 0.f, 0.f};
#pragma unroll
                for (int k = 0; k < 8; ++k) { const int s = d == 0 ? k : 7 - k; const int q = s >> 1;
                    hq[q] = ((s & 1) == hi) ? h : hq[q];
                    h = gA[chh][s] * h + gB[chh][s]; }
#pragma unroll
                for (int q = 0; q < 4; ++q) { float hh = hq[q];
#pragma unroll
                    for (int e = 0; e < 4; ++e) { const int r = 4 * q + (d == 0 ? e : 3 - e); hh = acc[chh][r] * hh + acc[2 + chh][r]; acc[2 + chh][r] = hh; } }
                if (d == 0) {
#pragma unroll
                    for (int r = 0; r < 16; ++r) { const int rl = wave * 32 + crow(r, hi); *(LAS unsigned short*)(HF + rl * 128 + ch * 2) = (unsigned short)f2bf(acc[2 + chh][r]); }
                } else {
#pragma unroll
                    for (int r = 0; r < 16; ++r) { const int rl = wave * 32 + crow(r, hi); LAS unsigned short* cgp = (LAS unsigned short*)(CG + rl * 128 + ch * 2);
                        const float g = bf2f(*cgp), hf = bf2f(*(const LAS unsigned short*)(HF + rl * 128 + ch * 2));
                        const float u2 = (2.0f * 0.7978845608028654f * LOG2E) * (g + 0.044715f * g * g * g);
                        const float ge = g * __builtin_amdgcn_rcpf(1.0f + __builtin_amdgcn_exp2f(-u2));
                        *cgp = (unsigned short)f2bf((hf + acc[2 + chh][r]) * ge); }
                }
            }
        }
    }
    __syncthreads();
    if (stage != 0) {
        bf16_t* Y = (bf16_t*)(wsu + WS_Y) + (size_t)pm * 256 * D + 640 + 64 * hb;
#pragma unroll
        for (int i = 0; i < 4; ++i) { const int e = tid + i * NTHREADS; const int row = e >> 3, cc = e & 7; *(GAS u32x4*)(Y + (size_t)row * D + 8 * cc) = *(const LAS u32x4*)(CG + row * 128 + cc * 16); }
        __syncthreads();
    }
}


__device__ __forceinline__ void lru_item_b(Frame& F, int l, int pm, int hb) {
    const int lane_ = fresh_lane();
    const int lane = lane_, wave = F.wave, tid = wave * 64 + lane, r32 = lane & 31, hi = lane >> 5;
    unsigned char* wsu = F.ws; asm volatile("" : "+s"(wsu));
    const int b = pm / TPB, j = pm % TPB;
    const bf16_t* P = (const bf16_t*)(wsu + WS_P) + (size_t)pm * 256 * DINP;
    LAS unsigned char* CG = F.lds + LRU_CG; LAS float* EXC = (LAS float*)(F.lds + LRU_EXC); LAS float* HIN = (LAS float*)(F.lds + LRU_HIN); LAS unsigned char* HF = F.lds + LRU_HF;
    float* SUM = (float*)(wsu + WS_LRU);
#pragma unroll
    for (int i = 0; i < 4; ++i) { const int e = tid + i * NTHREADS; const int row = e >> 3, cc = e & 7; *(LAS u32x4*)(CG + row * 128 + cc * 16) = *(const GAS u32x4*)(P + (size_t)row * DINP + O_CG + 64 * hb + 8 * cc); }
    asm volatile("" ::: "memory");
    if (tid < 128) { const int d = tid >> 6, ch = tid & 63; const int pm0 = b * TPB; float h = 0.f;
        typedef float f2 __attribute__((ext_vector_type(2)));
        const GAS f2* S2 = (const GAS f2*)SUM + (size_t)d * LW + 64 * hb + ch;
#pragma unroll
        for (int half = 0; half < 2; ++half) { f2 sv[8];
#pragma unroll
            for (int k = 0; k < 8; ++k) { const int q = half * 8 + k;
                const int jj = d == 0 ? q : (q == 0 ? 0 : 17 - q); const bool valid = d == 0 ? (q < j) : (j != 0 && (q == 0 || jj > j));
                sv[k] = valid ? S2[(size_t)(pm0 + jj) * 2 * LW] : (f2){1.f, 0.f}; }
#pragma unroll
            for (int k = 0; k < 8; ++k) h = sv[k][0] * h + sv[k][1];
            asm volatile("" : "+v"(h)); }
        HIN[tid] = h; }
    const int itemL = (b * 16 + (j - 1)) * 6 + hb;
#pragma unroll
    for (int d = 0; d < 2; ++d) {
        typedef float f2 __attribute__((ext_vector_type(2)));
        f32x16 acc[4];
        { const unsigned char* lg = wsu + (d == 0 ? WS_LG0 : WS_LG1) + (size_t)itemL * 65536 + wave * 1024 + lane * 16;
#pragma unroll
          for (int chh = 0; chh < 2; ++chh)
#pragma unroll
              for (int hf = 0; hf < 2; ++hf) { const u32x4 zv = *(const GAS u32x4*)(lg + chh * 16384 + hf * 8192), bv = *(const GAS u32x4*)(lg + 32768 + chh * 16384 + hf * 8192);
#pragma unroll
                  for (int k = 0; k < 4; ++k) { const int r = 8 * hf + 2 * k;
                      acc[chh][r] = __builtin_amdgcn_exp2f(-bflo(zv[k])); acc[chh][r + 1] = __builtin_amdgcn_exp2f(-bfhi(zv[k]));
                      acc[2 + chh][r] = bflo(bv[k]); acc[2 + chh][r + 1] = bfhi(bv[k]); } } }
        __syncthreads();
        float gA[2][8], gB[2][8];
#pragma unroll
        for (int chh = 0; chh < 2; ++chh) {
#pragma unroll
            for (int q = 0; q < 4; ++q) { float A_ = 1.f, B_ = 0.f;
#pragma unroll
                for (int e = 0; e < 4; ++e) { const int r = 4 * q + (d == 0 ? e : 3 - e); B_ = acc[chh][r] * B_ + acc[2 + chh][r]; A_ *= acc[chh][r]; }
                const float pA_ = __shfl_xor(A_, 32), pB_ = __shfl_xor(B_, 32);
                gA[chh][2 * q] = hi ? pA_ : A_; gA[chh][2 * q + 1] = hi ? A_ : pA_; gB[chh][2 * q] = hi ? pB_ : B_; gB[chh][2 * q + 1] = hi ? B_ : pB_; }
            float blkA = 1.f, blkH = 0.f;
#pragma unroll
            for (int k = 0; k < 8; ++k) { const int s = d == 0 ? k : 7 - k; blkH = gA[chh][s] * blkH + gB[chh][s]; blkA *= gA[chh][s]; }
            if (hi == 0) *(LAS f2*)(EXC + (wave * 64 + 32 * chh + r32) * 2) = (f2){blkA, blkH};
        }
        LDS_WAIT(); __syncthreads();
#pragma unroll
        for (int chh = 0; chh < 2; ++chh) { const int ch = 32 * chh + r32;
            float h = HIN[d * 64 + ch];
#pragma unroll
            for (int k = 0; k < 8; ++k) { const int w = d == 0 ? k : 7 - k; const f2 e2 = *(const LAS f2*)(EXC + (w * 64 + ch) * 2);
                const bool before = d == 0 ? (w < wave) : (w > wave);
                if (before) h = e2[0] * h + e2[1]; }
            float hq[4] = {0.f, 0.f, 0.f, 0.f};
#pragma unroll
            for (int k = 0; k < 8; ++k) { const int s = d == 0 ? k : 7 - k; const int q = s >> 1;
                hq[q] = ((s & 1) == hi) ? h : hq[q];
                h = gA[chh][s] * h + gB[chh][s]; }
#pragma unroll
            for (int q = 0; q < 4; ++q) { float hh = hq[q];
#pragma unroll
                for (int e = 0; e < 4; ++e) { const int r = 4 * q + (d == 0 ? e : 3 - e); hh = acc[chh][r] * hh + acc[2 + chh][r]; acc[2 + chh][r] = hh; } }
            if (d == 0) {
#pragma unroll
                for (int r = 0; r < 16; ++r) { const int rl = wave * 32 + crow(r, hi); *(LAS unsigned short*)(HF + rl * 128 + ch * 2) = (unsigned short)f2bf(acc[2 + chh][r]); }
            } else {
#pragma unroll
                for (int r = 0; r < 16; ++r) { const int rl = wave * 32 + crow(r, hi); LAS unsigned short* cgp = (LAS unsigned short*)(CG + rl * 128 + ch * 2);
                    const float g = bf2f(*cgp), hf = bf2f(*(const LAS unsigned short*)(HF + rl * 128 + ch * 2));
                    const float u2 = (2.0f * 0.7978845608028654f * LOG2E) * (g + 0.044715f * g * g * g);
                    const float ge = g * __builtin_amdgcn_rcpf(1.0f + __builtin_amdgcn_exp2f(-u2));
                    *cgp = (unsigned short)f2bf((hf + acc[2 + chh][r]) * ge); }
            }
        }
    }
    __syncthreads();
    { bf16_t* Y = (bf16_t*)(wsu + WS_Y) + (size_t)pm * 256 * D + 640 + 64 * hb;
#pragma unroll
      for (int i = 0; i < 4; ++i) { const int e = tid + i * NTHREADS; const int row = e >> 3, cc = e & 7; *(GAS u32x4*)(Y + (size_t)row * D + 8 * cc) = *(const LAS u32x4*)(CG + row * 128 + cc * 16); }
      __syncthreads(); }
}
__device__ __forceinline__ void unit_map16(const Frame& F, int u, int& gi, int& sub) {
    if (F.G == 256) { const int bid = u & 255, rnd = u >> 8, x = bid & 7, k = bid >> 3; gi = rnd * 16 + 2 * x + (k >> 4); sub = k & 15; }
    else { gi = u >> 4; sub = u & 15; }
}
__device__ __forceinline__ void phase_p2a(Frame& F, int l) {
    if (!(F.flags & 1)) for (int it = F.bid; it < NTILE * 6; it += F.G) { const int pm = it / 6; lru_item(F, l, pm, it % 6, (l == 0 && pm % TPB == 0) ? 2 : 0); }
    if (F.flags & 2) return;
    for (int u = F.bid; u < NB * 2 * 16; u += F.G) { int gi, pb; unit_map16(F, u, gi, pb); for (int g = 0; g < 3; ++g) sw_unit(F, l, gi >> 1, gi & 1, C + pb * 256, g); }
    if (l == 0) for (int u = F.G - 1 - F.bid; u < NB * 2 * 3; u += F.G) sw_unit(F, l, (u / 3) >> 1, (u / 3) & 1, 0, u % 3);
}
__device__ __forceinline__ void phase_p2b(Frame& F, int l) {
    if (!(F.flags & 1)) for (int it = F.bid; it < NTILE * 6; it += F.G) { const int pm = it / 6; if (pm % TPB == 0) continue; lru_item_b(F, l, pm, it % 6); }
    if (F.flags & 2) return;
    for (int u = F.bid; u < NB * 4 * 16; u += F.G) { int gi, qb; unit_map16(F, u, gi, qb); da_unit(F, l, gi >> 2, gi & 3, C + qb * 256, RB); }
    if (l == 0) for (int u = F.G - 1 - F.bid; u < NB * 4; u += F.G) da_unit(F, l, u >> 2, u & 3, 0, C);
}
#define XB_TMO      128
#define XB_XCNT(j)  (256  + 64 * (j))
#define XB_XSUB(j)  (1280 + 64 * (j))
#define XB_XGEN(j)  (2304 + 64 * (j))
#define XB_TOP      3328
#define XB_TOPGEN   3392
#define XCD_BAR_WORDS 3456
#define XB_SPIN_CAP (1u << 18)

__device__ __forceinline__ unsigned xb_ld(unsigned* p)              { return __hip_atomic_load(p, __ATOMIC_RELAXED, __HIP_MEMORY_SCOPE_AGENT); }
__device__ __forceinline__ unsigned xb_add(unsigned* p, unsigned v) { return __hip_atomic_fetch_add(p, v, __ATOMIC_RELAXED, __HIP_MEMORY_SCOPE_AGENT); }
__device__ __forceinline__ unsigned xb_xcc_id() { return (unsigned)__builtin_amdgcn_s_getreg((3 << 11) | 20) & 0xFu; }
#define XB_SPIN(cond, bar) do { unsigned _sp = 0; while (cond) { __builtin_amdgcn_s_sleep(1); \
    if ((++_sp & 255u) == 0u) { if (xb_ld(&(bar)[XB_TMO])) break; if (_sp > XB_SPIN_CAP) { atomicAdd(&(bar)[XB_TMO], 1u); break; } } } } while (0)

struct XcdBarrier {
    unsigned* bar; unsigned x;
    volatile LAS unsigned* st;
};

__device__ __forceinline__ XcdBarrier xcd_barrier_post(unsigned* bar, volatile LAS unsigned* st, int tid) {
    XcdBarrier b; b.bar = bar; b.x = xb_xcc_id(); b.st = st;
    if (tid == 0) (void)xb_add(&bar[XB_XCNT(b.x)], 1u);
    return b;
}
__device__ __forceinline__ void xcd_barrier_complete(unsigned* bar, unsigned x, unsigned& nloc, unsigned& nx) {
    const unsigned G = gridDim.x * gridDim.y * gridDim.z;
    unsigned sum, cnt, mine, sp = 0u;
    for (;;) {
        sum = 0u; cnt = 0u; mine = 0u;
#pragma unroll
        for (unsigned j = 0; j < 16; ++j) { const unsigned c = xb_ld(&bar[XB_XCNT(j)]); sum += c; cnt += (c > 0u) ? 1u : 0u; mine = (j == x) ? c : mine; }
        if (sum == G) break;
        __builtin_amdgcn_s_sleep(1);
        if ((++sp & 255u) == 0u) { if (xb_ld(&bar[XB_TMO])) break; if (sp > XB_SPIN_CAP) { atomicAdd(&bar[XB_TMO], 1u); break; } }
    }
    nloc = mine > 0u ? mine : 1u; nx = cnt > 0u ? cnt : 1u;
}

__device__ __forceinline__ void xcd_barrier(const XcdBarrier& b, int tid) {
    asm volatile("s_waitcnt vmcnt(0)" ::: "memory");
    __syncthreads();
    if (tid == 0) {
        unsigned* bar = b.bar;
        __builtin_amdgcn_s_waitcnt(0);
        unsigned nloc = b.st[0], nx = b.st[1];
        if (nloc == 0u) { xcd_barrier_complete(bar, b.x, nloc, nx); b.st[0] = nloc; b.st[1] = nx; }
        const unsigned old = xb_add(&bar[XB_XSUB(b.x)], 1u);
        const unsigned gen = old / nloc;
        if (old + 1u == (gen + 1u) * nloc) {
            __builtin_amdgcn_fence(__ATOMIC_RELEASE, "agent");
            asm volatile("s_waitcnt vmcnt(0)" ::: "memory");
            const unsigned og = xb_add(&bar[XB_TOP], 1u);
            const unsigned tg = og / nx;
            if (og + 1u == (tg + 1u) * nx) xb_add(&bar[XB_TOPGEN], 1u);
            else XB_SPIN(xb_ld(&bar[XB_TOPGEN]) == tg, bar);
            __builtin_amdgcn_fence(__ATOMIC_ACQUIRE, "agent");
            xb_add(&bar[XB_XGEN(b.x)], 1u);
            asm volatile("s_waitcnt vmcnt(0)" ::: "memory");
        } else {
            XB_SPIN(xb_ld(&bar[XB_XGEN(b.x)]) == gen, bar);
            __builtin_amdgcn_fence(__ATOMIC_ACQUIRE, "agent");
            asm volatile("s_waitcnt vmcnt(0)" ::: "memory");
        }
    }
    __syncthreads();
}

constexpr int CW_BAR = 4096;
constexpr int LDS_MISC = LDS_BYTES - 64;
#ifndef PROBE_DOUBLE
#define PROBE_DOUBLE (-1)
#endif
struct Args { const float* in[31]; float* out; unsigned char* ws; int ph_lo, ph_hi, flags, pad; };
constexpr int N_PHASES = 14;
__global__ void __launch_bounds__(NTHREADS, 2) mk_fwd(Args args) {
    extern __shared__ __attribute__((aligned(16))) unsigned char lds_raw[];
    cg::grid_group grid = cg::this_grid();
    Frame F;
    F.lds = (LAS unsigned char*)lds_raw;
    F.G = gridDim.x;
    F.inp = args.in; F.out = args.out; F.flags = args.flags;
    const int lo = args.ph_lo, hi = args.ph_hi;
    if (lo < 0) grid.sync();
    volatile LAS unsigned* bst = (volatile LAS unsigned*)(F.lds + LDS_MISC);
    if (threadIdx.x < 2) bst[threadIdx.x] = 0u;
    __syncthreads();
    XcdBarrier xbar = xcd_barrier_post((unsigned*)args.ws + CW_BAR, bst, (int)threadIdx.x);
    const int wave0 = __builtin_amdgcn_readfirstlane((int)threadIdx.x >> 6);
#define MK_PHASE(k, CALL) do { if (lo <= (k) && (k) < hi) { \
        { const int ln_ = fresh_lane(); int wv_ = wave0; asm volatile("" : "+s"(wv_)); F.lane = ln_; F.wave = wv_; F.tid = wv_ * 64 + ln_; } \
        { int bx = blockIdx.x; asm volatile("" : "+s"(bx)); F.bid = bx; F.vcu = (F.G % 8 == 0) ? (bx % 8) * (F.G / 8) + bx / 8 : bx; } \
        { unsigned char* w_ = args.ws; asm volatile("" : "+s"(w_)); F.ws = w_; int z_ = 0; asm volatile("" : "+s"(z_)); F.zero = z_; } \
        CALL; if ((k) + 1 < hi) { xcd_barrier(xbar, wave0 * 64 + fresh_lane()); } } } while (0)
    MK_PHASE(0, phase_p0a(F));
    MK_PHASE(1, phase_p0b(F));
    MK_PHASE(2, phase_p1(F, 0));
    MK_PHASE(3, phase_p2a(F, 0));
    MK_PHASE(4, phase_p2b(F, 0));
    MK_PHASE(5, phase_p3(F, 0));
    MK_PHASE(6, phase_p4(F, 0));
    MK_PHASE(7, phase_p5(F, 0));
    MK_PHASE(8, phase_p1(F, 1));
    MK_PHASE(9, phase_p2a(F, 1));
    MK_PHASE(10, phase_p2b(F, 1));
    MK_PHASE(11, phase_p3(F, 1));
    MK_PHASE(12, phase_p4(F, 1));
    MK_PHASE(13, phase_p5(F, 1));
#undef MK_PHASE
}
}

static int mk_setup() {
    static int grid = 0;
    if (grid == 0) {
        int dev = 0, cus = 0, per_cu = 0;
        hipGetDevice(&dev); hipDeviceGetAttribute(&cus, hipDeviceAttributeMultiprocessorCount, dev);
        hipFuncSetAttribute((const void*)mk::mk_fwd, hipFuncAttributeMaxDynamicSharedMemorySize, mk::LDS_BYTES);
        hipOccupancyMaxActiveBlocksPerMultiprocessor(&per_cu, (const void*)mk::mk_fwd, mk::NTHREADS, mk::LDS_BYTES);
        (void)hipGetLastError();
        if (per_cu < 1) { fprintf(stderr, "mk_setup: occupancy query says %d blocks/CU\n", per_cu); per_cu = 1; }
        grid = cus;
        fprintf(stderr, "mk_setup: cus %d per_cu %d grid %d\n", cus, per_cu, grid);
    }
    return grid;
}
static void mk_run(void* const* d_in, void* d_out, void* d_ws, hipStream_t stream, int lo, int hi, bool coop, int flags = 0) {
    const int grid = mk_setup();
    mk::Args a{};
    for (int i = 0; i < 31; ++i) a.in[i] = (const float*)d_in[i];
    a.out = (float*)d_out; a.ws = (unsigned char*)d_ws; a.ph_lo = lo; a.ph_hi = hi; a.flags = flags;
    if (coop) { void* params[] = {&a}; hipError_t e = hipLaunchCooperativeKernel((const void*)mk::mk_fwd, dim3(grid), dim3(mk::NTHREADS), params, mk::LDS_BYTES, stream);
        if (e != hipSuccess) fprintf(stderr, "coop launch failed: %s\n", hipGetErrorString(e)); }
    else hipLaunchKernelGGL(mk::mk_fwd, dim3(grid), dim3(mk::NTHREADS), mk::LDS_BYTES, stream, a);
}

extern "C" void kernel_launch(void* const* d_in, const int* in_sizes, int n_in, void* d_out, int out_size, void* d_ws, size_t ws_size, hipStream_t stream) {
    if (ws_size < mk::WS_END) { fprintf(stderr, "ws too small\n"); return; }
    hipMemsetAsync(d_ws, 0, 65536, stream);
    mk_run(d_in, d_out, d_ws, stream, 0, mk::N_PHASES, true);
}
```

```cpp
#include <hip/hip_runtime.h>
#include <hip/hip_cooperative_groups.h>
#include <math.h>
#include <stdint.h>
#include <cstdio>
namespace cg = cooperative_groups;
namespace pg8 {
#define PG8_LAS __attribute__((address_space(3)))
typedef unsigned short bf16_t;
typedef short bf16x8 __attribute__((ext_vector_type(8)));
typedef float f32x4 __attribute__((ext_vector_type(4)));
typedef unsigned u32x4 __attribute__((ext_vector_type(4)));
constexpr int BM = 256, BK = 64, HALF = 128, HTB = HALF * BK * 2  , STAGE_BYTES = 8 * HTB, NXCD = 8, WGM = 8;

__host__ __device__ __forceinline__ int lds_byte(int r, int c) { const int st = (r >> 4) * 2 + (c >> 5), rr = r & 15, cc = c & 31, ob = rr * 64 + cc * 2; return st * 1024 + (ob ^ (((ob >> 9) & 1) << 5)); }
__host__ __device__ __forceinline__ void stage_rc(int b, int& R, int& C) { const int st = b / 1024, sb = b % 1024, swz = sb ^ (((sb >> 9) & 1) << 5); R = (st >> 1) * 16 + swz / 64; C = (st & 1) * 32 + (swz % 64) / 2; }
__host__ __device__ __forceinline__ int perm32(int rho) { const int n = rho >> 4, i = rho & 15; return 8 * (i >> 2) + 4 * n + (i & 3); }

struct Unit { int pm, pn; };
struct Gemm { const bf16_t* A; const bf16_t* Bt; int M, N, K; };

struct StaticOrder {
    int nM, nN, nwg, G, c;
    __host__ __device__ void init(int M, int N, int G_, int c_) { nM = M / BM; nN = N / BM; nwg = nM * nN; G = G_; c = c_; }
    __host__ __device__ bool next(int i, Unit& u) const {
        const long L = (long)i * G + c; if (L >= nwg) return false;
        int wgid = (int)L; { const int q = nwg / NXCD, r = nwg % NXCD, xcd = wgid % NXCD, off = wgid / NXCD; wgid = (xcd < r ? xcd * (q + 1) : r * (q + 1) + (xcd - r) * q) + off; }
        const int nig = WGM * nN, gid = wgid / nig, fm = gid * WGM, gsz = (nM - fm) < WGM ? (nM - fm) : WGM;
        u.pm = fm + ((wgid % nig) % gsz); u.pn = (wgid % nig) / gsz; return true;
    }
    __device__ __forceinline__ void a_ready(const Unit&) const {}
    __device__ __forceinline__ void done(const Unit&) const {}
};


template <class Epi, class Sched, bool ALIGN_EPI = false, bool SP2 = false>
__device__ __forceinline__ void gemm_phase(PG8_LAS unsigned char* lds, const Gemm g, const Sched& S, const Epi& E, const int tid) {
    const int wid = __builtin_amdgcn_readfirstlane(tid >> 6), lane = tid & 63, wr = wid >> 2, wc = wid & 3, fr = lane & 15, fq = lane >> 4;
    const int K = g.K, nt = K / BK;
    unsigned voffA[2], voffB[2];
#pragma unroll
    for (int i = 0; i < 2; ++i) { int R, C; stage_rc(tid * 16 + i * 8192, R, C); const int Rb = Epi::PERM ? ((R & ~31) + perm32(R & 31)) : R;
        voffA[i] = (unsigned)(R * K + C) * 2u; voffB[i] = (unsigned)(Rb * K + C) * 2u; }
    const size_t kstep = (size_t)(BK * 2);
    const size_t hstep = (size_t)HALF * K * 2;
    const size_t tstep = 2 * hstep;
    const unsigned ldsw = (unsigned)wid * 1024u;
    const int aoff = lds_byte(wr * 64 + fr, fq * 8), boff = lds_byte(wc * 32 + fr, fq * 8);
#define PG8_SA(b, h) (((b) * 2 + (h)) * HTB)
#define PG8_SB(b, h) ((4 + (b) * 2 + (h)) * HTB)
#define PG8_STAGE(bufoff, gbase, voff) do { _Pragma("unroll") for (int _i = 0; _i < 2; ++_i) \
        __builtin_amdgcn_global_load_lds((const unsigned*)((const char*)(gbase) + (voff)[_i]), (PG8_LAS unsigned*)(lds + (bufoff) + ldsw + _i * 8192), 16, 0, 0); } while (0)
#define PG8_LDA(dst, b, h) do { _Pragma("unroll") for (int m = 0; m < 4; ++m) _Pragma("unroll") for (int k = 0; k < 2; ++k) dst[m][k] = *(const PG8_LAS bf16x8*)(lds + PG8_SA(b, h) + aoff + m * 2048 + k * 1024); } while (0)
#define PG8_LDB(dst, b, h) do { _Pragma("unroll") for (int n = 0; n < 2; ++n) _Pragma("unroll") for (int k = 0; k < 2; ++k) dst[n][k] = *(const PG8_LAS bf16x8*)(lds + PG8_SB(b, h) + boff + n * 2048 + k * 1024); } while (0)
#define PG8_MMA(ai, bj, At, Bt) do { __builtin_amdgcn_s_setprio(1); _Pragma("unroll") for (int m = 0; m < 4; ++m) _Pragma("unroll") for (int n = 0; n < 2; ++n) _Pragma("unroll") for (int k = 0; k < 2; ++k) \
        acc[ai][bj][m][n] = __builtin_amdgcn_mfma_f32_16x16x32_bf16(Bt[n][k], At[m][k], acc[ai][bj][m][n], 0, 0, 0); __builtin_amdgcn_s_setprio(0); } while (0)
#define PG8_WAIT_V(n) asm volatile("s_waitcnt vmcnt(" #n ")" ::: "memory")
#define PG8_WAIT_L(n) asm volatile("s_waitcnt lgkmcnt(" #n ")" ::: "memory")
#define PG8_BAR __builtin_amdgcn_s_barrier()
#define PG8_SCHED __builtin_amdgcn_sched_barrier(0)
    Unit cur, nxt; int ui = 0;
    if (!S.next(0, cur)) return;
    f32x4 acc[2][2][4][2];
#pragma unroll
    for (int a = 0; a < 2; ++a)
#pragma unroll
        for (int b = 0; b < 2; ++b)
#pragma unroll
            for (int m = 0; m < 4; ++m)
#pragma unroll
                for (int n = 0; n < 2; ++n) acc[a][b][m][n] = (f32x4){0.f, 0.f, 0.f, 0.f};
    bf16x8 At[4][2], B0[2][2], B1[2][2];
    const char* cA = (const char*)g.A + (size_t)cur.pm * tstep; const char* cB = (const char*)g.Bt + (size_t)cur.pn * tstep;
    S.a_ready(cur);
    if constexpr (SP2) {
        PG8_STAGE(PG8_SB(0, 0), cB, voffB); PG8_STAGE(PG8_SB(0, 1), cB + hstep, voffB); PG8_STAGE(PG8_SA(0, 0), cA, voffA); PG8_STAGE(PG8_SA(0, 1), cA + hstep, voffA);
        if (wr == 1) PG8_BAR;
        PG8_WAIT_V(2); PG8_BAR;
        PG8_STAGE(PG8_SB(1, 0), cB + kstep, voffB); PG8_STAGE(PG8_SA(1, 0), cA + kstep, voffA); PG8_STAGE(PG8_SB(1, 1), cB + hstep + kstep, voffB);
        PG8_WAIT_V(6); PG8_BAR;
    } else {
        PG8_STAGE(PG8_SB(0, 0), cB, voffB); PG8_STAGE(PG8_SA(0, 0), cA, voffA); PG8_STAGE(PG8_SB(0, 1), cB + hstep, voffB); PG8_STAGE(PG8_SA(0, 1), cA + hstep, voffA);
        if (wr == 1) PG8_BAR;
        PG8_WAIT_V(4); PG8_BAR;
        PG8_STAGE(PG8_SB(1, 0), cB + kstep, voffB); PG8_STAGE(PG8_SA(1, 0), cA + kstep, voffA); PG8_STAGE(PG8_SB(1, 1), cB + hstep + kstep, voffB);
        PG8_WAIT_V(6); PG8_BAR;
    }
    for (;;) {
        const bool has_next = S.next(ui + 1, nxt);
        const char* nA = has_next ? (const char*)g.A + (size_t)nxt.pm * tstep : cA; const char* nB = has_next ? (const char*)g.Bt + (size_t)nxt.pn * tstep : cB;
        for (int t = 0; t < nt; t += 2) {
            const bool last = (t == nt - 2);
            const char* a1 = cA + (size_t)(t + 1) * kstep;
            const char* a2 = last ? nA : cA + (size_t)(t + 2) * kstep; const char* b2 = last ? nB : cB + (size_t)(t + 2) * kstep;
            const char* a3 = a2 + kstep; const char* b3 = b2 + kstep;
            if (last && has_next) S.a_ready(nxt);
            if constexpr (SP2) {
            PG8_LDB(B0, 0, 0); PG8_LDB(B1, 0, 1); PG8_SCHED; PG8_LDA(At, 0, 0); PG8_STAGE(PG8_SA(1, 1), a1 + hstep, voffA);
            PG8_WAIT_V(8); PG8_WAIT_L(0); PG8_BAR; PG8_MMA(0, 0, At, B0); PG8_MMA(0, 1, At, B1); PG8_BAR; PG8_SCHED;
            PG8_LDA(At, 0, 1); PG8_STAGE(PG8_SB(0, 0), b2, voffB); PG8_STAGE(PG8_SB(0, 1), b2 + hstep, voffB); PG8_STAGE(PG8_SA(0, 0), a2, voffA);
            PG8_WAIT_V(8); PG8_WAIT_L(0); PG8_BAR; PG8_MMA(1, 0, At, B0); PG8_MMA(1, 1, At, B1); PG8_BAR; PG8_SCHED;
            PG8_LDB(B0, 1, 0); PG8_LDB(B1, 1, 1); PG8_SCHED; PG8_LDA(At, 1, 0); PG8_STAGE(PG8_SA(0, 1), a2 + hstep, voffA);
            PG8_WAIT_V(8); PG8_WAIT_L(0); PG8_BAR; PG8_MMA(0, 0, At, B0); PG8_MMA(0, 1, At, B1); PG8_BAR; PG8_SCHED;
            PG8_LDA(At, 1, 1); PG8_STAGE(PG8_SB(1, 0), b3, voffB); PG8_STAGE(PG8_SB(1, 1), b3 + hstep, voffB); PG8_STAGE(PG8_SA(1, 0), a3, voffA);
            PG8_WAIT_V(8); PG8_WAIT_L(0); PG8_BAR; PG8_MMA(1, 0, At, B0); PG8_MMA(1, 1, At, B1); PG8_BAR; PG8_SCHED;
            } else {
            PG8_LDB(B0, 0, 0); PG8_SCHED; PG8_LDA(At, 0, 0); PG8_STAGE(PG8_SA(1, 1), a1 + hstep, voffA);
            PG8_WAIT_L(8); PG8_BAR; PG8_WAIT_L(0); PG8_MMA(0, 0, At, B0); PG8_BAR; PG8_SCHED;
            PG8_LDB(B1, 0, 1); PG8_STAGE(PG8_SB(0, 0), b2, voffB);
            PG8_BAR; PG8_WAIT_L(0); PG8_MMA(0, 1, At, B1); PG8_BAR;
            PG8_LDA(At, 0, 1); PG8_STAGE(PG8_SA(0, 0), a2, voffA);
            PG8_BAR; PG8_WAIT_L(0); PG8_MMA(1, 0, At, B0); PG8_BAR; PG8_SCHED;
            PG8_STAGE(PG8_SB(0, 1), b2 + hstep, voffB);
            PG8_WAIT_V(6); PG8_BAR; PG8_MMA(1, 1, At, B1); PG8_BAR;
            PG8_LDB(B0, 1, 0); PG8_SCHED; PG8_LDA(At, 1, 0); PG8_STAGE(PG8_SA(0, 1), a2 + hstep, voffA);
            PG8_WAIT_L(8); PG8_BAR; PG8_WAIT_L(0); PG8_MMA(0, 0, At, B0); PG8_BAR; PG8_SCHED;
            PG8_LDB(B1, 1, 1); PG8_STAGE(PG8_SB(1, 0), b3, voffB);
            PG8_BAR; PG8_WAIT_L(0); PG8_MMA(0, 1, At, B1); PG8_BAR;
            PG8_LDA(At, 1, 1); PG8_STAGE(PG8_SA(1, 0), a3, voffA);
            PG8_BAR; PG8_WAIT_L(0); PG8_MMA(1, 0, At, B0); PG8_BAR; PG8_SCHED;
            PG8_STAGE(PG8_SB(1, 1), b3 + hstep, voffB);
            PG8_WAIT_V(6); PG8_BAR; PG8_MMA(1, 1, At, B1); PG8_BAR;
            }
        }
        if constexpr (ALIGN_EPI) { if (wr == 0) PG8_BAR; }
        if constexpr (!Epi::AFTER_DRAIN) { E(acc, cur, wr, wc, fr, fq); S.done(cur); }
        if (!has_next) break;
#pragma unroll
        for (int a = 0; a < 2; ++a)
#pragma unroll
            for (int b = 0; b < 2; ++b)
#pragma unroll
                for (int m = 0; m < 4; ++m)
#pragma unroll
                    for (int n = 0; n < 2; ++n) acc[a][b][m][n] = (f32x4){0.f, 0.f, 0.f, 0.f};
        cur = nxt; cA = nA; cB = nB; ++ui;
        if constexpr (ALIGN_EPI) { if (wr == 1) PG8_BAR; }
    }
    PG8_WAIT_V(0);
    if constexpr (!ALIGN_EPI) { if (wr == 0) PG8_BAR; }
    PG8_BAR;
    if constexpr (Epi::AFTER_DRAIN) { E.fused(acc, cur, wr, wc, fr, fq, lds, wid, lane); S.done(cur); }
#undef PG8_SA
#undef PG8_SB
#undef PG8_STAGE
#undef PG8_LDA
#undef PG8_LDB
#undef PG8_MMA
#undef PG8_WAIT_V
#undef PG8_WAIT_L
#undef PG8_BAR
#undef PG8_SCHED
}
}

#ifndef PG8_SP2
#define PG8_SP2 true
#endif

namespace mk {
using pg8::bf16_t; using pg8::f32x4; using pg8::Unit;
#define LAS __attribute__((address_space(3)))
typedef unsigned u32x2 __attribute__((ext_vector_type(2)));
typedef unsigned u32x4 __attribute__((ext_vector_type(4)));
constexpr int D = 1024, NB = 8, T = 4096, C = 256, RB = C + T, MALL = NB * RB, NTILE = MALL / 256, TPB = RB / 256  ;
constexpr int DIN = 2176, DINP = 2304, DMIX = 1024, DFF = 2816, NMOD = 6, LW = 384;
constexpr float EPS = 1e-6f, LOG2E = 1.4426950408889634f;
constexpr float QSA = 0.17677669529663687f * LOG2E, QSB = 0.125f * LOG2E;
constexpr int O_AQ = 0, O_AK = 256, O_AV = 512, O_BQ = 768, O_BK = 1152, O_BV = 1280, O_CX = 1408, O_CG = 1792;
constexpr int NWAVES = 8, NTHREADS = 512;
constexpr size_t MiB = 1u << 20;
constexpr size_t WS_CTL = 0;
constexpr size_t WS_WIN = 1 * MiB;
constexpr size_t WS_WOUT = 10 * MiB;
constexpr size_t WS_WUP = 14 * MiB;
constexpr size_t WS_WDN = 36 * MiB;
constexpr size_t WS_MOD = 47 * MiB;
constexpr size_t WS_BIAS1 = WS_MOD + 512 * 1024;
constexpr size_t WS_BIAS2 = WS_BIAS1 + 256 * 1024;
constexpr size_t WS_TAB = WS_BIAS2 + 512 * 1024;
constexpr size_t WS_TAB64 = WS_TAB + 4096, WS_PAR = WS_TAB64 + 8192;
constexpr int PAR_STRIDE = 512, PR_GQ32 = 0, PR_GK32 = 32, PR_GQ64 = 64, PR_GK64 = 128, PR_SUBG = 192, PR_SINK = 256, PR_LAM = 272, PR_MA = 273, PR_MB = 274, PR_LI = 275;
constexpr size_t WS_GAIN = WS_PAR + 8192;
constexpr size_t WS_FFNP = WS_GAIN + 16384;
constexpr size_t WS_LRUP = WS_FFNP + 96 * 1024;
constexpr size_t WS_LRUW = WS_LRUP + 32 * 1024;
constexpr size_t WS_VNM = WS_LRUW + 512 * 1024;
constexpr size_t WS_SS1 = 50 * MiB;
constexpr size_t WS_SS2 = WS_SS1 + 1 * MiB;
constexpr size_t WS_LRU = 55 * MiB;
constexpr size_t WS_XC = 56 * MiB;
constexpr size_t WS_SIDE = 64 * MiB;
constexpr size_t WS_VN = 73 * MiB;
constexpr size_t WS_P = 141 * MiB;
constexpr size_t WS_Y = 362 * MiB;
constexpr size_t WS_U = WS_P;
constexpr size_t WS_XB = 430 * MiB;
constexpr size_t WS_UC = 498 * MiB;
constexpr size_t WS_LG0 = 294 * MiB;
constexpr size_t WS_LG1 = WS_VN;
constexpr size_t WS_DEP = 32768;
constexpr size_t WS_END = 510 * MiB;
static_assert(WS_P + (size_t)MALL * DINP * 2 <= WS_LG0 && WS_LG0 + 48 * MiB <= WS_Y && WS_LG1 + 48 * MiB <= WS_P, "gate cache map");
static_assert(WS_FFNP + 2 * 4 * DFF * 4 <= WS_LRUP && WS_LRUW + 2 * 2 * 6 * 128 * 64 * 2 <= WS_VNM && WS_VNM + 3 * 9 * 1024 * 4 <= WS_SS1 && WS_SS2 + (size_t)MALL * 64 <= WS_LRU && WS_SIDE + (size_t)NTILE * 6 * DFF * 4 <= WS_VN && WS_U + (size_t)MALL * DFF * 2 <= WS_Y && WS_P + (size_t)MALL * DINP * 2 <= WS_Y && WS_XB + (size_t)MALL * D * 2 <= WS_UC && WS_UC + (size_t)NB * 256 * DFF * 2 <= WS_END && WS_Y + (size_t)MALL * D * 2 <= WS_XB && WS_VN + (size_t)MALL * D * 2 <= WS_P, "ws map");
constexpr int LDS_BYTES = 163840;
constexpr int LDS_EX = 131072, LDS_RED = LDS_EX + 4096, LDS_TAB32 = LDS_EX + 12288, LDS_TAB64 = LDS_EX + 16384;

__device__ __forceinline__ unsigned f2bf(float f) { unsigned u = __builtin_bit_cast(unsigned, f); return (u + 0x7fffu + ((u >> 16) & 1u)) >> 16; }
__device__ __forceinline__ unsigned pk2(float lo, float hi) { return f2bf(lo) | (f2bf(hi) << 16); }
__device__ __forceinline__ float bf2f(unsigned short h) { return __builtin_bit_cast(float, (unsigned)h << 16); }
__device__ __forceinline__ float sigmoidf_(float x) { return 1.f / (1.f + __expf(-x)); }
__device__ __forceinline__ float siluf_(float x) { return x * sigmoidf_(x); }
#define LDS_WAIT() asm volatile("s_waitcnt lgkmcnt(0)" ::: "memory")
#define GAS __attribute__((address_space(1)))
typedef float f32x2_t __attribute__((ext_vector_type(2))); typedef __bf16 bf16x2_t __attribute__((ext_vector_type(2)));
__device__ __forceinline__ unsigned cvtpk(float lo, float hi) { f32x2_t v = {lo, hi}; bf16x2_t b = __builtin_convertvector(v, bf16x2_t); return __builtin_bit_cast(unsigned, b); }
__device__ __forceinline__ f32x4 ldg4(const float* p) { return *(const GAS f32x4*)p; }
__device__ __forceinline__ void stg4(float* p, f32x4 v) { *(GAS f32x4*)p = v; }
__device__ __forceinline__ void stg2u(bf16_t* p, f32x4 v) { u32x2 o; o.x = cvtpk(v[0], v[1]); o.y = cvtpk(v[2], v[3]); *(GAS u32x2*)p = o; }
__device__ __forceinline__ int fresh_lane() { unsigned z = 0u; asm volatile("" : "+v"(z)); return (int)__builtin_amdgcn_mbcnt_hi(~0u, __builtin_amdgcn_mbcnt_lo(~0u, z)); }

struct Frame {
    LAS unsigned char* lds;
    int tid, lane, wave, vcu, G, bid, flags;
    const float* const* inp; int zero; float* out; unsigned char* ws;
    __device__ __forceinline__ const float* in_(int k) const { return inp[k + zero]; }
};

__device__ __forceinline__ int map_in(int n) {
    const int tile = n >> 8, lc = n & 255;
    if (tile <= 1) { const int s = lc >> 5, bj = (lc >> 4) & 1, q = lc & 15; return (tile << 8) + 128 * bj + 16 * s + q; }
    if (tile == 3 || tile == 4) { const int z = lc >> 6, bj = (lc >> 5) & 1, q = lc & 31; return (tile << 8) + 128 * bj + 32 * z + q; }
    return n;
}
__device__ __forceinline__ int map_up(int n) { if (n < DFF) return 256 * (n >> 7) + (n & 127); const int c = n - DFF; return 256 * (c >> 7) + 128 + (c & 127); }

template <int MAP> __device__ __forceinline__ void transpose_item(const float* __restrict__ W, int K, int N, bf16_t* __restrict__ WT, LAS float* scr, int item, int lane) {
    const int nblk = N / 32, kb = item / nblk, nb = item % nblk, k0 = 64 * kb, n0 = 32 * nb;
    { const int r8 = lane >> 3, c4 = (lane & 7) * 4;
#pragma unroll
      for (int i = 0; i < 8; ++i) { const int kk = 8 * i + r8; const f32x4 v = *(const f32x4*)(W + (size_t)(k0 + kk) * N + n0 + c4);
          LAS float* d = scr + kk * 33 + c4; d[0] = v[0]; d[1] = v[1]; d[2] = v[2]; d[3] = v[3]; } }
    LDS_WAIT(); asm volatile("" ::: "memory");
    const int c = lane & 7;
#pragma unroll
    for (int j = 0; j < 4; ++j) { const int n = (lane >> 3) + 8 * j; const LAS float* s = scr + (8 * c) * 33 + n;
        u32x4 o; o.x = pk2(s[0 * 33], s[1 * 33]); o.y = pk2(s[2 * 33], s[3 * 33]); o.z = pk2(s[4 * 33], s[5 * 33]); o.w = pk2(s[6 * 33], s[7 * 33]);
        const int nl = n0 + n; const int row = MAP == 1 ? map_in(nl) : (MAP == 2 ? map_up(nl) : nl);
        *(u32x4*)(WT + (size_t)row * K + k0 + 8 * c) = o; }
    LDS_WAIT(); asm volatile("" ::: "memory");
}

__device__ __forceinline__ void gemv9_item(Frame& F, LAS float* vecs, LAS float* red, const float* __restrict__ W, int ldw, int n0, float* __restrict__ out, int ldo, const float* __restrict__ addb) {
    float acc[9];
#pragma unroll
    for (int v = 0; v < 9; ++v) acc[v] = 0.f;
    const int kb = F.wave * 128;
#pragma unroll 4
    for (int k = 0; k < 128; k += 16) {
        float w[16];
#pragma unroll
        for (int i = 0; i < 16; ++i) w[i] = W[(size_t)(kb + k + i) * ldw + n0 + F.lane];
#pragma unroll
        for (int q = 0; q < 4; ++q) {
#pragma unroll
            for (int v = 0; v < 9; ++v) { const f32x4 x = *(const LAS f32x4*)(vecs + v * 1024 + kb + k + 4 * q); acc[v] += x[0] * w[4 * q] + x[1] * w[4 * q + 1] + x[2] * w[4 * q + 2] + x[3] * w[4 * q + 3]; }
        }
    }
#pragma unroll
    for (int v = 0; v < 9; ++v) red[(F.wave * 9 + v) * 64 + F.lane] = acc[v];
    __syncthreads();
    for (int e = F.tid; e < 9 * 64; e += NTHREADS) { const int v = e >> 6, ln = e & 63; float s = 0.f;
#pragma unroll
        for (int w8 = 0; w8 < 8; ++w8) s += red[(w8 * 9 + v) * 64 + ln];
        out[(size_t)v * ldo + n0 + ln] = s + (addb ? addb[n0 + ln] : 0.f); }
    __syncthreads();
}

__device__ const float INVF16[16] = {1.000000000e+00f, 5.623413324e-01f, 3.162277639e-01f, 1.778279394e-01f, 1.000000015e-01f, 5.623413250e-02f, 3.162277490e-02f, 1.778279431e-02f,
                                     9.999999776e-03f, 5.623413250e-03f, 3.162277630e-03f, 1.778279431e-03f, 1.000000047e-03f, 5.623413017e-04f, 3.162277571e-04f, 1.778279402e-04f};
__device__ __forceinline__ void phase_p0a(Frame& F) {
    const float* w_in = F.in_(8); const float* w_out = F.in_(26); const float* w_up = F.in_(27); const float* w_down = F.in_(30);
    bf16_t* WIN = (bf16_t*)(F.ws + WS_WIN); bf16_t* WOUT = (bf16_t*)(F.ws + WS_WOUT); bf16_t* WUP = (bf16_t*)(F.ws + WS_WUP); bf16_t* WDN = (bf16_t*)(F.ws + WS_WDN);
    LAS float* scr = (LAS float*)(F.lds + F.wave * 16384);
    const int gw = F.vcu * NWAVES + F.wave, NGW = F.G * NWAVES;
    constexpr int I_IN = 16 * (DIN / 32), I_OUT = 16 * 32, I_UP = 16 * (2 * DFF / 32), I_DN = (DFF / 64) * 32, I_L = I_IN + I_OUT + I_UP + I_DN;
    for (int it = gw; it < 2 * I_L; it += NGW) {
        const int l = it / I_L; int r = it % I_L;
        if (r < I_IN) { transpose_item<1>(w_in + (size_t)l * D * DIN, D, DIN, WIN + (size_t)l * DINP * D, scr, r, F.lane); continue; } r -= I_IN;
        if (r < I_OUT) { transpose_item<0>(w_out + (size_t)l * DMIX * D, DMIX, D, WOUT + (size_t)l * D * DMIX, scr, r, F.lane); continue; } r -= I_OUT;
        if (r < I_UP) { transpose_item<2>(w_up + (size_t)l * D * 2 * DFF, D, 2 * DFF, WUP + (size_t)l * 2 * DFF * D, scr, r, F.lane); continue; } r -= I_UP;
        transpose_item<0>(w_down + (size_t)l * DFF * D, DFF, D, WDN + (size_t)l * D * DFF, scr, r, F.lane);
    }
    { const int gt = F.vcu * NTHREADS + F.tid, NGT = F.G * NTHREADS; bf16_t* LW_ = (bf16_t*)(F.ws + WS_LRUW);
      for (int e = gt; e < 2 * 2 * 6 * 128 * 64; e += NGT) { const int i = e & 63, o = (e >> 6) & 127, blk = e >> 13;
          LW_[e] = (bf16_t)f2bf((o < 64 ? F.in_(21) : F.in_(23))[(size_t)blk * 4096 + i * 64 + (o & 63)]); } }
    { const int gt = F.vcu * NTHREADS + F.tid, NGT = F.G * NTHREADS; constexpr int PER = (DINP - DIN) * D * 2 / 16;
      for (int e = gt; e < 2 * PER; e += NGT) { const int l = e / PER, o = e % PER; *(u32x4*)((unsigned char*)(WIN + ((size_t)l * DINP + DIN) * D) + (size_t)o * 16) = (u32x4){0u, 0u, 0u, 0u}; } }
    __syncthreads();
    LAS float* vecs = (LAS float*)F.lds; LAS float* red = vecs + 9 * 1024;
    const float* cvec = F.in_(1); const float* cctx = F.in_(3); const float* w_mod = F.in_(4); const float* b_mod = F.in_(5);
    float* MOD = (float*)(F.ws + WS_MOD);
    bool staged = false;
    for (int item = F.bid; item < 2 * 96; item += F.G) {
        if (!staged) { for (int e = F.tid; e < 9 * 1024; e += NTHREADS) { const int v = e >> 10, k = e & 1023; vecs[e] = siluf_(v < 8 ? cvec[v * D + k] : cctx[k]); } __syncthreads(); staged = true; }
        const int l = item / 96, n0 = (item % 96) * 64;
        gemv9_item(F, vecs, red, w_mod + (size_t)l * D * NMOD * D, NMOD * D, n0, MOD + (size_t)l * 9 * NMOD * D, NMOD * D, b_mod + (size_t)l * NMOD * D);
    }
    if (F.bid == F.G - 1) {
        float* tab32 = (float*)(F.ws + WS_TAB); float* tab64 = (float*)(F.ws + WS_TAB64);
        for (int idx = F.tid; idx < 64 * 8 + 64 * 16; idx += NTHREADS) {
            int quarter, pos, fi; float* dst;
            if (idx < 64 * 8) { quarter = 8; pos = idx / 8; fi = idx % 8; dst = tab32 + idx * 2; }
            else { const int j = idx - 64 * 8; quarter = 16; pos = j / 16; fi = j % 16; dst = tab64 + j * 2; }
            const float invf = INVF16[fi * (16 / quarter)];
            const float x = (float)pos * invf;
            const float kf = rintf(x * 0.636619772f); const int kq = (int)kf;
            float r = fmaf(-kf, 1.5703125f, x); r = fmaf(-kf, 4.837512969970703125e-4f, r); r = fmaf(-kf, 7.54978995489188216e-8f, r);
            const float r2 = r * r;
            const float sp = r + r * r2 * (-1.6666654611e-1f + r2 * (8.3321608736e-3f + r2 * (-1.9515295891e-4f)));
            const float cp = 1.0f - 0.5f * r2 + r2 * r2 * (4.166664568298827e-2f + r2 * (-1.388731625493765e-3f + r2 * 2.443315711809948e-5f));
            const int qd = kq & 3;
            const float sv = qd == 0 ? sp : (qd == 1 ? cp : (qd == 2 ? -sp : -cp)), cv = qd == 0 ? cp : (qd == 1 ? -sp : (qd == 2 ? -cp : sp));
            dst[0] = cv; dst[1] = sv;
        }
        float* par = (float*)(F.ws + WS_PAR);
        for (int e = F.tid; e < 2 * 262; e += NTHREADS) { const int l = e / 262, i = e % 262; float v;
            if (i < 32) v = F.in_(9)[l * 32 + i]; else if (i < 64) v = F.in_(10)[l * 32 + i - 32]; else if (i < 128) v = F.in_(16)[l * 64 + i - 64]; else if (i < 192) v = F.in_(17)[l * 64 + i - 128];
            else if (i < 256) v = F.in_(15)[l * 64 + i - 192]; else v = F.in_(18)[l * 6 + i - 256];
            par[l * PAR_STRIDE + i] = v; }
        { float* gn = (float*)(F.ws + WS_GAIN); for (int e = F.tid; e < 4 * D; e += NTHREADS) gn[e] = e < 2 * D ? F.in_(6)[e] : F.in_(7)[e - 2 * D];
          float* fp = (float*)(F.ws + WS_FFNP); for (int e = F.tid; e < 2 * 4 * DFF; e += NTHREADS) { const int l = e / (4 * DFF), i = e % (4 * DFF); fp[e] = i < 3 * DFF ? F.in_(28)[(size_t)l * 3 * DFF + i] : F.in_(29)[(size_t)l * DFF + i - 3 * DFF]; } }
        { float* lp = (float*)(F.ws + WS_LRUP);
          for (int e = F.tid; e < 2 * 2 * LW; e += NTHREADS) { const int ld = e / LW, ch = e % LW;
              lp[(ld * 4 + 0) * LW + ch] = F.in_(22)[e]; lp[(ld * 4 + 1) * LW + ch] = F.in_(24)[e];
              const float lam = F.in_(25)[e]; const float sp = lam > 0.f ? log1pf(expf(-lam)) : -lam + log1pf(expf(lam));
              lp[(ld * 4 + 2) * LW + ch] = 8.0f * LOG2E * sp; lp[(ld * 4 + 3) * LW + ch] = F.in_(20)[e]; } }
        if (F.tid < 2) {
            const int l = F.tid; const float li = 0.8f - 0.6f * expf(-0.3f * (float)l);
            const float* lq1 = F.in_(11) + l * 32; const float* lk1 = F.in_(12) + l * 32; const float* lq2 = F.in_(13) + l * 32; const float* lk2 = F.in_(14) + l * 32;
            float s1 = 0.f, s2 = 0.f; for (int i = 0; i < 32; ++i) { s1 += lq1[i] * lk1[i]; s2 += lq2[i] * lk2[i]; }
            float mq = 0.f, mk_ = 0.f; for (int i = 0; i < 32; ++i) { mq = fmaxf(mq, fabsf(F.in_(9)[l * 32 + i])); mk_ = fmaxf(mk_, fabsf(F.in_(10)[l * 32 + i])); }
            float nq = 0.f, nk = 0.f; for (int i = 0; i < 64; ++i) { nq = fmaxf(nq, fabsf(F.in_(16)[l * 64 + i])); nk = fmaxf(nk, fabsf(F.in_(17)[l * 64 + i])); }
            float mb = QSB * 64.f * nq * nk; for (int i = 0; i < 6; ++i) mb = fmaxf(mb, F.in_(18)[l * 6 + i] * LOG2E);
            par[l * PAR_STRIDE + PR_LAM] = expf(s1) - expf(s2) + li; par[l * PAR_STRIDE + PR_MA] = QSA * 32.f * mq * mk_; par[l * PAR_STRIDE + PR_MB] = mb; par[l * PAR_STRIDE + PR_LI] = li;
        }
    }
}

__device__ __forceinline__ void phase_p0b(Frame& F) {
    LAS float* vecs = (LAS float*)F.lds; LAS float* red = vecs + 9 * 1024;
    const float* MOD = (const float*)(F.ws + WS_MOD); float* B1 = (float*)(F.ws + WS_BIAS1); float* B2 = (float*)(F.ws + WS_BIAS2);
    const float* w_in = F.in_(8); const float* w_up = F.in_(27);
    constexpr int I1 = DIN / 64, I2 = 2 * DFF / 64, IL = I1 + I2;
    for (int item = F.bid; item < 2 * IL; item += F.G) {
        const int l = item / IL; int r = item % IL; const bool is1 = r < I1; if (!is1) r -= I1;
        __syncthreads();
        for (int e = F.tid; e < 9 * 1024; e += NTHREADS) { const int v = e >> 10, k = e & 1023; vecs[e] = MOD[((size_t)l * 9 + v) * NMOD * D + (is1 ? 0 : 3) * D + k]; }
        __syncthreads();
        if (is1) gemv9_item(F, vecs, red, w_in + (size_t)l * D * DIN, DIN, r * 64, B1 + (size_t)l * 9 * DINP, DINP, nullptr);
        else gemv9_item(F, vecs, red, w_up + (size_t)l * D * 2 * DFF, 2 * DFF, r * 64, B2 + (size_t)l * 9 * 2 * DFF, 2 * DFF, nullptr);
    }
    { const int gt = F.vcu * NTHREADS + F.tid, NGT = F.G * NTHREADS; float* VNM = (float*)(F.ws + WS_VNM);
      for (int e = gt; e < 3 * 9 * D; e += NGT) { const int n = e % D, v = (e / D) % 9, k = e / (9 * D); const int l = k == 2 ? 1 : k;
          const float gn = k == 2 ? F.in_(6)[D + n] : F.in_(7)[l * D + n]; const float sc = MOD[((size_t)l * 9 + v) * NMOD * D + (k == 2 ? 1 : 4) * D + n];
          VNM[e] = gn * (1.0f + sc); } }
    { const int gt = F.vcu * NTHREADS + F.tid; if (gt < 2 * 9 * (DINP - DIN)) { const int lv = gt / (DINP - DIN), n = gt % (DINP - DIN); B1[(size_t)lv * DINP + DIN + n] = 0.f; } }
    const float* x = F.in_(0); const float* ctx = F.in_(2); const float* g1 = F.in_(6);
    bf16_t* VN = (bf16_t*)(F.ws + WS_VN); float* SS1 = (float*)(F.ws + WS_SS1);
    const int gw = F.vcu * NWAVES + F.wave, NGW = F.G * NWAVES;
    auto vn_src = [&](int g) -> const float* { const int b = g / RB, r = g % RB; return r < C ? ctx + ((size_t)b * C + r) * D : x + ((size_t)b * T + (r - C)) * D; };
    auto vn_row = [&](int g, const f32x4 (&xr)[4]) { const int b = g / RB, r = g % RB; const int v = r < C ? 8 : b;
        const float* sc = MOD + ((size_t)0 * 9 + v) * NMOD * D + 1 * D;
        float s = 0.f;
#pragma unroll
        for (int j = 0; j < 4; ++j) { const int n = 4 * F.lane + 256 * j; const f32x4 xv = xr[j]; const f32x4 gv = *(const f32x4*)(g1 + n); const f32x4 sv = *(const f32x4*)(sc + n);
            s += xv[0] * xv[0] + xv[1] * xv[1] + xv[2] * xv[2] + xv[3] * xv[3];
            u32x2 o; o.x = pk2(xv[0] * gv[0] * (1.f + sv[0]), xv[1] * gv[1] * (1.f + sv[1])); o.y = pk2(xv[2] * gv[2] * (1.f + sv[2]), xv[3] * gv[3] * (1.f + sv[3]));
            *(u32x2*)(VN + (size_t)g * D + n) = o; }
#pragma unroll
        for (int o = 1; o < 64; o <<= 1) s += __shfl_xor(s, o);
        if (F.lane == 0) *(f32x4*)(SS1 + (size_t)g * 4) = (f32x4){s, 0.f, 0.f, 0.f}; };
    for (int g = gw; g < MALL; g += 2 * NGW) {
        const int g2 = g + NGW; const bool two = g2 < MALL;
        const float* sa = vn_src(g); const float* sb = vn_src(two ? g2 : g);
        f32x4 xa[4], xb[4];
#pragma unroll
        for (int j = 0; j < 4; ++j) xa[j] = *(const f32x4*)(sa + 4 * F.lane + 256 * j);
#pragma unroll
        for (int j = 0; j < 4; ++j) xb[j] = *(const f32x4*)(sb + 4 * F.lane + 256 * j);
        vn_row(g, xa);
        if (two) vn_row(g2, xb);
    }
}

constexpr bool SPLIT_CTX = true;
struct Order {
    int nN, R, latent_only, k, nx, per, x, base, maxi;
    pg8::StaticOrder so; bool generic;
    __device__ __forceinline__ void init(int nMt, int N, int G, int c, int lat) {
        nN = N / 256; latent_only = lat; generic = (G != 256); base = 0; maxi = 1 << 30;
        if (generic) { so.init(nMt * 256, N, G, c); return; }
        x = c & 7; k = c >> 3; nx = 32; R = lat ? 16 : TPB; per = R * nN;
    }
    __device__ __forceinline__ bool next(int i, Unit& u) const {
        if (generic) { if (!so.next(i, u)) return false; if (latent_only) u.pm = (u.pm >> 4) * TPB + 1 + (u.pm & 15); return true; }
        if (i >= maxi) return false;
        const int lu = base + i * nx + k; if (lu >= per) return false;
        constexpr int RG = 4; const int nig = RG * nN, gid = lu / nig, fm = gid * RG, gsz = (R - fm) < RG ? (R - fm) : RG;
        const int rt = fm + (lu % nig) % gsz; u.pn = (lu % nig) / gsz;
        u.pm = x * TPB + (latent_only ? 1 + rt : rt); return true;
    }
    __device__ __forceinline__ void set_sub(int na, int ra) { if (k < na) { nx = na; maxi = ra; } else { base = na * ra; k -= na; nx = 32 - na; } }
    __device__ __forceinline__ void a_ready(const Unit&) const {}
    __device__ __forceinline__ void done(const Unit&) const {}
};
struct CtxOrder {
    int pm, pn, have;
    __device__ __forceinline__ void init(int x, int pn_, int nN) { pm = x * TPB; pn = pn_; have = (pn_ >= 0 && pn_ < nN) ? 1 : 0; }
    __device__ __forceinline__ bool next(int i, Unit& u) const { if (i != 0 || !have) return false; u.pm = pm; u.pn = pn; return true; }
    __device__ __forceinline__ void a_ready(const Unit&) const {}
    __device__ __forceinline__ void done(const Unit&) const {}
};
__device__ __forceinline__ void dep_signal(Frame& F, int idx) {
    asm volatile("s_waitcnt vmcnt(0)" ::: "memory"); __syncthreads();
    if (F.wave == 0 && fresh_lane() == 0) { __builtin_amdgcn_fence(__ATOMIC_RELEASE, "agent"); asm volatile("s_waitcnt vmcnt(0)" ::: "memory");
        __hip_atomic_fetch_add((unsigned*)(F.ws + WS_DEP) + 16 * idx, 1u, __ATOMIC_RELAXED, __HIP_MEMORY_SCOPE_AGENT); }
}
__device__ __forceinline__ void dep_wait(Frame& F, int idx, unsigned need) {
    if (F.wave == 0 && fresh_lane() == 0) { unsigned* p = (unsigned*)(F.ws + WS_DEP) + 16 * idx; unsigned sp = 0;
        while (__hip_atomic_load(p, __ATOMIC_RELAXED, __HIP_MEMORY_SCOPE_AGENT) < need) { __builtin_amdgcn_s_sleep(2); if (++sp > (1u << 22)) break; } }
    __syncthreads();
    __builtin_amdgcn_fence(__ATOMIC_ACQUIRE, "agent"); asm volatile("s_waitcnt vmcnt(0)" ::: "memory");
}

struct EpiIn {
    static constexpr bool PERM = true, AFTER_DRAIN = false;
    unsigned char* ws; LAS unsigned char* lds; int l; int skip;
    __device__ __forceinline__ void operator()(const f32x4 (&acc)[2][2][4][2], const Unit& u, int wr, int wc, int fr, int fq) const {
        if (skip) return;
        { const int ln = fresh_lane(); fr = ln & 15; fq = ln >> 4; }
        bf16_t* P = (bf16_t*)(ws + WS_P); const float* SS = (const float*)(ws + WS_SS1); const float* bias = (const float*)(ws + WS_BIAS1) + (size_t)l * 9 * DINP;
        const LAS float* tab32 = (const LAS float*)(lds + LDS_TAB32); const LAS float* tab64 = (const LAS float*)(lds + LDS_TAB64); const float* par = (const float*)(ws + WS_PAR) + l * PAR_STRIDE;
        const int b = u.pm / TPB, j = u.pm % TPB; const bool lat = j != 0; const float* bia = bias + (size_t)(lat ? b : 8) * DINP;
        const int pn = u.pn;
        float rsv[2][4];
        { f32x4 s4[2][4];
#pragma unroll
          for (int ai = 0; ai < 2; ++ai)
#pragma unroll
              for (int m = 0; m < 4; ++m) s4[ai][m] = ldg4(SS + ((size_t)u.pm * 256 + ai * 128 + wr * 64 + m * 16 + fr) * 4);
#pragma unroll
          for (int ai = 0; ai < 2; ++ai)
#pragma unroll
              for (int m = 0; m < 4; ++m) rsv[ai][m] = __builtin_amdgcn_rsqf((s4[ai][m][0] + s4[ai][m][1] + s4[ai][m][2] + s4[ai][m][3]) * (1.0f / D) + EPS); }
        const int tb4 = (j - 1) * 4 + wr;
        if (pn <= 1) {
            const float* gain = par + (pn == 0 ? PR_GQ32 : PR_GK32);
            const int dq = 8 * (fq & 1); const int col0 = 256 * pn + 32 * (2 * wc + (fq >> 1)) + dq;
            f32x4 g1[2], g2[2], b1[2], b2[2];
#pragma unroll
            for (int n = 0; n < 2; ++n) { g1[n] = ldg4(gain + dq + 4 * n); g2[n] = ldg4(gain + 16 + dq + 4 * n); b1[n] = ldg4(bia + col0 + 4 * n); b2[n] = ldg4(bia + col0 + 16 + 4 * n); }
            const float qs = pn == 0 ? QSA : 1.0f;
#pragma unroll
            for (int ai = 0; ai < 2; ++ai)
#pragma unroll
                for (int m = 0; m < 4; ++m) {
                    const int rloc = ai * 128 + wr * 64 + m * 16 + fr; bf16_t* prow_p = P + ((size_t)u.pm * 256 + rloc) * DINP; const float rs = rsv[ai][m];
                    f32x4 x1[2], x2[2]; float ss = 0.f;
#pragma unroll
                    for (int n = 0; n < 2; ++n) { x1[n] = acc[ai][0][m][n] * rs + b1[n]; x2[n] = acc[ai][1][m][n] * rs + b2[n];
                        ss += x1[n][0] * x1[n][0] + x1[n][1] * x1[n][1] + x1[n][2] * x1[n][2] + x1[n][3] * x1[n][3] + x2[n][0] * x2[n][0] + x2[n][1] * x2[n][1] + x2[n][2] * x2[n][2] + x2[n][3] * x2[n][3]; }
                    ss += __shfl_xor(ss, 16);
                    const float ri = __builtin_amdgcn_rsqf(ss * (1.0f / 32.f) + EPS) * qs;
                    const int pos = (fq & 1) ? 16 * m + fr : tb4 + 2 * ai;
#pragma unroll
                    for (int n = 0; n < 2; ++n) {
                        f32x4 y1 = x1[n] * ri * g1[n], y2 = x2[n] * ri * g2[n];
                        if (lat) { const LAS float* tb = tab32 + (pos * 8 + 4 * n) * 2; const f32x4 c01 = *(const LAS f32x4*)(tb), c23 = *(const LAS f32x4*)(tb + 4);
                            const f32x4 cs = (f32x4){c01[0], c01[2], c23[0], c23[2]}, sn = (f32x4){c01[1], c01[3], c23[1], c23[3]};
                            const f32x4 z1 = y1 * cs - y2 * sn, z2 = y1 * sn + y2 * cs; y1 = z1; y2 = z2; }
                        x1[n] = y1; x2[n] = y2;
                    }
                    u32x4 o1, o2; o1.x = cvtpk(x1[0][0], x1[0][1]); o1.y = cvtpk(x1[0][2], x1[0][3]); o1.z = cvtpk(x1[1][0], x1[1][1]); o1.w = cvtpk(x1[1][2], x1[1][3]);
                    o2.x = cvtpk(x2[0][0], x2[0][1]); o2.y = cvtpk(x2[0][2], x2[0][3]); o2.z = cvtpk(x2[1][0], x2[1][1]); o2.w = cvtpk(x2[1][2], x2[1][3]);
                    *(GAS u32x4*)(prow_p + col0) = o1; *(GAS u32x4*)(prow_p + col0 + 16) = o2;
                }
        } else if (pn == 3 || pn == 4) {
            const bool isq = pn == 3 || wc < 2; const float* gain = par + (isq ? PR_GQ64 : PR_GK64);
            const int colb = 256 * pn + 64 * wc + 8 * fq;
            f32x4 ga[2], gb[2], ba[2], bb[2];
#pragma unroll
            for (int n = 0; n < 2; ++n) { ga[n] = ldg4(gain + 8 * fq + 4 * n); gb[n] = ldg4(gain + 32 + 8 * fq + 4 * n); ba[n] = ldg4(bia + colb + 4 * n); bb[n] = ldg4(bia + colb + 32 + 4 * n); }
            const float qs = isq ? QSB : 1.0f;
#pragma unroll
            for (int ai = 0; ai < 2; ++ai)
#pragma unroll
                for (int m = 0; m < 4; ++m) {
                    const int rloc = ai * 128 + wr * 64 + m * 16 + fr; bf16_t* prow_p = P + ((size_t)u.pm * 256 + rloc) * DINP; const float rs = rsv[ai][m];
                    f32x4 xa[2], xb[2]; float ss = 0.f;
#pragma unroll
                    for (int n = 0; n < 2; ++n) { xa[n] = acc[ai][0][m][n] * rs + ba[n]; xb[n] = acc[ai][1][m][n] * rs + bb[n];
                        ss += xa[n][0] * xa[n][0] + xa[n][1] * xa[n][1] + xa[n][2] * xa[n][2] + xa[n][3] * xa[n][3] + xb[n][0] * xb[n][0] + xb[n][1] * xb[n][1] + xb[n][2] * xb[n][2] + xb[n][3] * xb[n][3]; }
                    ss += __shfl_xor(ss, 16); ss += __shfl_xor(ss, 32);
                    const float ri = __builtin_amdgcn_rsqf(ss * (1.0f / 64.f) + EPS) * qs;
                    const int pos = fq < 2 ? tb4 + 2 * ai : 16 * m + fr;
#pragma unroll
                    for (int n = 0; n < 2; ++n) {
                        f32x4 y1 = xa[n] * ri * ga[n], y2 = xb[n] * ri * gb[n];
                        if (lat) { const LAS float* tb = tab64 + (pos * 16 + 8 * (fq & 1) + 4 * n) * 2; const f32x4 c01 = *(const LAS f32x4*)(tb), c23 = *(const LAS f32x4*)(tb + 4);
                            const f32x4 cs = (f32x4){c01[0], c01[2], c23[0], c23[2]}, sn = (f32x4){c01[1], c01[3], c23[1], c23[3]};
                            const f32x4 z1 = y1 * cs - y2 * sn, z2 = y1 * sn + y2 * cs; y1 = z1; y2 = z2; }
                        xa[n] = y1; xb[n] = y2;
                    }
                    u32x4 o1, o2; o1.x = cvtpk(xa[0][0], xa[0][1]); o1.y = cvtpk(xa[0][2], xa[0][3]); o1.z = cvtpk(xa[1][0], xa[1][1]); o1.w = cvtpk(xa[1][2], xa[1][3]);
                    o2.x = cvtpk(xb[0][0], xb[0][1]); o2.y = cvtpk(xb[0][2], xb[0][3]); o2.z = cvtpk(xb[1][0], xb[1][1]); o2.w = cvtpk(xb[1][2], xb[1][3]);
                    *(GAS u32x4*)(prow_p + colb) = o1; *(GAS u32x4*)(prow_p + colb + 32) = o2;
                }
        } else {
            f32x4 bv[2][2];
#pragma unroll
            for (int bj = 0; bj < 2; ++bj)
#pragma unroll
                for (int n = 0; n < 2; ++n) { const int col = 256 * pn + 128 * bj + 32 * wc + 8 * fq + 4 * n; bv[bj][n] = col < DIN ? ldg4(bia + col) : (f32x4){0.f, 0.f, 0.f, 0.f}; }
#pragma unroll
            for (int ai = 0; ai < 2; ++ai)
#pragma unroll
                for (int m = 0; m < 4; ++m) {
                    const int rloc = ai * 128 + wr * 64 + m * 16 + fr; bf16_t* prow_p = P + ((size_t)u.pm * 256 + rloc) * DINP; const float rs = rsv[ai][m];
#pragma unroll
                    for (int bj = 0; bj < 2; ++bj) { const int col = 256 * pn + 128 * bj + 32 * wc + 8 * fq;
                        if (col < DIN) { const f32x4 a0 = acc[ai][bj][m][0] * rs + bv[bj][0], a1 = acc[ai][bj][m][1] * rs + bv[bj][1];
                            u32x4 o; o.x = cvtpk(a0[0], a0[1]); o.y = cvtpk(a0[2], a0[3]); o.z = cvtpk(a1[0], a1[1]); o.w = cvtpk(a1[2], a1[3]); *(GAS u32x4*)(prow_p + col) = o; } }
                }
        }
    }
};

__device__ __forceinline__ void phase_p1(Frame& F, int l) {
    { const float* t32 = (const float*)(F.ws + WS_TAB); LAS float* d32 = (LAS float*)(F.lds + LDS_TAB32);
      for (int e = F.tid; e < (4096 + 8192) / 16; e += NTHREADS) *(LAS f32x4*)(d32 + 4 * e) = ldg4(t32 + 4 * e);
      __syncthreads(); }
    pg8::Gemm g{(const bf16_t*)(F.ws + WS_VN), (const bf16_t*)(F.ws + WS_WIN) + (size_t)l * DINP * D, MALL, DINP, D};
    EpiIn E{F.ws, F.lds, l, F.flags & 4};
    if (SPLIT_CTX && l == 1) {
        const int x = F.bid & 7, k = F.bid >> 3;
        Order S; S.init(NB * 16, DINP, F.G, (int)F.bid, 1); S.set_sub(4, 2);
        pg8::gemm_phase<EpiIn, Order, true, true>(F.lds, g, S, E, F.wave * 64 + fresh_lane());
        CtxOrder Sc; Sc.init(x, 31 - k, DINP / 256);
        if (Sc.have) { __syncthreads(); dep_wait(F, 8 + x, 4u); pg8::gemm_phase<EpiIn, CtxOrder, true, true>(F.lds, g, Sc, E, F.wave * 64 + fresh_lane()); }
        return;
    }
    Order S; S.init(NTILE, DINP, F.G, (int)F.bid, 0);
    pg8::gemm_phase<EpiIn, Order, true, true>(F.lds, g, S, E, F.tid);
}
struct EpiRes {
    static constexpr bool PERM = true, AFTER_DRAIN = false;
    unsigned char* ws; const float* xin; const float* ctxin; float* out; LAS float* red; int l, kind, skip;
    __device__ __forceinline__ void operator()(const f32x4 (&acc)[2][2][4][2], const Unit& u, int wr, int wc, int fr, int fq) const {
        if (skip) return;
        { const int ln = fresh_lane(); fr = ln & 15; fq = ln >> 4; }
        const float* MOD = (const float*)(ws + WS_MOD);
        const int b = u.pm / TPB, j = u.pm % TPB; const bool lat = j != 0; const int v = lat ? b : 8;
        const float* gate = MOD + ((size_t)l * 9 + v) * NMOD * D + (kind == 0 ? 2 : 5) * D;
        const bool do_vn = kind == 0 || l == 0;
        const float* vnm = (const float*)(ws + WS_VNM) + ((size_t)(kind == 0 ? l : 2) * 9 + v) * D;
        float* SSd = (float*)(ws + (kind == 0 ? WS_SS2 : WS_SS1));
        bf16_t* VN = (bf16_t*)(ws + WS_VN); bf16_t* XB = (bf16_t*)(ws + WS_XB);
        const bool first = kind == 0 && l == 0, last = kind == 1 && l == 1;
        const float* srcf = lat ? xin + (size_t)b * T * D : ctxin + (size_t)b * C * D;
        float* dstf = out + (size_t)b * T * D;
        const int rbase = lat ? (j - 1) * 256 : 0;
        const int c0 = 256 * u.pn + 32 * wc + 8 * fq;
        f32x4 gt[2][2], vm[2][2];
#pragma unroll
        for (int bj = 0; bj < 2; ++bj)
#pragma unroll
            for (int n = 0; n < 2; ++n) { gt[bj][n] = ldg4(gate + c0 + 128 * bj + 4 * n); vm[bj][n] = do_vn ? ldg4(vnm + c0 + 128 * bj + 4 * n) : (f32x4){0.f, 0.f, 0.f, 0.f}; }
#define EPIRES_ROW(ai, m, X0, X1, BJ) do { const int c = c0 + 128 * (BJ); \
            const f32x4 x0 = (X0) + gt[BJ][0] * acc[ai][BJ][m][0], x1 = (X1) + gt[BJ][1] * acc[ai][BJ][m][1]; \
            if (last) { const size_t ro = (size_t)(rbase + rloc) * D; stg4(dstf + ro + c, x0); stg4(dstf + ro + c + 4, x1); } \
            else { u32x4 o; o.x = cvtpk(x0[0], x0[1]); o.y = cvtpk(x0[2], x0[3]); o.z = cvtpk(x1[0], x1[1]); o.w = cvtpk(x1[2], x1[3]); *(GAS u32x4*)(XB + g * D + c) = o; } \
            if (do_vn) { const f32x4 v0 = x0 * vm[BJ][0], v1 = x1 * vm[BJ][1]; \
                u32x4 o; o.x = cvtpk(v0[0], v0[1]); o.y = cvtpk(v0[2], v0[3]); o.z = cvtpk(v1[0], v1[1]); o.w = cvtpk(v1[2], v1[3]); *(GAS u32x4*)(VN + g * D + c) = o; \
                ss += (x0[0] * x0[0] + x0[1] * x0[1] + x0[2] * x0[2] + x0[3] * x0[3]) + (x1[0] * x1[0] + x1[1] * x1[1] + x1[2] * x1[2] + x1[3] * x1[3]); } } while (0)
        if (first) {
#pragma unroll
            for (int hq = 0; hq < 4; ++hq) {
                const int ai = hq >> 1, mb = (hq & 1) * 2;
                f32x4 xo[2][2][2];
#pragma unroll
                for (int mm = 0; mm < 2; ++mm) { const size_t ro = (size_t)(rbase + ai * 128 + wr * 64 + (mb + mm) * 16 + fr) * D;
#pragma unroll
                    for (int bj = 0; bj < 2; ++bj) { xo[mm][bj][0] = ldg4(srcf + ro + c0 + 128 * bj); xo[mm][bj][1] = ldg4(srcf + ro + c0 + 128 * bj + 4); } }
#pragma unroll
                for (int mm = 0; mm < 2; ++mm) { const int m = mb + mm; const int rloc = ai * 128 + wr * 64 + m * 16 + fr; const size_t g = (size_t)u.pm * 256 + rloc; float ss = 0.f;
                    EPIRES_ROW(ai, m, xo[mm][0][0], xo[mm][0][1], 0); EPIRES_ROW(ai, m, xo[mm][1][0], xo[mm][1][1], 1);
                    if (do_vn) { ss += __shfl_xor(ss, 16); ss += __shfl_xor(ss, 32); if (fq == 0) red[wc * 256 + rloc] = ss; } }
            }
        } else {
#pragma unroll
            for (int ai = 0; ai < 2; ++ai) {
                u32x4 raw[4][2];
#pragma unroll
                for (int m = 0; m < 4; ++m) { const size_t g = (size_t)u.pm * 256 + ai * 128 + wr * 64 + m * 16 + fr;
#pragma unroll
                    for (int bj = 0; bj < 2; ++bj) raw[m][bj] = *(const GAS u32x4*)(XB + g * D + c0 + 128 * bj); }
#pragma unroll
                for (int m = 0; m < 4; ++m) { const int rloc = ai * 128 + wr * 64 + m * 16 + fr; const size_t g = (size_t)u.pm * 256 + rloc; float ss = 0.f;
#pragma unroll
                    for (int bj = 0; bj < 2; ++bj) { const u32x4 v = raw[m][bj];
                        const f32x4 a0 = (f32x4){__builtin_bit_cast(float, v.x << 16), __builtin_bit_cast(float, v.x & 0xffff0000u), __builtin_bit_cast(float, v.y << 16), __builtin_bit_cast(float, v.y & 0xffff0000u)};
                        const f32x4 a1 = (f32x4){__builtin_bit_cast(float, v.z << 16), __builtin_bit_cast(float, v.z & 0xffff0000u), __builtin_bit_cast(float, v.w << 16), __builtin_bit_cast(float, v.w & 0xffff0000u)};
                        if (bj == 0) EPIRES_ROW(ai, m, a0, a1, 0); else EPIRES_ROW(ai, m, a0, a1, 1); }
                    if (do_vn) { ss += __shfl_xor(ss, 16); ss += __shfl_xor(ss, 32); if (fq == 0) red[wc * 256 + rloc] = ss; } }
            }
        }
#undef EPIRES_ROW
        if (do_vn) {
            asm volatile("s_waitcnt lgkmcnt(0)" ::: "memory"); __builtin_amdgcn_s_barrier(); asm volatile("" ::: "memory");
            const int tid = 64 * (4 * wr + wc) + 16 * fq + fr;
            if (tid < 256) SSd[((size_t)u.pm * 256 + tid) * 4 + u.pn] = (red[tid] + red[256 + tid]) + (red[512 + tid] + red[768 + tid]);
        }
    }
};

struct EpiUp {
    static constexpr bool PERM = true, AFTER_DRAIN = false;
    unsigned char* ws; LAS float* ex; LAS float* pl; int l, skip; bf16_t* ub;
    __device__ __forceinline__ void operator()(const f32x4 (&acc)[2][2][4][2], const Unit& u, int wr, int wc, int fr, int fq) const {
        if (skip) return;
        { const int ln = fresh_lane(); fr = ln & 15; fq = ln >> 4; }
        const float* SS = (const float*)(ws + WS_SS2); const float* ffp = (const float*)(ws + WS_FFNP) + (size_t)l * 4 * DFF;
        const int b = u.pm / TPB, j = u.pm % TPB; const int v = j != 0 ? b : 8;
        const float* bia = (const float*)(ws + WS_BIAS2) + ((size_t)l * 9 + v) * 2 * DFF;
        bf16_t* U = ub;
        float* SIDE = (float*)(ws + WS_SIDE) + (size_t)u.pm * 6 * DFF;
        const int ch0 = 128 * u.pn + 32 * wc + 8 * fq;
        LAS float* rsl = pl + 6 * 128;
        { const int tid = 64 * (4 * wr + wc) + 16 * fq + fr;
          if (tid < 256) { const f32x4 s4 = ldg4(SS + ((size_t)u.pm * 256 + tid) * 4); rsl[tid] = __builtin_amdgcn_rsqf((s4[0] + s4[1] + s4[2] + s4[3]) * (1.0f / D) + EPS); } }
        { const int tid = 64 * (4 * wr + wc) + 16 * fq + fr;
          if (tid < 192) { const int vsel = tid >> 5, c4 = (tid & 31) * 4; const float* src = vsel == 0 ? bia : (vsel == 1 ? bia + DFF : ffp + (size_t)(vsel - 2) * DFF);
              *(LAS f32x4*)(pl + vsel * 128 + c4) = ldg4(src + 128 * u.pn + c4); } }
        asm volatile("s_waitcnt vmcnt(0) lgkmcnt(0)" ::: "memory"); __builtin_amdgcn_s_barrier(); asm volatile("" ::: "memory");
#pragma unroll
        for (int ai = 0; ai < 2; ++ai)
#pragma unroll
            for (int n = 0; n < 2; ++n) { const int q = 2 * ai + wr; const int cc = 32 * wc + 8 * fq + 4 * n; const f32x4 b4x = ldg4(bia + ch0 + 4 * n);
                if (fr == 0) *(LAS f32x4*)(ex + (q * 2 + 0) * 128 + cc) = acc[ai][0][0][n] * rsl[ai * 128 + wr * 64 + 0 * 16 + fr] + b4x;
                if (fr == 15) *(LAS f32x4*)(ex + (q * 2 + 1) * 128 + cc) = acc[ai][0][3][n] * rsl[ai * 128 + wr * 64 + 3 * 16 + fr] + b4x; }
        asm volatile("s_waitcnt lgkmcnt(0)" ::: "memory"); __builtin_amdgcn_s_barrier(); asm volatile("" ::: "memory");
        const int lane = fr + 16 * fq; const int srcp = (lane & 48) | ((fr + 15) & 15), srcn = (lane & 48) | ((fr + 1) & 15);
#pragma unroll
        for (int ai = 0; ai < 2; ++ai) {
            const int q = 2 * ai + wr;
            u32x2 keep[4];
#pragma unroll
            for (int n = 0; n < 2; ++n) {
                const int cc = 32 * wc + 8 * fq + 4 * n; const int ch = ch0 + 4 * n;
                const f32x4 b4n = *(const LAS f32x4*)(pl + 0 * 128 + cc), bv4n = *(const LAS f32x4*)(pl + 1 * 128 + cc), w0n = *(const LAS f32x4*)(pl + 2 * 128 + cc), w1n = *(const LAS f32x4*)(pl + 3 * 128 + cc), w2n = *(const LAS f32x4*)(pl + 4 * 128 + cc), fbn = *(const LAS f32x4*)(pl + 5 * 128 + cc);
                f32x4 pb = (f32x4){0.f, 0.f, 0.f, 0.f}, nb = pb;
                if (q > 0) pb = *(const LAS f32x4*)(ex + ((q - 1) * 2 + 1) * 128 + cc);
                if (q < 3) nb = *(const LAS f32x4*)(ex + ((q + 1) * 2 + 0) * 128 + cc);
                f32x4 Gm[4];
#pragma unroll
                for (int m = 0; m < 4; ++m) Gm[m] = acc[ai][0][m][n] * rsl[ai * 128 + wr * 64 + m * 16 + fr] + b4n;
#pragma unroll
                for (int m = 0; m < 4; ++m) {
                    const f32x4 sp = (fr == 15 && m > 0) ? Gm[m > 0 ? m - 1 : 0] : Gm[m], sn = (fr == 0 && m < 3) ? Gm[m < 3 ? m + 1 : 3] : Gm[m];
                    f32x4 prev, next;
#pragma unroll
                    for (int e = 0; e < 4; ++e) {
                        float pv_, nv_; const float spe = sp[e], sne = sn[e];
                        asm volatile("s_nop 1\n\tv_mov_b32_dpp %0, %1 row_ror:1 row_mask:0xf bank_mask:0xf" : "=&v"(pv_) : "v"(spe));
                        asm volatile("s_nop 1\n\tv_mov_b32_dpp %0, %1 row_ror:15 row_mask:0xf bank_mask:0xf" : "=&v"(nv_) : "v"(sne));
                        prev[e] = pv_; next[e] = nv_; }
                    if (m == 0 && fr == 0) prev = pb;
                    if (m == 3 && fr == 15) next = nb;
                    const f32x4 pre = fbn + w0n * prev + w1n * Gm[m] + w2n * next;
                    const f32x4 val = acc[ai][1][m][n] * rsl[ai * 128 + wr * 64 + m * 16 + fr] + bv4n;
                    f32x4 uu;
#pragma unroll
                    for (int e = 0; e < 4; ++e) uu[e] = pre[e] * __builtin_amdgcn_rcpf(1.0f + __builtin_amdgcn_exp2f(-LOG2E * pre[e])) * val[e];
                    const int rloc = ai * 128 + wr * 64 + m * 16 + fr; const size_t g = (size_t)u.pm * 256 + rloc;
                    if (n == 0) { keep[m].x = cvtpk(uu[0], uu[1]); keep[m].y = cvtpk(uu[2], uu[3]); }
                    else { u32x4 o; o.x = keep[m].x; o.y = keep[m].y; o.z = cvtpk(uu[0], uu[1]); o.w = cvtpk(uu[2], uu[3]); *(GAS u32x4*)(U + g * DFF + ch0) = o; }
                    if (rloc == 0 || rloc == 255) { float* sd = SIDE + (size_t)(ch >> 2) * 24 + (rloc == 0 ? 0 : 12); stg4(sd, pre); stg4(sd + 4, val); stg4(sd + 8, Gm[m]); }
                }
            }
        }
        asm volatile("s_waitcnt lgkmcnt(0)" ::: "memory"); __builtin_amdgcn_s_barrier(); asm volatile("" ::: "memory");
    }
};

__device__ __forceinline__ void phase_p3(Frame& F, int l) {
    pg8::Gemm g{(const bf16_t*)(F.ws + WS_Y), (const bf16_t*)(F.ws + WS_WOUT) + (size_t)l * D * DMIX, MALL, D, DMIX};
    const bool lat = l != 0 || SPLIT_CTX;
    Order S; S.init(lat ? NB * 16 : NTILE, D, F.G, F.bid, lat ? 1 : 0);
    EpiRes E{F.ws, F.in_(0), F.in_(2), F.out, (LAS float*)(F.lds + LDS_RED), l, 0, F.flags & 4};
    pg8::gemm_phase<EpiRes, Order, true, true>(F.lds, g, S, E, F.tid);
}
__device__ __forceinline__ void phase_p4(Frame& F, int l) {
    pg8::Gemm g{(const bf16_t*)(F.ws + WS_VN), (const bf16_t*)(F.ws + WS_WUP) + (size_t)l * 2 * DFF * D, MALL, 2 * DFF, D};
    if (SPLIT_CTX && l == 0) {
        const int x = F.bid & 7, k = F.bid >> 3;
        {
          pg8::Gemm g3{(const bf16_t*)(F.ws + WS_Y), (const bf16_t*)(F.ws + WS_WOUT), MALL, D, DMIX};
          CtxOrder Sc; Sc.init(x, k, D / 256);
          if (Sc.have) { EpiRes E3{F.ws, F.in_(0), F.in_(2), F.out, (LAS float*)(F.lds + LDS_RED), 0, 0, F.flags & 4};
              pg8::gemm_phase<EpiRes, CtxOrder, true, true>(F.lds, g3, Sc, E3, F.tid); dep_signal(F, x); } }
        { EpiUp E{F.ws, (LAS float*)(F.lds + LDS_EX), (LAS float*)(F.lds + LDS_EX + 25600), l, F.flags & 4, (bf16_t*)(F.ws + WS_U)};
          Order S; S.init(NB * 16, 2 * DFF, F.G, F.bid, 1);
          pg8::gemm_phase<EpiUp, Order, true, true>(F.lds, g, S, E, F.wave * 64 + fresh_lane()); }
        CtxOrder Sc; Sc.init(x, k - 4, 2 * DFF / 256);
        if (Sc.have) { __syncthreads(); dep_wait(F, x, 4u);
            EpiUp Ec{F.ws, (LAS float*)(F.lds + LDS_EX), (LAS float*)(F.lds + LDS_EX + 25600), l, F.flags & 4, (bf16_t*)(F.ws + WS_UC) + ((ptrdiff_t)x * 256 - (ptrdiff_t)x * TPB * 256) * DFF};
            pg8::gemm_phase<EpiUp, CtxOrder, true, true>(F.lds, g, Sc, Ec, F.wave * 64 + fresh_lane()); }
        return;
    }
    Order S; S.init(l == 0 ? NTILE : NB * 16, 2 * DFF, F.G, F.bid, l == 0 ? 0 : 1);
    EpiUp E{F.ws, (LAS float*)(F.lds + LDS_EX), (LAS float*)(F.lds + LDS_EX + 25600), l, F.flags & 4, (bf16_t*)(F.ws + WS_U)};
    pg8::gemm_phase<EpiUp, Order, true, true>(F.lds, g, S, E, F.tid);
}
__device__ __forceinline__ void phase_p5c(Frame& F) {
    if (!SPLIT_CTX) return;
    const int x = F.bid & 7, k = F.bid >> 3;
    CtxOrder Sc; Sc.init(x, k, D / 256);
    if (!Sc.have) return;
    pg8::Gemm g{(const bf16_t*)(F.ws + WS_UC) + ((ptrdiff_t)x * 256 - (ptrdiff_t)x * TPB * 256) * DFF, (const bf16_t*)(F.ws + WS_WDN), MALL, D, DFF};
    EpiRes E{F.ws, F.in_(0), F.in_(2), F.out, (LAS float*)(F.lds + LDS_RED), 0, 1, F.flags & 4};
    pg8::gemm_phase<EpiRes, CtxOrder, true, true>(F.lds, g, Sc, E, F.tid);
    dep_signal(F, 8 + x);
}
__device__ __forceinline__ void phase_p5(Frame& F, int l) {
    const bool lat = l != 0 || SPLIT_CTX;
    Order S; S.init(lat ? NB * 16 : NTILE, D, F.G, F.bid, lat ? 1 : 0);
    { const float* SIDE = (const float*)(F.ws + WS_SIDE); const float* ffp = (const float*)(F.ws + WS_FFNP) + (size_t)l * 4 * DFF; bf16_t* U = (bf16_t*)(F.ws + WS_U);
      Unit u;
      for (int i = 0; S.next(i, u); ++i) { const int pm = u.pm, j = pm % TPB;
          for (int ch = F.tid; ch < DFF; ch += NTHREADS) {
              const size_t so = ((size_t)pm * (DFF / 4) + (ch >> 2)) * 24 + (ch & 3);
              if (j >= 2) { const float pre = SIDE[so + 0] + ffp[ch] * SIDE[so - (size_t)(DFF / 4) * 24 + 20];
                  U[(size_t)pm * 256 * DFF + ch] = (bf16_t)f2bf(pre / (1.0f + __expf(-pre)) * SIDE[so + 4]); }
              if (j >= 1 && j <= 15) { const float pre = SIDE[so + 12] + ffp[2 * DFF + ch] * SIDE[so + (size_t)(DFF / 4) * 24 + 8];
                  U[((size_t)pm * 256 + 255) * DFF + ch] = (bf16_t)f2bf(pre / (1.0f + __expf(-pre)) * SIDE[so + 16]); }
          } }
      asm volatile("s_waitcnt vmcnt(0)" ::: "memory"); __syncthreads(); }
    pg8::Gemm g{(const bf16_t*)(F.ws + WS_U), (const bf16_t*)(F.ws + WS_WDN) + (size_t)l * D * DFF, MALL, D, DFF};
    EpiRes E{F.ws, F.in_(0), F.in_(2), F.out, (LAS float*)(F.lds + LDS_RED), l, 1, F.flags & 4};
    pg8::gemm_phase<EpiRes, Order, true, true>(F.lds, g, S, E, F.tid);
}
typedef short bf16x8 __attribute__((ext_vector_type(8)));
typedef short s16x4 __attribute__((ext_vector_type(4)));
typedef float f32x16 __attribute__((ext_vector_type(16)));
__device__ __forceinline__ int crow(int r, int hi) { return (r & 3) + 8 * (r >> 2) + 4 * hi; }
typedef short v4i16_t __attribute__((ext_vector_type(4)));
__device__ __forceinline__ s16x4 vtr(const LAS unsigned char* p) { return __builtin_bit_cast(s16x4, __builtin_amdgcn_ds_read_tr16_b64_v4i16((LAS v4i16_t*)p)); }

constexpr int ATT_KV_BYTES = 8192;
__device__ __forceinline__ void att_stage(const bf16_t* Krow0, const bf16_t* Vrow0, LAS unsigned char* kbuf, LAS unsigned char* vbuf, int wave, int lane) {
    const int kr = 8 * wave + (lane >> 3);
    const bf16_t* ks = Krow0 + (size_t)kr * DINP + (((lane & 7) ^ ((kr >> 1) & 7)) * 8);
    const bf16_t* vs = Vrow0 + (size_t)(16 * (wave & 3) + (lane >> 2)) * DINP + (wave >> 2) * 32 + (lane & 3) * 8;
    __builtin_amdgcn_global_load_lds((const unsigned*)ks, (LAS unsigned*)(kbuf + wave * 1024), 16, 0, 0);
    __builtin_amdgcn_global_load_lds((const unsigned*)vs, (LAS unsigned*)(vbuf + wave * 1024), 16, 0, 0);
}
template <int NK> __device__ __forceinline__ f32x16 att_qk(const LAS unsigned char* kbuf, int d0, int kh, const bf16x8* qr, f32x16 cinit, int r32, int hi) {
    f32x16 s = cinit;
#pragma unroll
    for (int i = 0; i < NK; ++i) { const int key = kh * 32 + r32; const bf16x8 kf = *(const LAS bf16x8*)(kbuf + key * 128 + (((2 * (d0 + i) + hi) ^ ((key >> 1) & 7)) * 16)); s = __builtin_amdgcn_mfma_f32_32x32x16_bf16(kf, qr[i], s, 0, 0, 0); }
    return s;
}
__device__ __forceinline__ bf16x8 att_vfrag(const LAS unsigned char* vbuf, int dh, int ks, int lane, int hi) {
    const LAS unsigned char* p = vbuf + (dh * 4 + ks) * 1024 + ((lane >> 4) & 1) * 32 + (lane & 3) * 8 + (4 * hi + ((lane & 15) >> 2)) * 64;
    const s16x4 lo = vtr(p), hh = vtr(p + 512);
    return (bf16x8){lo[0], lo[1], lo[2], lo[3], hh[0], hh[1], hh[2], hh[3]};
}
__device__ __forceinline__ float half_swap_sum(float v) { return v + __shfl_xor(v, 32); }

__device__ __forceinline__ void da_unit(Frame& F, int l, int b, int h, int q0, int nkeys) {
    const int lane_ = fresh_lane();
    const int lane = lane_, wave = F.wave, r32 = lane & 31, hi = lane >> 5;
    unsigned char* wsu = F.ws; asm volatile("" : "+s"(wsu));
    const bf16_t* P = (const bf16_t*)(wsu + WS_P) + (size_t)b * RB * DINP;
    const float* par = (const float*)(wsu + WS_PAR) + l * PAR_STRIDE;
    LAS unsigned char* kb0 = F.lds; LAS unsigned char* vb0 = F.lds + 4 * ATT_KV_BYTES;
    LAS float* wsf = (LAS float*)(F.lds + 8 * ATT_KV_BYTES) + wave * 128;
    const bf16_t* Kp = P + O_AK + h * 64; const bf16_t* Vp = P + O_AV + h * 64;
    const int NT = nkeys / 64;
#pragma nounroll
    for (int t0 = 0; t0 < 2; ++t0) att_stage(Kp + (size_t)t0 * 64 * DINP, Vp + (size_t)t0 * 64 * DINP, kb0 + t0 * ATT_KV_BYTES, vb0 + t0 * ATT_KV_BYTES, wave, lane);
    bf16x8 qr[4];
#pragma unroll
    for (int d0 = 0; d0 < 4; ++d0) qr[d0] = *(const bf16x8*)(P + (size_t)(q0 + wave * 32 + r32) * DINP + O_AQ + h * 64 + d0 * 16 + hi * 8);
    const float negM = -par[PR_MA];
    f32x16 cinit;
#pragma unroll
    for (int r = 0; r < 16; ++r) cinit[r] = negM;
    f32x16 o[2][2];
#pragma unroll
    for (int m = 0; m < 2; ++m)
#pragma unroll
        for (int dh = 0; dh < 2; ++dh)
#pragma unroll
            for (int r = 0; r < 16; ++r) o[m][dh][r] = 0.f;
    float lsum[2] = {0.f, 0.f};
    asm volatile("s_waitcnt vmcnt(0)" ::: "memory"); __syncthreads();
    f32x16 sc0 = att_qk<2>(kb0, 0, 0, qr, cinit, r32, hi), sc1 = att_qk<2>(kb0, 0, 1, qr, cinit, r32, hi);
    unsigned pwp[4][4];
#pragma unroll
    for (int ks = 0; ks < 4; ++ks)
#pragma unroll
        for (int i = 0; i < 4; ++i) pwp[ks][i] = 0u;
#ifdef DA_STAMP
    unsigned long long st_[6] = {0, 0, 0, 0, 0, 0}; unsigned long long ta_, tb_;
#define DSTAMP(v) do { __builtin_amdgcn_sched_barrier(0); asm volatile("s_memtime %0\n\ts_waitcnt lgkmcnt(0)" : "=s"(v) :: "memory"); __builtin_amdgcn_sched_barrier(0); } while (0)
#else
#define DSTAMP(v) do {} while (0)
#endif
    int bk = 0, bk1 = 1, bvp = 0;
    for (int t = 0; t < NT; ++t) {
#ifdef DA_STAMP
        DSTAMP(ta_); const unsigned long long titer_ = ta_;
#endif
        if (t + 2 < NT) { const int bl = (t + 2) & 3; att_stage(Kp + (size_t)(t + 2) * 64 * DINP, Vp + (size_t)(t + 2) * 64 * DINP, kb0 + bl * ATT_KV_BYTES, vb0 + bl * ATT_KV_BYTES, wave, lane); }
#pragma unroll
        for (int m = 0; m < 2; ++m) {
#ifdef DA_STAMP
            DSTAMP(ta_);
#endif
            f32x16 sn0 = cinit, sn1 = cinit;
            const bool have_next = m == 0 || t + 1 < NT;
            if (have_next) { const LAS unsigned char* kbn = kb0 + (m == 0 ? bk : bk1) * ATT_KV_BYTES; const int mn = m ^ 1;
                sn0 = att_qk<2>(kbn, 2 * mn, 0, qr + 2 * mn, cinit, r32, hi); sn1 = att_qk<2>(kbn, 2 * mn, 1, qr + 2 * mn, cinit, r32, hi); }
#ifdef DA_STAMP
            DSTAMP(tb_); st_[0] += tb_ - ta_; ta_ = tb_;
#endif
            if (m == 1 || t > 0) { const LAS unsigned char* vb = vb0 + (m == 1 ? bk : bvp) * ATT_KV_BYTES;
#pragma unroll
                for (int dh = 0; dh < 2; ++dh)
#pragma unroll
                    for (int ks = 0; ks < 4; ++ks) { const bf16x8 vf = att_vfrag(vb, dh, ks, lane, hi); const u32x4 pa = (u32x4){pwp[ks][0], pwp[ks][1], pwp[ks][2], pwp[ks][3]};
                        o[m ^ 1][dh] = __builtin_amdgcn_mfma_f32_32x32x16_bf16(__builtin_bit_cast(bf16x8, pa), vf, o[m ^ 1][dh], 0, 0, 0); } }
#ifdef DA_STAMP
            DSTAMP(tb_); st_[1] += tb_ - ta_; ta_ = tb_;
#endif
            float acc = 0.f;
#pragma unroll
            for (int r = 0; r < 16; ++r) { sc0[r] = __builtin_amdgcn_exp2f(sc0[r]); sc1[r] = __builtin_amdgcn_exp2f(sc1[r]); acc += sc0[r] + sc1[r]; }
            lsum[m] += acc;
#pragma unroll
            for (int i = 0; i < 4; ++i) { pwp[0][i] = cvtpk(sc0[2 * i], sc0[2 * i + 1]); pwp[1][i] = cvtpk(sc0[8 + 2 * i], sc0[8 + 2 * i + 1]); pwp[2][i] = cvtpk(sc1[2 * i], sc1[2 * i + 1]); pwp[3][i] = cvtpk(sc1[8 + 2 * i], sc1[8 + 2 * i + 1]); }
            sc0 = sn0; sc1 = sn1;
#ifdef DA_STAMP
            asm volatile("" : "+v"(sc0), "+v"(sc1));
            DSTAMP(tb_); st_[2] += tb_ - ta_; ta_ = tb_;
#endif
        }
        bvp = bk; bk = bk1; bk1 = (bk1 + 1) & 3;
        asm volatile("s_waitcnt vmcnt(0) lgkmcnt(0)" ::: "memory");
#ifdef DA_STAMP
        DSTAMP(tb_); st_[3] += tb_ - ta_; ta_ = tb_;
#endif
        __builtin_amdgcn_s_barrier(); asm volatile("" ::: "memory");
#ifdef DA_STAMP
        DSTAMP(tb_); st_[4] += tb_ - ta_; st_[5] += tb_ - titer_;
#endif
    }
    { const LAS unsigned char* vb = vb0 + bvp * ATT_KV_BYTES;
#pragma unroll
      for (int dh = 0; dh < 2; ++dh)
#pragma unroll
          for (int ks = 0; ks < 4; ++ks) { const bf16x8 vf = att_vfrag(vb, dh, ks, lane, hi); const u32x4 pa = (u32x4){pwp[ks][0], pwp[ks][1], pwp[ks][2], pwp[ks][3]};
              o[1][dh] = __builtin_amdgcn_mfma_f32_32x32x16_bf16(__builtin_bit_cast(bf16x8, pa), vf, o[1][dh], 0, 0, 0); } }
    unsigned char* ws2 = F.ws; asm volatile("" : "+s"(ws2));
    const float* par2 = (const float*)(ws2 + WS_PAR) + l * PAR_STRIDE;
    const float lam = par2[PR_LAM], li = par2[PR_LI];
    lsum[0] = half_swap_sum(lsum[0]); lsum[1] = half_swap_sum(lsum[1]);
    if (hi == 0) { wsf[r32] = __builtin_amdgcn_rcpf(lsum[0]); wsf[32 + r32] = lam * __builtin_amdgcn_rcpf(lsum[1]); }
    LDS_WAIT();
    float ss[16];
#pragma unroll
    for (int r = 0; r < 16; ++r) { const int row = crow(r, hi); const float i0 = wsf[row], i1 = wsf[32 + row];
        float sq = 0.f;
#pragma unroll
        for (int dh = 0; dh < 2; ++dh) { const float v = o[0][dh][r] * i0 - o[1][dh][r] * i1; o[0][dh][r] = v; sq += v * v; }
        ss[r] = sq; }
#pragma unroll
    for (int sh = 1; sh < 32; sh <<= 1)
#pragma unroll
        for (int r = 0; r < 16; ++r) ss[r] += __shfl_xor(ss[r], sh);
    bf16_t* Y = (bf16_t*)(ws2 + WS_Y) + ((size_t)b * RB + q0 + wave * 32) * D + h * 64;
#pragma unroll
    for (int dh = 0; dh < 2; ++dh) { const float gsc = par2[PR_SUBG + 32 * dh + r32] * (1.0f - li);
#pragma unroll
        for (int r = 0; r < 16; ++r) { const float rs = __builtin_amdgcn_rsqf(ss[r] * (1.0f / 64.f) + EPS);
            if (!(F.flags & 8)) Y[(size_t)crow(r, hi) * D + 32 * dh + r32] = (bf16_t)f2bf(o[0][dh][r] * rs * gsc); } }
#ifdef DA_STAMP
    if (F.bid == DA_STAMP_BLOCK && wave == DA_STAMP_WAVE && lane == 0 && q0 == C && nkeys == RB) { unsigned long long* sp_ = (unsigned long long*)(ws2 + WS_CTL + 65536);
        for (int i = 0; i < 6; ++i) sp_[i] = st_[i]; sp_[6] = (unsigned long long)NT; }
#endif
    __syncthreads();
}

__device__ __forceinline__ void sw_unit3(Frame& F, int l, int b, int kv, int q0) {
    const int lane_ = fresh_lane();
    const int lane = lane_, wave = F.wave, r32 = lane & 31, hi = lane >> 5;
    const bf16_t* P = (const bf16_t*)(F.ws + WS_P) + (size_t)b * RB * DINP;
    const float* par = (const float*)(F.ws + WS_PAR) + l * PAR_STRIDE;
    LAS unsigned char* kb0 = F.lds; LAS unsigned char* vb0 = F.lds + 2 * ATT_KV_BYTES;
    LAS float* wsf = (LAS float*)(F.lds + 4 * ATT_KV_BYTES) + wave * 128;
    const bf16_t* Kp = P + O_BK + kv * 64; const bf16_t* Vp = P + O_BV + kv * 64;
    const bool lat = q0 != 0;
    const int pos0 = q0 - C;
    const int band_lo = lat ? (pos0 - 128 < 0 ? 0 : pos0 - 128) : 0, band_hi = lat ? (pos0 + 384 > T ? T : pos0 + 384) : 0;
    const int NT = 4 + (band_hi - band_lo) / 64;
    const int qpos = pos0 + wave * 32 + r32;
    att_stage(Kp, Vp, kb0, vb0, wave, lane);
    LAS unsigned char* QL = F.lds + 40960 + (wave * 64 + lane) * 16;
#pragma unroll
    for (int g = 0; g < 3; ++g)
#pragma unroll
        for (int d0 = 0; d0 < 4; ++d0) *(LAS bf16x8*)(QL + (g * 4 + d0) * 8192) = *(const bf16x8*)(P + (size_t)(q0 + wave * 32 + r32) * DINP + O_BQ + (kv * 3 + g) * 64 + d0 * 16 + hi * 8);
    const float negM = -par[PR_MB];
    f32x16 cinit;
#pragma unroll
    for (int r = 0; r < 16; ++r) cinit[r] = negM;
    f32x16 o[3][2]; float lsum[3];
#pragma unroll
    for (int g = 0; g < 3; ++g) {
        lsum[g] = hi == 0 ? __builtin_amdgcn_exp2f(par[PR_SINK + kv * 3 + g] * LOG2E + negM) : 0.f;
#pragma unroll
        for (int dh = 0; dh < 2; ++dh)
#pragma unroll
            for (int r = 0; r < 16; ++r) o[g][dh][r] = 0.f; }
    asm volatile("s_waitcnt vmcnt(0)" ::: "memory"); __syncthreads();
    for (int t = 0; t < NT; ++t) {
        const int cur = t & 1;
        if (t + 1 < NT) { const int nr = (t + 1 < 4) ? (t + 1) * 64 : C + band_lo + (t + 1 - 4) * 64;
            att_stage(Kp + (size_t)nr * DINP, Vp + (size_t)nr * DINP, kb0 + (cur ^ 1) * ATT_KV_BYTES, vb0 + (cur ^ 1) * ATT_KV_BYTES, wave, lane); }
        const LAS unsigned char* kb = kb0 + cur * ATT_KV_BYTES; const LAS unsigned char* vb = vb0 + cur * ATT_KV_BYTES;
        const int kpos0 = band_lo + (t - 4) * 64;
        const int wlo = pos0 + wave * 32 - 128, whi = pos0 + wave * 32 + 31 + 128;
        const bool band = t >= 4;
        const bool active = !band || (kpos0 + 63 >= wlo && kpos0 <= whi);
        if (active) {
            const bool need_mask = band && (kpos0 < wlo + 31 || kpos0 + 63 > whi - 31);
#pragma unroll
            for (int g = 0; g < 3; ++g) {
                unsigned pw[4][4];
                bf16x8 qr[4];
#pragma unroll
                for (int d0 = 0; d0 < 4; ++d0) qr[d0] = *(const LAS bf16x8*)(QL + (g * 4 + d0) * 8192);
#pragma unroll
                for (int kh = 0; kh < 2; ++kh) {
                    f32x16 s = att_qk<4>(kb, 0, kh, qr, cinit, r32, hi);
                    float acc = 0.f;
#pragma unroll
                    for (int r = 0; r < 16; ++r) { float p = __builtin_amdgcn_exp2f(s[r]);
                        if (need_mask) { const int d = qpos - (kpos0 + kh * 32 + crow(r, hi)); p = (d > 128 || d < -128) ? 0.f : p; }
                        s[r] = p; acc += p; }
                    lsum[g] += acc;
#pragma unroll
                    for (int i = 0; i < 4; ++i) { pw[2 * kh][i] = cvtpk(s[2 * i], s[2 * i + 1]); pw[2 * kh + 1][i] = cvtpk(s[8 + 2 * i], s[8 + 2 * i + 1]); }
                }
#pragma unroll
                for (int dh = 0; dh < 2; ++dh)
#pragma unroll
                    for (int ks = 0; ks < 4; ++ks) { const bf16x8 vf = att_vfrag(vb, dh, ks, lane, hi); const u32x4 pa = (u32x4){pw[ks][0], pw[ks][1], pw[ks][2], pw[ks][3]};
                        o[g][dh] = __builtin_amdgcn_mfma_f32_32x32x16_bf16(__builtin_bit_cast(bf16x8, pa), vf, o[g][dh], 0, 0, 0); }
                asm volatile("" ::: "memory");
            }
        }
        asm volatile("s_waitcnt vmcnt(0)" ::: "memory"); __syncthreads();
    }
    {
        const int ln = fresh_lane(); const int r32e = ln & 31, hie = ln >> 5;
        unsigned char* ws2 = F.ws; asm volatile("" : "+s"(ws2));
        LAS float* wsf2 = (LAS float*)(F.lds + 4 * ATT_KV_BYTES) + wave * 128;
        bf16_t* Y = (bf16_t*)(ws2 + WS_Y) + ((size_t)b * RB + q0 + wave * 32) * D + 256 + kv * 192;
#pragma unroll
        for (int g = 0; g < 3; ++g) {
            { const float lt = half_swap_sum(lsum[g]); if (hie == 0) wsf2[r32e] = __builtin_amdgcn_rcpf(lt); }
            LDS_WAIT();
#pragma unroll
            for (int r = 0; r < 16; ++r) { const int row = crow(r, hie); const float il = wsf2[row];
#pragma unroll
                for (int dh = 0; dh < 2; ++dh) Y[(size_t)row * D + g * 64 + 32 * dh + r32e] = (bf16_t)f2bf(o[g][dh][r] * il); }
            LDS_WAIT(); asm volatile("" ::: "memory");
        }
    }
    __syncthreads();
}

constexpr int LRU_XS = 0, LRU_CG = 33792, LRU_XCB = LRU_CG + 32768, LRU_WT = LRU_XCB + 256 * 144, LRU_EXC = LRU_WT + 128 * 144, LRU_HIN = LRU_EXC + 4096, LRU_PRM = LRU_HIN + 512, LRU_HF = LRU_PRM + 4096;
static_assert(LRU_HF + 32768 <= LDS_BYTES - 64, "LRU LDS map");
__device__ __forceinline__ float fast_sigmoid(float z) { return __builtin_amdgcn_rcpf(1.0f + __builtin_amdgcn_exp2f(-LOG2E * z)); }
__device__ __forceinline__ float bflo(unsigned v) { return __builtin_bit_cast(float, v << 16); }
__device__ __forceinline__ float bfhi(unsigned v) { return __builtin_bit_cast(float, v & 0xffff0000u); }
#define LBAR() do { asm volatile("s_waitcnt lgkmcnt(0)" ::: "memory"); __builtin_amdgcn_s_barrier(); asm volatile("" ::: "memory"); } while (0)
__device__ __forceinline__ void lru_item(Frame& F, int l, int pm, int hb, int stage, int dmask = 3) {
    const int lane_ = fresh_lane();
    const int lane = lane_, wave = F.wave, tid = wave * 64 + lane, r32 = lane & 31, hi = lane >> 5;
    unsigned char* wsu = F.ws; asm volatile("" : "+s"(wsu));
    const int b = pm / TPB, j = pm % TPB; const int L = j == 0 ? C : T, t0 = j == 0 ? 0 : (j - 1) * 256;
    const bf16_t* P = (const bf16_t*)(wsu + WS_P) + (size_t)pm * 256 * DINP;
    LAS unsigned char* XS = F.lds + LRU_XS; LAS unsigned char* CG = F.lds + LRU_CG; LAS unsigned char* XCb = F.lds + LRU_XCB; LAS unsigned char* WT = F.lds + LRU_WT;
    LAS float* EXC = (LAS float*)(F.lds + LRU_EXC); LAS float* HIN = (LAS float*)(F.lds + LRU_HIN);
    float* SUM = (float*)(wsu + WS_LRU);
    const u32x4* wsrc = (const u32x4*)((const bf16_t*)(wsu + WS_LRUW) + (size_t)(l * 2 * 6 + hb) * 8192);
    u32x4 xv[5], wv[4], cgv[4]; float pv[2];
#pragma unroll
    for (int i = 0; i < 5; ++i) { const int e = tid + i * NTHREADS; const int row = e >> 3, cc = e & 7; const int rl = row - 3, tt = t0 + rl;
        xv[i] = (u32x4){0u, 0u, 0u, 0u};
        if (e < 262 * 8 && tt >= 0 && tt < L) xv[i] = *(const GAS u32x4*)(P + (ptrdiff_t)rl * DINP + O_CX + 64 * hb + 8 * cc); }
#pragma unroll
    for (int i = 0; i < 4; ++i) wv[i] = *(const GAS u32x4*)(wsrc + (i >> 1) * 6 * 1024 + tid + (i & 1) * NTHREADS);
#pragma unroll
    for (int i = 0; i < 2; ++i) { const int e = tid + i * NTHREADS; const int ch = e & 63, kk = (e >> 6) & 7, d = e >> 9;
        pv[i] = kk < 4 ? F.in_(19)[((size_t)(l * 2 + d) * 4 + kk) * LW + 64 * hb + ch] : ((const float*)(wsu + WS_LRUP))[((size_t)(l * 2 + d) * 4 + (kk - 4)) * LW + 64 * hb + ch]; }
    if (stage != 0) {
#pragma unroll
        for (int i = 0; i < 4; ++i) { const int e = tid + i * NTHREADS; const int row = e >> 3, cc = e & 7; cgv[i] = *(const GAS u32x4*)(P + (size_t)row * DINP + O_CG + 64 * hb + 8 * cc); } }
#pragma unroll
    for (int i = 0; i < 5; ++i) { const int e = tid + i * NTHREADS; if (e < 262 * 8) *(LAS u32x4*)(XS + (e >> 3) * 128 + (e & 7) * 16) = xv[i]; }
#pragma unroll
    for (int i = 0; i < 2; ++i) { const int e = tid + i * NTHREADS; *(LAS u32x4*)(WT + (e >> 3) * 144 + (e & 7) * 16) = wv[i]; }
#pragma unroll
    for (int i = 0; i < 2; ++i) ((LAS float*)(F.lds + LRU_PRM))[tid + i * NTHREADS] = pv[i];
    if (stage != 0) {
#pragma unroll
        for (int i = 0; i < 4; ++i) { const int e = tid + i * NTHREADS; *(LAS u32x4*)(CG + (e >> 3) * 128 + (e & 7) * 16) = cgv[i]; } }
    LAS unsigned char* HF = F.lds + LRU_HF;
    const bool cache = stage == 0 && j != 0; const int itemL = (b * 16 + (j - 1)) * 6 + hb;
#pragma unroll
    for (int d = 0; d < 2; ++d) {
        if (!((dmask >> d) & 1)) continue;
        if (d == 1) {
#pragma unroll
            for (int i = 0; i < 2; ++i) { const int e = tid + i * NTHREADS; *(LAS u32x4*)(WT + (e >> 3) * 144 + (e & 7) * 16) = wv[2 + i]; } }
        typedef float f2 __attribute__((ext_vector_type(2)));
        const LAS float* prm = (const LAS float*)(F.lds + LRU_PRM) + d * 512;
        const int c2 = (tid & 31) * 2;
        LBAR();
        const f2 w0 = *(const LAS f2*)(prm + 0 * 64 + c2), w1 = *(const LAS f2*)(prm + 1 * 64 + c2), w2 = *(const LAS f2*)(prm + 2 * 64 + c2), w3 = *(const LAS f2*)(prm + 3 * 64 + c2), bb = *(const LAS f2*)(prm + 7 * 64 + c2);
#pragma unroll 4
        for (int i = 0; i < 16; ++i) { const int rl = (tid >> 5) + 16 * i; const LAS unsigned char* x = XS + (rl + 3) * 128 + c2 * 2;
            const unsigned u0 = *(const LAS unsigned*)(x), ua = *(const LAS unsigned*)(x + (d == 0 ? -3 : 3) * 128), ub = *(const LAS unsigned*)(x + (d == 0 ? -2 : 2) * 128), uc = *(const LAS unsigned*)(x + (d == 0 ? -1 : 1) * 128);
            const float v0 = bb[0] + w0[0] * bflo(ua) + w1[0] * bflo(ub) + w2[0] * bflo(uc) + w3[0] * bflo(u0);
            const float v1 = bb[1] + w0[1] * bfhi(ua) + w1[1] * bfhi(ub) + w2[1] * bfhi(uc) + w3[1] * bfhi(u0);
            *(LAS unsigned*)(XCb + rl * 144 + c2 * 2) = cvtpk(v0, v1); }
        LBAR();
        f32x16 acc[4];
#pragma unroll
        for (int nt = 0; nt < 4; ++nt)
#pragma unroll
            for (int r = 0; r < 16; ++r) acc[nt][r] = 0.f;
#pragma unroll
        for (int ks = 0; ks < 4; ++ks) { const bf16x8 af = *(const LAS bf16x8*)(XCb + (wave * 32 + r32) * 144 + (16 * ks + 8 * hi) * 2);
#pragma unroll
            for (int nt = 0; nt < 4; ++nt) { const bf16x8 bf = *(const LAS bf16x8*)(WT + (32 * nt + r32) * 144 + (16 * ks + 8 * hi) * 2);
                acc[nt] = __builtin_amdgcn_mfma_f32_32x32x16_bf16(af, bf, acc[nt], 0, 0, 0); } }
#pragma unroll
        for (int chh = 0; chh < 2; ++chh) { const int ch = 32 * chh + r32;
            const float ba = prm[4 * 64 + ch], bx = prm[5 * 64 + ch], sp8 = prm[6 * 64 + ch];
            unsigned zp[8], bp[8]; float zprev = 0.f, bprev = 0.f;
#pragma unroll
            for (int r = 0; r < 16; ++r) { const int rl = wave * 32 + crow(r, hi);
                const float xc = bf2f(*(const LAS unsigned short*)(XCb + rl * 144 + ch * 2));
                const float rg = fast_sigmoid(acc[chh][r] + ba), ig = fast_sigmoid(acc[2 + chh][r] + bx);
                const float z = rg * sp8;
                const float av = __builtin_amdgcn_exp2f(-z);
                const float bv = __builtin_amdgcn_sqrtf(fmaxf(1.0f - av * av, 0.f)) * (ig * xc);
                acc[chh][r] = av; acc[2 + chh][r] = bv;
                if (r & 1) { zp[r >> 1] = cvtpk(zprev, z); bp[r >> 1] = cvtpk(bprev, bv); } else { zprev = z; bprev = bv; } }
            if (cache) {
                unsigned char* lg = wsu + (d == 0 ? WS_LG0 : WS_LG1) + (size_t)itemL * 65536 + chh * 16384 + wave * 1024 + lane * 16;
                *(GAS u32x4*)(lg) = (u32x4){zp[0], zp[1], zp[2], zp[3]}; *(GAS u32x4*)(lg + 8192) = (u32x4){zp[4], zp[5], zp[6], zp[7]};
                *(GAS u32x4*)(lg + 32768) = (u32x4){bp[0], bp[1], bp[2], bp[3]}; *(GAS u32x4*)(lg + 32768 + 8192) = (u32x4){bp[4], bp[5], bp[6], bp[7]}; } }
        float gA[2][8], gB[2][8];
#pragma unroll
        for (int chh = 0; chh < 2; ++chh) {
#pragma unroll
            for (int q = 0; q < 4; ++q) { float A_ = 1.f, B_ = 0.f;
#pragma unroll
                for (int e = 0; e < 4; ++e) { const int r = 4 * q + (d == 0 ? e : 3 - e); B_ = acc[chh][r] * B_ + acc[2 + chh][r]; A_ *= acc[chh][r]; }
                const float pA_ = __shfl_xor(A_, 32), pB_ = __shfl_xor(B_, 32);
                gA[chh][2 * q] = hi ? pA_ : A_; gA[chh][2 * q + 1] = hi ? A_ : pA_; gB[chh][2 * q] = hi ? pB_ : B_; gB[chh][2 * q + 1] = hi ? B_ : pB_; }
            float blkA = 1.f, blkH = 0.f;
#pragma unroll
            for (int k = 0; k < 8; ++k) { const int s = d == 0 ? k : 7 - k; blkH = gA[chh][s] * blkH + gB[chh][s]; blkA *= gA[chh][s]; }
            if (hi == 0) *(LAS f2*)(EXC + (wave * 64 + 32 * chh + r32) * 2) = (f2){blkA, blkH};
        }
        LBAR();
#pragma unroll
        for (int chh = 0; chh < 2; ++chh) { const int ch = 32 * chh + r32;
            float h = 0.f;
            float totA = 1.f, totH = 0.f;
#pragma unroll
            for (int k = 0; k < 8; ++k) { const int w = d == 0 ? k : 7 - k; const f2 e2 = *(const LAS f2*)(EXC + (w * 64 + ch) * 2);
                const bool before = d == 0 ? (w < wave) : (w > wave);
                if (before) h = e2[0] * h + e2[1];
                totH = e2[0] * totH + e2[1]; totA *= e2[0]; }
            { if (wave == 0 && hi == 0) *(GAS f2*)(SUM + (((size_t)pm * 2 + d) * LW + 64 * hb + ch) * 2) = (f2){totA, totH}; }
            if (stage != 0) {
                float hq[4] = {0.f, 0.f, 0.f, 0.f};
#pragma unroll
                for (int k = 0; k < 8; ++k) { const int s = d == 0 ? k : 7 - k; const int q = s >> 1;
                    hq[q] = ((s & 1) == hi) ? h : hq[q];
                    h = gA[chh][s] * h + gB[chh][s]; }
#pragma unroll
                for (int q = 0; q < 4; ++q) { float hh = hq[q];
#pragma unroll
                    for (int e = 0; e < 4; ++e) { const int r = 4 * q + (d == 0 ? e : 3 - e); hh = acc[chh][r] * hh + acc[2 + chh][r]; acc[2 + chh][r] = hh; } }
                if (d == 0) {
#pragma unroll
                    for (int r = 0; r < 16; ++r) { const int rl = wave * 32 + crow(r, hi); *(LAS unsigned short*)(HF + rl * 128 + ch * 2) = (unsigned short)f2bf(acc[2 + chh][r]); }
                } else {
#pragma unroll
                    for (int r = 0; r < 16; ++r) { const int rl = wave * 32 + crow(r, hi); LAS unsigned short* cgp = (LAS unsigned short*)(CG + rl * 128 + ch * 2);
                        const float g = bf2f(*cgp), hf = bf2f(*(const LAS unsigned short*)(HF + rl * 128 + ch * 2));
                        const float u2 = (2.0f * 0.7978845608028654f * LOG2E) * (g + 0.044715f * g * g * g);
                        const float ge = g * __builtin_amdgcn_rcpf(1.0f + __builtin_amdgcn_exp2f(-u2));
                        *cgp = (unsigned short)f2bf((hf + acc[2 + chh][r]) * ge); }
                }
            }
        }
    }
    LBAR();
    if (stage != 0) {
        bf16_t* Y = (bf16_t*)(wsu + WS_Y) + (size_t)pm * 256 * D + 640 + 64 * hb;
#pragma unroll
        for (int i = 0; i < 4; ++i) { const int e = tid + i * NTHREADS; const int row = e >> 3, cc = e & 7; *(GAS u32x4*)(Y + (size_t)row * D + 8 * cc) = *(const LAS u32x4*)(CG + row * 128 + cc * 16); }
        LBAR();
    }
}


__device__ __forceinline__ void lru_item_b(Frame& F, int l, int pm, int hb) {
    const int lane_ = fresh_lane();
    const int lane = lane_, wave = F.wave, tid = wave * 64 + lane, r32 = lane & 31, hi = lane >> 5;
    unsigned char* wsu = F.ws; asm volatile("" : "+s"(wsu));
    const int b = pm / TPB, j = pm % TPB;
    const bf16_t* P = (const bf16_t*)(wsu + WS_P) + (size_t)pm * 256 * DINP;
    LAS unsigned char* CG = F.lds + LRU_CG; LAS float* EXC = (LAS float*)(F.lds + LRU_EXC); LAS float* HIN = (LAS float*)(F.lds + LRU_HIN); LAS unsigned char* HF = F.lds + LRU_HF;
    float* SUM = (float*)(wsu + WS_LRU);
    typedef float f2 __attribute__((ext_vector_type(2)));
    const int itemL = (b * 16 + (j - 1)) * 6 + hb;
    u32x4 cgv[4], zv[2][2][2], bv[2][2][2];
#pragma unroll
    for (int i = 0; i < 4; ++i) { const int e = tid + i * NTHREADS; const int row = e >> 3, cc = e & 7; cgv[i] = *(const GAS u32x4*)(P + (size_t)row * DINP + O_CG + 64 * hb + 8 * cc); }
#pragma unroll
    for (int d = 0; d < 2; ++d) { const unsigned char* lg = wsu + (d == 0 ? WS_LG0 : WS_LG1) + (size_t)itemL * 65536 + wave * 1024 + lane * 16;
#pragma unroll
        for (int chh = 0; chh < 2; ++chh)
#pragma unroll
            for (int hf = 0; hf < 2; ++hf) { zv[d][chh][hf] = *(const GAS u32x4*)(lg + chh * 16384 + hf * 8192); bv[d][chh][hf] = *(const GAS u32x4*)(lg + 32768 + chh * 16384 + hf * 8192); } }
    if (tid < 128) { const int d = tid >> 6, ch = tid & 63; const int pm0 = b * TPB; float h = 0.f;
        const GAS f2* S2 = (const GAS f2*)SUM + (size_t)d * LW + 64 * hb + ch;
        f2 sv[16];
#pragma unroll
        for (int q = 0; q < 16; ++q) { const int jj = d == 0 ? q : (q == 0 ? 0 : 17 - q); const bool valid = d == 0 ? (q < j) : (q == 0 || jj > j);
            sv[q] = valid ? S2[(size_t)(pm0 + jj) * 2 * LW] : (f2){1.f, 0.f}; }
#pragma unroll
        for (int q = 0; q < 16; ++q) h = sv[q][0] * h + sv[q][1];
        HIN[tid] = h; }
#pragma unroll
    for (int i = 0; i < 4; ++i) { const int e = tid + i * NTHREADS; *(LAS u32x4*)(CG + (e >> 3) * 128 + (e & 7) * 16) = cgv[i]; }
#pragma unroll
    for (int d = 0; d < 2; ++d) {
        f32x16 acc[4];
#pragma unroll
        for (int chh = 0; chh < 2; ++chh)
#pragma unroll
            for (int hf = 0; hf < 2; ++hf)
#pragma unroll
                for (int k = 0; k < 4; ++k) { const int r = 8 * hf + 2 * k;
                    acc[chh][r] = __builtin_amdgcn_exp2f(-bflo(zv[d][chh][hf][k])); acc[chh][r + 1] = __builtin_amdgcn_exp2f(-bfhi(zv[d][chh][hf][k]));
                    acc[2 + chh][r] = bflo(bv[d][chh][hf][k]); acc[2 + chh][r + 1] = bfhi(bv[d][chh][hf][k]); }
        LBAR();
        float gA[2][8], gB[2][8];
#pragma unroll
        for (int chh = 0; chh < 2; ++chh) {
#pragma unroll
            for (int q = 0; q < 4; ++q) { float A_ = 1.f, B_ = 0.f;
#pragma unroll
                for (int e = 0; e < 4; ++e) { const int r = 4 * q + (d == 0 ? e : 3 - e); B_ = acc[chh][r] * B_ + acc[2 + chh][r]; A_ *= acc[chh][r]; }
                const float pA_ = __shfl_xor(A_, 32), pB_ = __shfl_xor(B_, 32);
                gA[chh][2 * q] = hi ? pA_ : A_; gA[chh][2 * q + 1] = hi ? A_ : pA_; gB[chh][2 * q] = hi ? pB_ : B_; gB[chh][2 * q + 1] = hi ? B_ : pB_; }
            float blkA = 1.f, blkH = 0.f;
#pragma unroll
            for (int k = 0; k < 8; ++k) { const int s = d == 0 ? k : 7 - k; blkH = gA[chh][s] * blkH + gB[chh][s]; blkA *= gA[chh][s]; }
            if (hi == 0) *(LAS f2*)(EXC + (wave * 64 + 32 * chh + r32) * 2) = (f2){blkA, blkH};
        }
        LBAR();
#pragma unroll
        for (int chh = 0; chh < 2; ++chh) { const int ch = 32 * chh + r32;
            float h = HIN[d * 64 + ch];
#pragma unroll
            for (int k = 0; k < 8; ++k) { const int w = d == 0 ? k : 7 - k; const f2 e2 = *(const LAS f2*)(EXC + (w * 64 + ch) * 2);
                const bool before = d == 0 ? (w < wave) : (w > wave);
                if (before) h = e2[0] * h + e2[1]; }
            float hq[4] = {0.f, 0.f, 0.f, 0.f};
#pragma unroll
            for (int k = 0; k < 8; ++k) { const int s = d == 0 ? k : 7 - k; const int q = s >> 1;
                hq[q] = ((s & 1) == hi) ? h : hq[q];
                h = gA[chh][s] * h + gB[chh][s]; }
#pragma unroll
            for (int q = 0; q < 4; ++q) { float hh = hq[q];
#pragma unroll
                for (int e = 0; e < 4; ++e) { const int r = 4 * q + (d == 0 ? e : 3 - e); hh = acc[chh][r] * hh + acc[2 + chh][r]; acc[2 + chh][r] = hh; } }
            if (d == 0) {
#pragma unroll
                for (int r = 0; r < 16; ++r) { const int rl = wave * 32 + crow(r, hi); *(LAS unsigned short*)(HF + rl * 128 + ch * 2) = (unsigned short)f2bf(acc[2 + chh][r]); }
            } else {
#pragma unroll
                for (int r = 0; r < 16; ++r) { const int rl = wave * 32 + crow(r, hi); LAS unsigned short* cgp = (LAS unsigned short*)(CG + rl * 128 + ch * 2);
                    const float g = bf2f(*cgp), hf = bf2f(*(const LAS unsigned short*)(HF + rl * 128 + ch * 2));
                    const float u2 = (2.0f * 0.7978845608028654f * LOG2E) * (g + 0.044715f * g * g * g);
                    const float ge = g * __builtin_amdgcn_rcpf(1.0f + __builtin_amdgcn_exp2f(-u2));
                    *cgp = (unsigned short)f2bf((hf + acc[2 + chh][r]) * ge); }
            }
        }
    }
    LBAR();
    { bf16_t* Y = (bf16_t*)(wsu + WS_Y) + (size_t)pm * 256 * D + 640 + 64 * hb;
#pragma unroll
      for (int i = 0; i < 4; ++i) { const int e = tid + i * NTHREADS; const int row = e >> 3, cc = e & 7; *(GAS u32x4*)(Y + (size_t)row * D + 8 * cc) = *(const LAS u32x4*)(CG + row * 128 + cc * 16); }
      LBAR(); }
}
__device__ __forceinline__ void unit_map16(const Frame& F, int u, int& gi, int& sub) {
    if (F.G == 256) { const int bid = u & 255, rnd = u >> 8, x = bid & 7, k = bid >> 3; gi = rnd * 16 + 2 * x + (k >> 4); sub = k & 15; }
    else { gi = u >> 4; sub = u & 15; }
}
__device__ __forceinline__ void phase_p2a(Frame& F, int l) {
    if (!(F.flags & 2)) {
        for (int u = F.bid; u < NB * 2 * 16; u += F.G) { int gi, pb; unit_map16(F, u, gi, pb); sw_unit3(F, l, gi >> 1, gi & 1, C + pb * 256); }
        if (l == 0) for (int u = F.G - 1 - F.bid; u < NB * 2; u += F.G) sw_unit3(F, l, u >> 1, u & 1, 0);
    }
    if (!(F.flags & 1)) {
        for (int it = F.bid; it < 3 * F.G; it += F.G) { const int pm = it / 6; lru_item(F, l, pm, it % 6, (l == 0 && pm % TPB == 0) ? 2 : 0); }
        const int nx2 = NTILE * 6 - 3 * F.G;
        if ((int)F.bid < 2 * nx2) { const int it = 3 * F.G + (int)F.bid % nx2, pm = it / 6; lru_item(F, l, pm, it % 6, 0, 1 << ((int)F.bid / nx2)); }
    }
}
__device__ __forceinline__ void phase_p2b(Frame& F, int l) {
    if (!(F.flags & 1)) for (int it = F.bid + ((NTILE * 6 - 1 - F.bid) / F.G) * F.G; it >= 0; it -= F.G) { const int pm = it / 6; if (pm % TPB == 0) continue; lru_item_b(F, l, pm, it % 6); }
    if (F.flags & 2) return;
    for (int u = F.bid; u < NB * 4 * 16; u += F.G) { int gi, qb; unit_map16(F, u, gi, qb); da_unit(F, l, gi >> 2, gi & 3, C + qb * 256, RB); }
    if (l == 0) for (int u = F.G - 1 - F.bid; u < NB * 4; u += F.G) da_unit(F, l, u >> 2, u & 3, 0, C);
}
#define XB_TMO      128
#define XB_XCNT(j)  (256  + 64 * (j))
#define XB_XSUB(j)  (1280 + 64 * (j))
#define XB_XGEN(j)  (2304 + 64 * (j))
#define XB_TOP      3328
#define XB_TOPGEN   3392
#define XCD_BAR_WORDS 3456
#define XB_SPIN_CAP (1u << 18)

__device__ __forceinline__ unsigned xb_ld(unsigned* p)              { return __hip_atomic_load(p, __ATOMIC_RELAXED, __HIP_MEMORY_SCOPE_AGENT); }
__device__ __forceinline__ unsigned xb_add(unsigned* p, unsigned v) { return __hip_atomic_fetch_add(p, v, __ATOMIC_RELAXED, __HIP_MEMORY_SCOPE_AGENT); }
__device__ __forceinline__ unsigned xb_xcc_id() { return (unsigned)__builtin_amdgcn_s_getreg((3 << 11) | 20) & 0xFu; }
#define XB_SPIN(cond, bar) do { unsigned _sp = 0; while (cond) { __builtin_amdgcn_s_sleep(1); \
    if ((++_sp & 255u) == 0u) { if (xb_ld(&(bar)[XB_TMO])) break; if (_sp > XB_SPIN_CAP) { atomicAdd(&(bar)[XB_TMO], 1u); break; } } } } while (0)

struct XcdBarrier {
    unsigned* bar; unsigned x;
    volatile LAS unsigned* st;
};

__device__ __forceinline__ XcdBarrier xcd_barrier_post(unsigned* bar, volatile LAS unsigned* st, int tid) {
    XcdBarrier b; b.bar = bar; b.x = xb_xcc_id(); b.st = st;
    if (tid == 0) (void)xb_add(&bar[XB_XCNT(b.x)], 1u);
    return b;
}
__device__ __forceinline__ void xcd_barrier_complete(unsigned* bar, unsigned x, unsigned& nloc, unsigned& nx) {
    const unsigned G = gridDim.x * gridDim.y * gridDim.z;
    unsigned sum, cnt, mine, sp = 0u;
    for (;;) {
        sum = 0u; cnt = 0u; mine = 0u;
#pragma unroll
        for (unsigned j = 0; j < 16; ++j) { const unsigned c = xb_ld(&bar[XB_XCNT(j)]); sum += c; cnt += (c > 0u) ? 1u : 0u; mine = (j == x) ? c : mine; }
        if (sum == G) break;
        __builtin_amdgcn_s_sleep(1);
        if ((++sp & 255u) == 0u) { if (xb_ld(&bar[XB_TMO])) break; if (sp > XB_SPIN_CAP) { atomicAdd(&bar[XB_TMO], 1u); break; } }
    }
    nloc = mine > 0u ? mine : 1u; nx = cnt > 0u ? cnt : 1u;
}

__device__ __forceinline__ void xcd_barrier(const XcdBarrier& b, int tid) {
    asm volatile("s_waitcnt vmcnt(0)" ::: "memory");
    __syncthreads();
    if (tid == 0) {
        unsigned* bar = b.bar;
        __builtin_amdgcn_s_waitcnt(0);
        unsigned nloc = b.st[0], nx = b.st[1];
        if (nloc == 0u) { xcd_barrier_complete(bar, b.x, nloc, nx); b.st[0] = nloc; b.st[1] = nx; }
        const unsigned old = xb_add(&bar[XB_XSUB(b.x)], 1u);
        const unsigned gen = old / nloc;
        if (old + 1u == (gen + 1u) * nloc) {
            __builtin_amdgcn_fence(__ATOMIC_RELEASE, "agent");
            asm volatile("s_waitcnt vmcnt(0)" ::: "memory");
            const unsigned og = xb_add(&bar[XB_TOP], 1u);
            const unsigned tg = og / nx;
            if (og + 1u == (tg + 1u) * nx) xb_add(&bar[XB_TOPGEN], 1u);
            else XB_SPIN(xb_ld(&bar[XB_TOPGEN]) == tg, bar);
            __builtin_amdgcn_fence(__ATOMIC_ACQUIRE, "agent");
            xb_add(&bar[XB_XGEN(b.x)], 1u);
            asm volatile("s_waitcnt vmcnt(0)" ::: "memory");
        } else {
            XB_SPIN(xb_ld(&bar[XB_XGEN(b.x)]) == gen, bar);
            __builtin_amdgcn_fence(__ATOMIC_ACQUIRE, "agent");
            asm volatile("s_waitcnt vmcnt(0)" ::: "memory");
        }
    }
    __syncthreads();
}

constexpr int CW_BAR = 4096;
constexpr int LDS_MISC = LDS_BYTES - 64;
#ifndef PROBE_DOUBLE
#define PROBE_DOUBLE (-1)
#endif
struct Args { const float* in[31]; float* out; unsigned char* ws; int ph_lo, ph_hi, flags, pad; };
constexpr int N_PHASES = 14;
__global__ void __launch_bounds__(NTHREADS, 2) mk_fwd(Args args) {
    extern __shared__ __attribute__((aligned(16))) unsigned char lds_raw[];
    cg::grid_group grid = cg::this_grid();
    Frame F;
    F.lds = (LAS unsigned char*)lds_raw;
    F.G = gridDim.x;
    F.inp = args.in; F.out = args.out; F.flags = args.flags;
    const int lo = args.ph_lo, hi = args.ph_hi;
    if (lo < 0) grid.sync();
    volatile LAS unsigned* bst = (volatile LAS unsigned*)(F.lds + LDS_MISC);
    if (threadIdx.x < 2) bst[threadIdx.x] = 0u;
    __syncthreads();
    XcdBarrier xbar = xcd_barrier_post((unsigned*)args.ws + CW_BAR, bst, (int)threadIdx.x);
    const int wave0 = __builtin_amdgcn_readfirstlane((int)threadIdx.x >> 6);
#define MK_PHASE(k, CALL) do { if (lo <= (k) && (k) < hi) { \
        { const int ln_ = fresh_lane(); int wv_ = wave0; asm volatile("" : "+s"(wv_)); F.lane = ln_; F.wave = wv_; F.tid = wv_ * 64 + ln_; } \
        { int bx = blockIdx.x; asm volatile("" : "+s"(bx)); F.bid = bx; F.vcu = (F.G % 8 == 0) ? (bx % 8) * (F.G / 8) + bx / 8 : bx; } \
        { unsigned char* w_ = args.ws; asm volatile("" : "+s"(w_)); F.ws = w_; int z_ = 0; asm volatile("" : "+s"(z_)); F.zero = z_; } \
        CALL; if ((k) + 1 < hi) { xcd_barrier(xbar, wave0 * 64 + fresh_lane()); } } } while (0)
#ifdef DUP_PHASE
#define MK_DUP(k, CALL) do { if ((k) == DUP_PHASE) { \
        { const int ln_ = fresh_lane(); int wv_ = wave0; asm volatile("" : "+s"(wv_)); F.lane = ln_; F.wave = wv_; F.tid = wv_ * 64 + ln_; } \
        { int bx = blockIdx.x; asm volatile("" : "+s"(bx)); F.bid = bx; F.vcu = (F.G % 8 == 0) ? (bx % 8) * (F.G / 8) + bx / 8 : bx; } \
        { unsigned char* w_ = args.ws; asm volatile("" : "+s"(w_)); F.ws = w_; int z_ = 0; asm volatile("" : "+s"(z_)); F.zero = z_; } \
        F.flags = DUP_FLAGS; CALL; F.flags = 0; xcd_barrier(xbar, wave0 * 64 + fresh_lane()); } } while (0)
#else
#define MK_DUP(k, CALL) do { } while (0)
#endif
    MK_PHASE(0, phase_p0a(F));
    MK_DUP(0, phase_p0a(F));
    MK_PHASE(1, phase_p0b(F));
    MK_DUP(1, phase_p0b(F));
    MK_PHASE(2, phase_p1(F, 0));
    MK_DUP(2, phase_p1(F, 0));
    MK_PHASE(3, phase_p2a(F, 0));
    MK_DUP(3, phase_p2a(F, 0));
    MK_PHASE(4, phase_p2b(F, 0));
    MK_DUP(4, phase_p2b(F, 0));
    MK_PHASE(5, phase_p3(F, 0));
    MK_DUP(5, phase_p3(F, 0));
    MK_PHASE(6, phase_p4(F, 0));
    MK_DUP(6, phase_p4(F, 0));
    MK_PHASE(7, phase_p5(F, 0));
    MK_DUP(7, phase_p5(F, 0));
    MK_PHASE(8, (phase_p5c(F), phase_p1(F, 1)));
    MK_DUP(8, (phase_p5c(F), phase_p1(F, 1)));
    MK_PHASE(9, phase_p2a(F, 1));
    MK_DUP(9, phase_p2a(F, 1));
    MK_PHASE(10, phase_p2b(F, 1));
    MK_DUP(10, phase_p2b(F, 1));
    MK_PHASE(11, phase_p3(F, 1));
    MK_DUP(11, phase_p3(F, 1));
    MK_PHASE(12, phase_p4(F, 1));
    MK_DUP(12, phase_p4(F, 1));
    MK_PHASE(13, phase_p5(F, 1));
    MK_DUP(13, phase_p5(F, 1));
#undef MK_PHASE
#undef MK_DUP
}
}

static int mk_setup() {
    static int grid = 0;
    if (grid == 0) {
        int dev = 0, cus = 0, per_cu = 0;
        hipGetDevice(&dev); hipDeviceGetAttribute(&cus, hipDeviceAttributeMultiprocessorCount, dev);
        hipFuncSetAttribute((const void*)mk::mk_fwd, hipFuncAttributeMaxDynamicSharedMemorySize, mk::LDS_BYTES);
        hipOccupancyMaxActiveBlocksPerMultiprocessor(&per_cu, (const void*)mk::mk_fwd, mk::NTHREADS, mk::LDS_BYTES);
        (void)hipGetLastError();
        if (per_cu < 1) { fprintf(stderr, "mk_setup: occupancy query says %d blocks/CU\n", per_cu); per_cu = 1; }
        grid = 256;
        if (cus * per_cu < grid) fprintf(stderr, "mk_setup: %d CUs x %d cannot hold the 256-workgroup cooperative grid\n", cus, per_cu);
        fprintf(stderr, "mk_setup: cus %d per_cu %d grid %d\n", cus, per_cu, grid);
    }
    return grid;
}
static void mk_run(void* const* d_in, void* d_out, void* d_ws, hipStream_t stream, int lo, int hi, bool coop, int flags = 0) {
    const int grid = mk_setup();
    mk::Args a{};
    for (int i = 0; i < 31; ++i) a.in[i] = (const float*)d_in[i];
    a.out = (float*)d_out; a.ws = (unsigned char*)d_ws; a.ph_lo = lo; a.ph_hi = hi; a.flags = flags;
    if (coop) { void* params[] = {&a}; hipError_t e = hipLaunchCooperativeKernel((const void*)mk::mk_fwd, dim3(grid), dim3(mk::NTHREADS), params, mk::LDS_BYTES, stream);
        if (e != hipSuccess) fprintf(stderr, "coop launch failed: %s\n", hipGetErrorString(e)); }
    else hipLaunchKernelGGL(mk::mk_fwd, dim3(grid), dim3(mk::NTHREADS), mk::LDS_BYTES, stream, a);
}

extern "C" void kernel_launch(void* const* d_in, const int* in_sizes, int n_in, void* d_out, int out_size, void* d_ws, size_t ws_size, hipStream_t stream) {
    if (ws_size < mk::WS_END) { fprintf(stderr, "ws too small\n"); return; }
    hipMemsetAsync(d_ws, 0, 65536, stream);
    mk_run(d_in, d_out, d_ws, stream, 0, mk::N_PHASES, true);
}
```
